# Optimizing an MI355X kernel written in HIP

```python
import math
import jax, jax.numpy as jnp
from jax import lax
import numpy as np

D_MODEL = 1024
BATCH = 8
SEQ = 2048
DEPTH = 2

GRID_W = 64
CTX_LEN = 256
N_MOD = 9
D_FF = ((8 * D_MODEL + 3 * 256 - 1) // (3 * 256)) * 256
ADA_INIT = 0.5
LN_EPS = 1e-6
NEG_INF = -1e30

NA_HEAD_DIM = 64
NA_HEADS = (D_MODEL // 2) // NA_HEAD_DIM
NA_WIN_R = 8
NA_WIN_C = 16

GLA_HEADS = 4
GLA_DV = (D_MODEL // 2) // GLA_HEADS
GLA_DK = GLA_DV // 2
GLA_GATE_RANK = 16
GLA_TAU = 16.0
GLA_CHUNK = 64

DIFF_HEAD_DIM = 64
DIFF_HEADS = D_MODEL // (2 * DIFF_HEAD_DIM)
Q_BLOCK = 128
ROPE_THETA = 10000.0
ROPE_AXIS_DIM = DIFF_HEAD_DIM // 2

EVEN_SPLITS = (NA_HEADS * NA_HEAD_DIM,) * 3 + (GLA_HEADS * GLA_DK, GLA_HEADS * GLA_DK, GLA_HEADS * GLA_DV, GLA_HEADS * GLA_DV, GLA_GATE_RANK, GLA_GATE_RANK)
EVEN_IN = sum(EVEN_SPLITS)
EVEN_MIX = NA_HEADS * NA_HEAD_DIM + GLA_HEADS * GLA_DV
ODD_WIDTH = DIFF_HEADS * 2 * DIFF_HEAD_DIM
ODD_IN = 3 * ODD_WIDTH

kernel_name = 'hybrid_na_gla_diffattn_macaron_deepnorm'


def layer_norm(u):
    uf = u.astype(jnp.float32)
    mu = jnp.mean(uf, -1, keepdims=True)
    var = jnp.mean(jnp.square(uf - mu), -1, keepdims=True)
    return ((uf - mu) * lax.rsqrt(var + LN_EPS)).astype(u.dtype)


def rms_norm(u, g):
    uf = u.astype(jnp.float32)
    return (uf * lax.rsqrt(jnp.mean(uf * uf, -1, keepdims=True) + LN_EPS)).astype(u.dtype) * g


def modulate(u, shift, scale):
    return u * (1.0 + scale) + shift


def adaln_modulation(cond, w, b):
    m = jax.nn.silu(cond) @ w + b
    if m.ndim == 2:
        m = m[:, None, :]
    return jnp.split(m, N_MOD, axis=-1)


def swiglu(u, w_in, w_out):
    a, g = jnp.split(u @ w_in, 2, axis=-1)
    return (jax.nn.silu(a) * g) @ w_out


def split_cols(z, widths):
    idx = [int(i) for i in np.cumsum(widths)[:-1]]
    return jnp.split(z, idx, axis=-1)


def heads(t, n):
    return t.reshape(t.shape[0], t.shape[1], n, -1)


def softmax_attend(q, k, v):
    s = jnp.einsum('bthd,blhd->bhtl', q, k).astype(jnp.float32) * (q.shape[-1] ** -0.5)
    p = jax.nn.softmax(s, axis=-1).astype(v.dtype)
    return jnp.einsum('bhtl,blhd->bthd', p, v)


def neighbourhood_attention(q, k, v, kc, vc, rpb):
    B, S, H, dh = q.shape
    rows = S // GRID_W
    wr = min(NA_WIN_R, rows)
    grid = lambda t: t.reshape(B, rows, GRID_W, H, dh)
    qg, kg, vg = grid(q), grid(k), grid(v)
    r = jnp.arange(rows)
    row_start = jnp.clip(r - wr // 2, 0, rows - wr)
    row_idx = row_start[:, None] + jnp.arange(wr)[None, :]
    kb = kg[:, row_idx]
    vb = vg[:, row_idx]
    cidx = jnp.arange(GRID_W)
    col_start = jnp.clip(cidx - NA_WIN_C // 2, 0, GRID_W - NA_WIN_C)
    col_ok = (cidx[None, :] >= col_start[:, None]) & (cidx[None, :] < col_start[:, None] + NA_WIN_C)
    dr = row_idx - r[:, None] + NA_WIN_R - 1
    dc = jnp.clip(cidx[None, :] - cidx[:, None], -(NA_WIN_C - 1), NA_WIN_C - 1) + NA_WIN_C - 1
    bias = rpb[:, dr[:, None, :, None], dc[None, :, None, :]]
    scale = dh ** -0.5
    s_loc = jnp.einsum('brchd,briwhd->bhrciw', qg, kb).astype(jnp.float32) * scale + bias[None].astype(jnp.float32)
    s_loc = jnp.where(col_ok[:, None, :], s_loc, NEG_INF).reshape(B, H, rows, GRID_W, wr * GRID_W)
    s_ctx = jnp.einsum('brchd,blhd->bhrcl', qg, kc).astype(jnp.float32) * scale
    p = jax.nn.softmax(jnp.concatenate([s_loc, s_ctx], -1), axis=-1).astype(v.dtype)
    p_loc = p[..., :wr * GRID_W].reshape(B, H, rows, GRID_W, wr, GRID_W)
    p_ctx = p[..., wr * GRID_W:]
    o = jnp.einsum('bhrciw,briwhd->brchd', p_loc, vb) + jnp.einsum('bhrcl,blhd->brchd', p_ctx, vc)
    return o.reshape(B, S, H, dh)


def gla_chunked(q, k, v, log_g, state0, include_diag, with_output):
    B, T, H, dk = q.shape
    dv = v.shape[-1]
    n = T // GLA_CHUNK
    f32 = jnp.float32
    chunk = lambda t: t.astype(f32).reshape(B, n, GLA_CHUNK, H, t.shape[-1])
    qc, kc, vc, gc = chunk(q), chunk(k), chunk(v), chunk(log_g)
    b = jnp.cumsum(gc, axis=2)
    b_last = b[:, :, -1:]
    u = jnp.einsum('bnshd,bnshe->bnhde', kc * jnp.exp(b_last - b), vc)
    decay = jnp.exp(b_last[:, :, 0])

    def step(state, inp):
        dec, uc = inp
        return dec[..., None] * state + uc, state

    s_final, s_in = lax.scan(step, state0.astype(f32), (jnp.moveaxis(decay, 1, 0), jnp.moveaxis(u, 1, 0)))
    if not with_output:
        return None, s_final
    s_in = jnp.moveaxis(s_in, 0, 1)
    q_t = qc * jnp.exp(b)
    k_t = kc * jnp.exp(-b)
    mask = jnp.tril(jnp.ones((GLA_CHUNK, GLA_CHUNK), bool), 0 if include_diag else -1)
    att = jnp.where(mask, jnp.einsum('bnthd,bnshd->bnhts', q_t, k_t), 0.0)
    o = jnp.einsum('bnhts,bnshe->bnthe', att, vc) + jnp.einsum('bnthd,bnhde->bnthe', q_t, s_in)
    return o.reshape(B, T, H, dv).astype(v.dtype), s_final


def na_gla_mixer(xin, hin, w_in, w_out, rpb, w_gf, b_gf, w_gb, b_gb, norm_g, with_ctx_out):
    B, S, _ = xin.shape
    nq_x, nk_x, nv_x, gq_x, gk_x, gv_x, gr_x, zf_x, zb_x = split_cols(xin @ w_in, EVEN_SPLITS)
    nq_h, nk_h, nv_h, gq_h, gk_h, gv_h, gr_h, zf_h, zb_h = split_cols(hin @ w_in, EVEN_SPLITS)
    kh_na, vh_na = heads(nk_h, NA_HEADS), heads(nv_h, NA_HEADS)
    na_x = neighbourhood_attention(heads(nq_x, NA_HEADS), heads(nk_x, NA_HEADS), heads(nv_x, NA_HEADS), kh_na, vh_na, rpb)

    def gla_inputs(gq, gk, gv, zf, zb):
        q = heads(gq, GLA_HEADS) * (GLA_DK ** -0.5)
        lf = heads(jax.nn.log_sigmoid((zf @ w_gf + b_gf).astype(jnp.float32)) / GLA_TAU, GLA_HEADS)
        lb = heads(jax.nn.log_sigmoid((zb @ w_gb + b_gb).astype(jnp.float32)) / GLA_TAU, GLA_HEADS)
        return q, heads(gk, GLA_HEADS), heads(gv, GLA_HEADS), lf, lb

    flip = lambda t: jnp.flip(t, axis=1)
    s0 = jnp.zeros((B, GLA_HEADS, GLA_DK, GLA_DV), jnp.float32)
    qh, kh, vh, lfh, lbh = gla_inputs(gq_h, gk_h, gv_h, zf_h, zb_h)
    oh_f, sh_f = gla_chunked(qh, kh, vh, lfh, s0, True, with_ctx_out)
    oh_b, sh_b = gla_chunked(flip(qh), flip(kh), flip(vh), flip(lbh), s0, False, with_ctx_out)
    qx, kx, vx, lfx, lbx = gla_inputs(gq_x, gk_x, gv_x, zf_x, zb_x)
    ox_f, _ = gla_chunked(qx, kx, vx, lfx, sh_f, True, True)
    ox_b, _ = gla_chunked(flip(qx), flip(kx), flip(vx), flip(lbx), sh_b, False, True)

    def gla_out(o_f, o_b_flipped, gr):
        o = rms_norm(o_f + flip(o_b_flipped), norm_g) * jax.nn.silu(heads(gr, GLA_HEADS))
        return o.reshape(o.shape[0], o.shape[1], GLA_HEADS * GLA_DV)

    y_x = jnp.concatenate([na_x.reshape(B, S, -1), gla_out(ox_f, ox_b, gr_x)], -1) @ w_out
    y_h = None
    if with_ctx_out:
        na_h = softmax_attend(heads(nq_h, NA_HEADS), kh_na, vh_na)
        y_h = jnp.concatenate([na_h.reshape(B, hin.shape[1], -1), gla_out(oh_f, oh_b, gr_h)], -1) @ w_out
    return y_x, y_h


def axial_rope_tables(n_tokens):
    t = jnp.arange(n_tokens)
    row = (t // GRID_W).astype(jnp.float32)
    col = (t % GRID_W).astype(jnp.float32)
    inv = ROPE_THETA ** (-jnp.arange(0, ROPE_AXIS_DIM, 2, dtype=jnp.float32) / ROPE_AXIS_DIM)
    ar, ac = row[:, None] * inv, col[:, None] * inv
    ang = jnp.concatenate([ar, ar, ac, ac], -1)
    return jnp.cos(ang), jnp.sin(ang)


def apply_axial_rope(u, cos, sin):
    shape = (1, u.shape[1]) + (1,) * (u.ndim - 3) + (u.shape[-1],)
    cos = cos.reshape(shape).astype(u.dtype)
    sin = sin.reshape(shape).astype(u.dtype)
    half = u.shape[-1] // 2

    def rot(w):
        m = w.shape[-1] // 2
        return jnp.concatenate([-w[..., m:], w[..., :m]], -1)

    return u * cos + jnp.concatenate([rot(u[..., :half]), rot(u[..., half:])], -1) * sin


def differential_softmax_attend(q, k, v, lam):
    s = jnp.einsum('bqhmd,bkhmd->bhmqk', q, k).astype(jnp.float32) * (DIFF_HEAD_DIM ** -0.5)
    p = jax.nn.softmax(s, axis=-1)
    pd = (p[:, :, 0] - lam * p[:, :, 1]).astype(v.dtype)
    return jnp.einsum('bhqk,bkhe->bqhe', pd, v)


def diff_attention_mixer(xin, hin, w_in, w_out, lq1, lk1, lq2, lk2, subln_g, lambda_init, with_ctx_out):
    B, S, _ = xin.shape
    qk_heads = lambda t: t.reshape(t.shape[0], t.shape[1], DIFF_HEADS, 2, DIFF_HEAD_DIM)
    v_heads = lambda t: t.reshape(t.shape[0], t.shape[1], DIFF_HEADS, 2 * DIFF_HEAD_DIM)
    qx, kx, vx = jnp.split(xin @ w_in, 3, axis=-1)
    cos, sin = axial_rope_tables(S)
    qx = apply_axial_rope(qk_heads(qx), cos, sin)
    kx = apply_axial_rope(qk_heads(kx), cos, sin)
    vx = v_heads(vx)
    if with_ctx_out:
        qh, kh, vh = jnp.split(hin @ w_in, 3, axis=-1)
        qh = qk_heads(qh)
    else:
        kh, vh = jnp.split(hin @ w_in[:, ODD_WIDTH:], 2, axis=-1)
    kh, vh = qk_heads(kh), v_heads(vh)
    f32 = jnp.float32
    lam = (jnp.exp(jnp.sum(lq1.astype(f32) * lk1.astype(f32))) - jnp.exp(jnp.sum(lq2.astype(f32) * lk2.astype(f32))) + lambda_init)
    k_all = jnp.concatenate([kx, kh], axis=1)
    v_all = jnp.concatenate([vx, vh], axis=1)
    nb = S // Q_BLOCK
    q_blocks = jnp.moveaxis(qx.reshape(B, nb, Q_BLOCK, DIFF_HEADS, 2, DIFF_HEAD_DIM), 1, 0)
    o_blocks = lax.map(lambda qb: differential_softmax_attend(qb, k_all, v_all, lam), q_blocks)
    ox = jnp.moveaxis(o_blocks, 0, 1).reshape(B, S, DIFF_HEADS, 2 * DIFF_HEAD_DIM)

    def finish(o):
        o = rms_norm(o, subln_g) * (1.0 - lambda_init)
        return o.reshape(o.shape[0], o.shape[1], ODD_WIDTH) @ w_out

    y_x = finish(ox)
    y_h = finish(differential_softmax_attend(qh, kh, vh, lam)) if with_ctx_out else None
    return y_x, y_h


def setup_inputs(seed: int = 0) -> dict:
    key = jax.random.key(seed)
    ks = iter(jax.random.split(key, 64))
    f32 = jnp.float32
    beta = (8.0 * DEPTH) ** -0.25

    def normal(shape, scale):
        return jax.random.normal(next(ks), shape, f32) * scale

    inp = {}
    inp['x'] = normal((BATCH, SEQ, D_MODEL), 1.0)
    inp['c'] = normal((BATCH, D_MODEL), 1.0)
    inp['ctx'] = normal((BATCH, CTX_LEN, D_MODEL), 1.0)
    inp['c_ctx'] = normal((D_MODEL,), 1.0)
    for i in range(DEPTH):
        p = 'l%d_' % i
        inp[p + 'w_ada'] = normal((D_MODEL, N_MOD * D_MODEL), ADA_INIT * D_MODEL ** -0.5)
        inp[p + 'b_ada'] = normal((N_MOD * D_MODEL,), 0.02)
        inp[p + 'ffn1_w_in'] = normal((D_MODEL, 2 * D_FF), D_MODEL ** -0.5)
        inp[p + 'ffn1_w_out'] = normal((D_FF, D_MODEL), beta * D_FF ** -0.5)
        if i % 2 == 0:
            inp[p + 'mix_w_in'] = normal((D_MODEL, EVEN_IN), D_MODEL ** -0.5)
            inp[p + 'mix_w_out'] = normal((EVEN_MIX, D_MODEL), beta * EVEN_MIX ** -0.5)
            inp[p + 'na_rpb'] = normal((NA_HEADS, 2 * NA_WIN_R - 1, 2 * NA_WIN_C - 1), 0.05)
            inp[p + 'gla_w_gate_f'] = normal((GLA_GATE_RANK, GLA_HEADS * GLA_DK), GLA_GATE_RANK ** -0.5)
            inp[p + 'gla_b_gate_f'] = normal((GLA_HEADS * GLA_DK,), 0.1)
            inp[p + 'gla_w_gate_b'] = normal((GLA_GATE_RANK, GLA_HEADS * GLA_DK), GLA_GATE_RANK ** -0.5)
            inp[p + 'gla_b_gate_b'] = normal((GLA_HEADS * GLA_DK,), 0.1)
            inp[p + 'gla_norm_g'] = 1.0 + normal((GLA_DV,), 0.02)
        else:
            inp[p + 'mix_w_in'] = normal((D_MODEL, ODD_IN), D_MODEL ** -0.5)
            inp[p + 'mix_w_out'] = normal((ODD_WIDTH, D_MODEL), beta * ODD_WIDTH ** -0.5)
            inp[p + 'lambda_q1'] = normal((DIFF_HEAD_DIM,), 0.1)
            inp[p + 'lambda_k1'] = normal((DIFF_HEAD_DIM,), 0.1)
            inp[p + 'lambda_q2'] = normal((DIFF_HEAD_DIM,), 0.1)
            inp[p + 'lambda_k2'] = normal((DIFF_HEAD_DIM,), 0.1)
            inp[p + 'subln_g'] = 1.0 + normal((2 * DIFF_HEAD_DIM,), 0.02)
        inp[p + 'ffn2_w_in'] = normal((D_MODEL, 2 * D_FF), D_MODEL ** -0.5)
        inp[p + 'ffn2_w_out'] = normal((D_FF, D_MODEL), beta * D_FF ** -0.5)
    return inp


def reference(x, c, ctx, c_ctx,
              l0_w_ada, l0_b_ada, l0_ffn1_w_in, l0_ffn1_w_out, l0_mix_w_in, l0_mix_w_out, l0_na_rpb,
              l0_gla_w_gate_f, l0_gla_b_gate_f, l0_gla_w_gate_b, l0_gla_b_gate_b, l0_gla_norm_g,
              l0_ffn2_w_in, l0_ffn2_w_out,
              l1_w_ada, l1_b_ada, l1_ffn1_w_in, l1_ffn1_w_out, l1_mix_w_in, l1_mix_w_out,
              l1_lambda_q1, l1_lambda_k1, l1_lambda_q2, l1_lambda_k2, l1_subln_g,
              l1_ffn2_w_in, l1_ffn2_w_out):
    common = (
        (l0_w_ada, l0_b_ada, l0_ffn1_w_in, l0_ffn1_w_out, l0_ffn2_w_in, l0_ffn2_w_out),
        (l1_w_ada, l1_b_ada, l1_ffn1_w_in, l1_ffn1_w_out, l1_ffn2_w_in, l1_ffn2_w_out),
    )
    mixers = (
        (l0_mix_w_in, l0_mix_w_out, l0_na_rpb, l0_gla_w_gate_f, l0_gla_b_gate_f, l0_gla_w_gate_b, l0_gla_b_gate_b, l0_gla_norm_g),
        (l1_mix_w_in, l1_mix_w_out, l1_lambda_q1, l1_lambda_k1, l1_lambda_q2, l1_lambda_k2, l1_subln_g),
    )
    alpha = (2.0 * DEPTH) ** 0.25
    h = ctx
    for i in range(DEPTH):
        w_ada, b_ada, f1_in, f1_out, f2_in, f2_out = common[i]
        last = i == DEPTH - 1
        mx = adaln_modulation(c, w_ada, b_ada)
        mh = adaln_modulation(c_ctx, w_ada, b_ada)
        x = layer_norm(alpha * x + mx[2] * (0.5 * swiglu(modulate(x, mx[0], mx[1]), f1_in, f1_out)))
        h = layer_norm(alpha * h + mh[2] * (0.5 * swiglu(modulate(h, mh[0], mh[1]), f1_in, f1_out)))
        xin = modulate(x, mx[3], mx[4])
        hin = modulate(h, mh[3], mh[4])
        if i % 2 == 0:
            y_x, y_h = na_gla_mixer(xin, hin, *mixers[i], with_ctx_out=not last)
        else:
            lambda_init = 0.8 - 0.6 * math.exp(-0.3 * i)
            y_x, y_h = diff_attention_mixer(xin, hin, *mixers[i], lambda_init=lambda_init, with_ctx_out=not last)
        x = layer_norm(alpha * x + mx[5] * y_x)
        x = layer_norm(alpha * x + mx[8] * (0.5 * swiglu(modulate(x, mx[6], mx[7]), f2_in, f2_out)))
        if not last:
            h = layer_norm(alpha * h + mh[5] * y_h)
            h = layer_norm(alpha * h + mh[8] * (0.5 * swiglu(modulate(h, mh[6], mh[7]), f2_in, f2_out)))
    return x
```

```cpp
#include <hip/hip_runtime.h>
#include <hip/hip_cooperative_groups.h>
#include <cstdio>
#include <cstdint>
namespace cg = cooperative_groups;

typedef unsigned short bf16_t;
typedef float f32x4 __attribute__((ext_vector_type(4)));
typedef unsigned u32x4 __attribute__((ext_vector_type(4)));
typedef unsigned u32x2 __attribute__((ext_vector_type(2)));
#define DI __device__ __forceinline__

constexpr int NB = 8, SEQ = 2048, CTXL = 256, DM = 1024, DFF = 2816;
constexpr int MX = NB * SEQ, MH = NB * CTXL, MT = MX + MH;
constexpr float ALPHA = 1.41421356237309515f;
constexpr float LN_EPS = 1e-6f;
constexpr float LAMBDA_INIT = 0.35550906759f;
constexpr int NTHR = 512;

constexpr int LD0 = 3328, C_NQ = 0, C_NK = 512, C_NV = 1024, C_GQ = 1536, C_GK = 1792, C_GV = 2048, C_GR = 2560, C_ZF = 3072, C_ZB = 3088;
constexpr int LD1 = 3072;

constexpr size_t MiB = 1u << 20;
constexpr size_t WS_MOD = 0;
constexpr size_t WS_ROPE = 1 * MiB;
constexpr size_t WS_XH = 2 * MiB;
constexpr size_t WS_WT = 10 * MiB;
constexpr size_t WT_LAYER = 42 * MiB;
constexpr size_t WT_F1I = 0, WT_F1O = 11 * MiB, WT_MI = 16 * MiB + MiB / 2, WT_MO = 23 * MiB, WT_F2I = 25 * MiB, WT_F2O = 36 * MiB;
constexpr size_t WS_A = 94 * MiB;
constexpr size_t WS_H = 130 * MiB;
constexpr size_t WS_OF = 247 * MiB;
constexpr size_t WS_OB = 265 * MiB;
constexpr size_t WS_END = 283 * MiB;

constexpr int LDS_BYTES = 147456;

struct P { const float* in[31]; float* out; unsigned char* ws; int ph_lo, ph_hi; };

DI float bf2f(bf16_t h) { return __uint_as_float(((unsigned)h) << 16); }
DI bf16_t f2bf(float f) { unsigned u = __float_as_uint(f); return (bf16_t)((u + 0x7fffu + ((u >> 16) & 1u)) >> 16); }
DI unsigned pk2(float lo, float hi) { return (unsigned)f2bf(lo) | ((unsigned)f2bf(hi) << 16); }
DI float silu_f(float v) { return v / (1.f + expf(-v)); }
DI float wave_sum(float v) {
#pragma unroll
    for (int o = 1; o < 64; o <<= 1) v += __shfl_xor(v, o);
    return v;
}
DI int otid() { int t = threadIdx.x; asm volatile("" : "+v"(t)); return t; }
DI float* xres_ptr(const P& p, int m) { return m < MX ? p.out + (size_t)m * DM : (float*)(p.ws + WS_XH) + (size_t)(m - MX) * DM; }
DI const float* xin_ptr(const P& p, int m) { return m < MX ? p.in[0] + (size_t)m * DM : p.in[2] + (size_t)(m - MX) * DM; }
DI int modrow(int m) { return m < MX ? (m >> 11) : 8; }
DI const float* mod_ptr(const P& p, int l, int r, int chunk) { return (const float*)(p.ws + WS_MOD) + ((size_t)(l * 9 + r) * 9 + chunk) * DM; }
DI bf16_t* wt_ptr(const P& p, int l, size_t off) { return (bf16_t*)(p.ws + WS_WT + (size_t)l * WT_LAYER + off); }

DI void phase_adaln(const P& p, float* lds) {
    float* sc = lds; float* red = lds + 9 * 1024;
    const int tid = otid(), lane = tid & 63, w = tid >> 6;
    for (int i = tid; i < 9 * 1024; i += NTHR) { const int r = i >> 10, k = i & 1023; const float v = r < 8 ? p.in[1][r * 1024 + k] : p.in[3][k]; sc[i] = silu_f(v); }
    __syncthreads();
    for (int item = blockIdx.x; item < 288; item += gridDim.x) {
        const int l = item / 144, cb = item % 144, n = cb * 64 + lane;
        const float* W = p.in[l ? 18 : 4]; const float* bb = p.in[l ? 19 : 5];
        float acc[9];
#pragma unroll
        for (int r = 0; r < 9; ++r) acc[r] = 0.f;
#pragma unroll 4
        for (int k = w * 128; k < w * 128 + 128; ++k) { const float wv = W[(size_t)k * 9216 + n];
#pragma unroll
            for (int r = 0; r < 9; ++r) acc[r] += sc[r * 1024 + k] * wv; }
#pragma unroll
        for (int r = 0; r < 9; ++r) red[(w * 9 + r) * 64 + lane] = acc[r];
        __syncthreads();
        float* MOD = (float*)(p.ws + WS_MOD);
        for (int o = tid; o < 576; o += NTHR) { const int r = o >> 6, c = o & 63; float s = bb[cb * 64 + c];
#pragma unroll
            for (int w2 = 0; w2 < 8; ++w2) s += red[(w2 * 9 + r) * 64 + c];
            MOD[(size_t)(l * 9 + r) * 9216 + cb * 64 + c] = s; }
        __syncthreads();
    }
}
DI void phase_rope_table(const P& p) {
    float* T = (float*)(p.ws + WS_ROPE);
    for (int idx = blockIdx.x * NTHR + otid(); idx < 2048 * 32; idx += gridDim.x * NTHR) {
        const int t = idx >> 5, j = idx & 31, fi = j & 15; const float pos = (float)(j < 16 ? (t >> 6) : (t & 63));
        const float inv = powf(10000.f, -(float)(2 * fi) / 32.f); const float ang = pos * inv;
        T[idx * 2] = cosf(ang); T[idx * 2 + 1] = sinf(ang);
    }
}
DI void conv_item(const float* W, int K, int Nsrc, int src0, bf16_t* WT, int n0dst, int k0, float* scr, int lane) {
    if (src0 >= 0) {
#pragma unroll 8
        for (int i = 0; i < 32; ++i) { const int kk = 2 * i + (lane >> 5); scr[kk * 33 + (lane & 31)] = W[(size_t)(k0 + kk) * Nsrc + src0 + (lane & 31)]; }
    } else {
#pragma unroll 8
        for (int i = 0; i < 32; ++i) { const int kk = 2 * i + (lane >> 5); scr[kk * 33 + (lane & 31)] = 0.f; }
    }
    asm volatile("s_waitcnt lgkmcnt(0)" ::: "memory");
    const int c = lane & 7;
#pragma unroll
    for (int j = 0; j < 4; ++j) { const int n = (lane >> 3) + 8 * j; const float* s = scr + (8 * c) * 33 + n;
        u32x4 o; o.x = pk2(s[0 * 33], s[1 * 33]); o.y = pk2(s[2 * 33], s[3 * 33]); o.z = pk2(s[4 * 33], s[5 * 33]); o.w = pk2(s[6 * 33], s[7 * 33]);
        *(u32x4*)(WT + (size_t)(n0dst + n) * K + k0 + 8 * c) = o; }
    asm volatile("s_waitcnt lgkmcnt(0)" ::: "memory");
}
DI void conv_matrix_item(const float* W, int K, int Nsrc, int Ndst, int kind, bf16_t* WT, int item, float* scr, int lane) {
    const int nblk = Ndst / 32, kb = item / nblk, nb = item % nblk, n0 = nb * 32;
    int src0;
    if (kind == 1) { const int t = n0 >> 8, j = n0 & 255; src0 = j < 128 ? 128 * t + j : DFF + 128 * t + (j - 128); }
    else src0 = n0 < Nsrc ? n0 : -1;
    conv_item(W, K, Nsrc, src0, WT, n0, kb * 64, scr, lane);
}
DI void phase_convert(const P& p, float* lds) {
    const int tid = otid(), lane = tid & 63, w = tid >> 6;
    float* scr = lds + w * (64 * 33 + 16);
    const int gw = blockIdx.x * 8 + w, NGW = gridDim.x * 8;
    for (int l = 0; l < 2; ++l) {
        const int b = l ? 18 : 4;
        const int nmi = l ? 3072 : 3104, nmid = l ? 3072 : 3328;
        const int i0 = 16 * 176, i1 = 44 * 32, i2 = 16 * (nmid / 32), i3 = 16 * 32;
        const int total = i0 + i1 + i2 + i3 + i0 + i1;
        for (int it = gw; it < total; it += NGW) {
            int r = it;
            if (r < i0) { conv_matrix_item(p.in[b + 2], 1024, 5632, 5632, 1, wt_ptr(p, l, WT_F1I), r, scr, lane); continue; } r -= i0;
            if (r < i1) { conv_matrix_item(p.in[b + 3], 2816, 1024, 1024, 0, wt_ptr(p, l, WT_F1O), r, scr, lane); continue; } r -= i1;
            if (r < i2) { conv_matrix_item(p.in[b + 4], 1024, nmi, nmid, 0, wt_ptr(p, l, WT_MI), r, scr, lane); continue; } r -= i2;
            if (r < i3) { conv_matrix_item(p.in[b + 5], 1024, 1024, 1024, 0, wt_ptr(p, l, WT_MO), r, scr, lane); continue; } r -= i3;
            const int f2 = l ? 29 : 16;
            if (r < i0) { conv_matrix_item(p.in[f2], 1024, 5632, 5632, 1, wt_ptr(p, l, WT_F2I), r, scr, lane); continue; } r -= i0;
            conv_matrix_item(p.in[f2 + 1], 2816, 1024, 1024, 0, wt_ptr(p, l, WT_F2O), r, scr, lane);
        }
    }
}

DI void phase_rowpass(const P& p, bool do_ln, int src_mode, bool write_x, bool write_a, int l_mod, int ch_shift, int ch_scale, int M) {
    const int tid = otid(), lane = tid & 63, w = tid >> 6;
    const int gw = blockIdx.x * 8 + w, NGW = gridDim.x * 8;
    bf16_t* A = (bf16_t*)(p.ws + WS_A);
    for (int m = gw; m < M; m += NGW) {
        const f32x4* src = (const f32x4*)(src_mode == 0 ? xin_ptr(p, m) : (const float*)xres_ptr(p, m)) + lane;
        f32x4 v[4]; float s = 0.f;
#pragma unroll
        for (int j = 0; j < 4; ++j) { v[j] = src[64 * j]; s += (v[j].x + v[j].y) + (v[j].z + v[j].w); }
        if (do_ln) {
            const float mean = wave_sum(s) * (1.f / DM); float s2 = 0.f;
#pragma unroll
            for (int j = 0; j < 4; ++j) { v[j] = v[j] - mean; s2 += (v[j].x * v[j].x + v[j].y * v[j].y) + (v[j].z * v[j].z + v[j].w * v[j].w); }
            const float rstd = 1.0f / sqrtf(wave_sum(s2) * (1.f / DM) + LN_EPS);
#pragma unroll
            for (int j = 0; j < 4; ++j) v[j] = v[j] * rstd;
        }
        if (write_x) { f32x4* dst = (f32x4*)xres_ptr(p, m) + lane;
#pragma unroll
            for (int j = 0; j < 4; ++j) dst[64 * j] = v[j]; }
        if (write_a) {
            const f32x4* sh = (const f32x4*)mod_ptr(p, l_mod, modrow(m), ch_shift) + lane; const f32x4* scp = (const f32x4*)mod_ptr(p, l_mod, modrow(m), ch_scale) + lane;
            u32x2* o8 = (u32x2*)(A + (size_t)m * DM) + lane;
#pragma unroll
            for (int j = 0; j < 4; ++j) { const f32x4 a = v[j] * (scp[64 * j] + 1.0f) + sh[64 * j]; u32x2 o; o.x = pk2(a.x, a.y); o.y = pk2(a.z, a.w); o8[64 * j] = o; }
        }
    }
}

template <class Epi>
DI void naive_gemm(const bf16_t* A, const bf16_t* Wt, int M, int N, int K, const Epi& epi, float* lds) {
    float* sA = lds; float* sB = lds + 32 * 132;
    const int tid = otid(), tx = tid & 31, ty = tid >> 5;
    const int ntn = N / 256, ntm = M / 128, ntiles = ntm * ntn;
    for (int tile = blockIdx.x; tile < ntiles; tile += gridDim.x) {
        const int tn = tile % ntn, tm = tile / ntn, m0 = tm * 128, n0 = tn * 256;
        float acc[8][8];
#pragma unroll
        for (int i = 0; i < 8; ++i)
#pragma unroll
            for (int j = 0; j < 8; ++j) acc[i][j] = 0.f;
        for (int k0 = 0; k0 < K; k0 += 32) {
            const int row = tid >> 2, kc = (tid & 3) * 8;
            { const u32x4 raw = *(const u32x4*)(A + (size_t)(m0 + row) * K + k0 + kc);
#pragma unroll
              for (int j = 0; j < 4; ++j) { sA[(kc + 2 * j) * 132 + row] = __uint_as_float(raw[j] << 16); sA[(kc + 2 * j + 1) * 132 + row] = __uint_as_float(raw[j] & 0xffff0000u); } }
#pragma unroll
            for (int h = 0; h < 2; ++h) { const int rb = row + 128 * h; const u32x4 raw = *(const u32x4*)(Wt + (size_t)(n0 + rb) * K + k0 + kc);
#pragma unroll
              for (int j = 0; j < 4; ++j) { sB[(kc + 2 * j) * 264 + rb] = __uint_as_float(raw[j] << 16); sB[(kc + 2 * j + 1) * 264 + rb] = __uint_as_float(raw[j] & 0xffff0000u); } }
            __syncthreads();
#pragma unroll 4
            for (int kk = 0; kk < 32; ++kk) {
                const f32x4 a0 = *(const f32x4*)&sA[kk * 132 + ty * 8], a1 = *(const f32x4*)&sA[kk * 132 + ty * 8 + 4];
                const f32x4 b0 = *(const f32x4*)&sB[kk * 264 + tx * 4], b1 = *(const f32x4*)&sB[kk * 264 + 128 + tx * 4];
                const float a[8] = {a0.x, a0.y, a0.z, a0.w, a1.x, a1.y, a1.z, a1.w}; const float b[8] = {b0.x, b0.y, b0.z, b0.w, b1.x, b1.y, b1.z, b1.w};
#pragma unroll
                for (int i = 0; i < 8; ++i)
#pragma unroll
                    for (int j = 0; j < 8; ++j) acc[i][j] += a[i] * b[j];
            }
            __syncthreads();
        }
#pragma unroll
        for (int i = 0; i < 8; ++i)
#pragma unroll
            for (int j = 0; j < 4; ++j) epi.pair(m0 + ty * 8 + i, tn, tx * 4 + j, acc[i][j], acc[i][4 + j]);
    }
}
struct EpiSwiglu { bf16_t* H; DI void pair(int m, int t, int c, float va, float vg) const { H[(size_t)m * DFF + t * 128 + c] = f2bf(silu_f(va) * vg); } };
struct EpiStore { bf16_t* O; int ld; DI void pair(int m, int t, int c, float va, float vg) const { O[(size_t)m * ld + t * 256 + c] = f2bf(va); O[(size_t)m * ld + t * 256 + 128 + c] = f2bf(vg); } };
struct EpiResid { const P* p; int src_mode, l, chunk; float scale;
    DI void one(int m, int n, float v) const { const float* res = src_mode ? (const float*)xres_ptr(*p, m) : xin_ptr(*p, m); const float g = mod_ptr(*p, l, modrow(m), chunk)[n]; xres_ptr(*p, m)[n] = ALPHA * res[n] + g * scale * v; }
    DI void pair(int m, int t, int c, float va, float vg) const { one(m, t * 256 + c, va); one(m, t * 256 + 128 + c, vg); } };

template <int NV>
DI void att_step(const float (&q)[64], const bf16_t* kp, const bf16_t* vp, float bias, float& mx, float& l, float (&o)[NV]) {
    float dot = 0.f;
#pragma unroll
    for (int c = 0; c < 8; ++c) { const u32x4 raw = *(const u32x4*)(kp + c * 8);
#pragma unroll
        for (int j = 0; j < 4; ++j) { dot += q[c * 8 + 2 * j] * __uint_as_float(raw[j] << 16); dot += q[c * 8 + 2 * j + 1] * __uint_as_float(raw[j] & 0xffff0000u); } }
    const float s = dot * 0.125f + bias;
    const float mn = fmaxf(mx, s), corr = expf(mx - mn), pr = expf(s - mn);
    mx = mn; l = l * corr + pr;
#pragma unroll
    for (int c = 0; c < NV / 8; ++c) { const u32x4 raw = *(const u32x4*)(vp + c * 8);
#pragma unroll
        for (int j = 0; j < 4; ++j) { o[c * 8 + 2 * j] = o[c * 8 + 2 * j] * corr + pr * __uint_as_float(raw[j] << 16); o[c * 8 + 2 * j + 1] = o[c * 8 + 2 * j + 1] * corr + pr * __uint_as_float(raw[j] & 0xffff0000u); } }
}
DI void load_q64(float (&q)[64], const bf16_t* qp) {
#pragma unroll
    for (int c = 0; c < 8; ++c) { const u32x4 raw = *(const u32x4*)(qp + c * 8);
#pragma unroll
        for (int j = 0; j < 4; ++j) { q[c * 8 + 2 * j] = __uint_as_float(raw[j] << 16); q[c * 8 + 2 * j + 1] = __uint_as_float(raw[j] & 0xffff0000u); } }
}
DI void phase_na_naive(const P& p) {
    const bf16_t* QKV = (const bf16_t*)(p.ws + WS_H); bf16_t* A = (bf16_t*)(p.ws + WS_A); const float* rpb = p.in[10];
    for (int idx = blockIdx.x * NTHR + otid(); idx < MT * 8; idx += gridDim.x * NTHR) {
        const int head = idx & 7, m = idx >> 3;
        float q[64], o[64]; float mx = -1e30f, l = 0.f;
        load_q64(q, QKV + (size_t)m * LD0 + C_NQ + head * 64);
#pragma unroll
        for (int d = 0; d < 64; ++d) o[d] = 0.f;
        int b;
        if (m < MX) {
            b = m >> 11; const int t = m & 2047, r = t >> 6, c = t & 63;
            const int rs = min(max(r - 4, 0), 24), cs = min(max(c - 8, 0), 48);
#pragma unroll 1
            for (int i = 0; i < 8; ++i)
#pragma unroll 1
                for (int w = 0; w < 16; ++w) { const int rr = rs + i, ww = cs + w; const size_t mk = (size_t)b * 2048 + rr * 64 + ww;
                    const float bias = rpb[(head * 15 + (rr - r + 7)) * 31 + (ww - c + 15)];
                    att_step<64>(q, QKV + mk * LD0 + C_NK + head * 64, QKV + mk * LD0 + C_NV + head * 64, bias, mx, l, o); }
        } else b = (m - MX) >> 8;
#pragma unroll 1
        for (int lk = 0; lk < 256; ++lk) { const size_t mk = (size_t)MX + b * 256 + lk;
            att_step<64>(q, QKV + mk * LD0 + C_NK + head * 64, QKV + mk * LD0 + C_NV + head * 64, 0.f, mx, l, o); }
        const float il = 1.f / l; bf16_t* op = A + (size_t)m * DM + head * 64;
#pragma unroll
        for (int d = 0; d < 64; d += 2) *(unsigned*)(op + d) = pk2(o[d] * il, o[d + 1] * il);
    }
}
DI void phase_gla_naive(const P& p, float* lds) {
    float* sq = lds; float* sk = lds + 4096; float* sa = lds + 8192; float* sv = lds + 12288;
    const bf16_t* QKV = (const bf16_t*)(p.ws + WS_H);
    const int tid = otid();
    for (int chain = blockIdx.x; chain < 64; chain += gridDim.x) {
        const int dir = chain & 1, h = (chain >> 1) & 3, b = chain >> 3;
        const float* wg = p.in[dir ? 13 : 11]; const float* bg = p.in[dir ? 14 : 12];
        bf16_t* O = (bf16_t*)(p.ws + (dir ? WS_OB : WS_OF));
        const int zoff = dir ? C_ZB : C_ZF;
        float S[64];
#pragma unroll
        for (int d = 0; d < 64; ++d) S[d] = 0.f;
        for (int seg = 0; seg < 2; ++seg) {
            const int base = seg == 0 ? MX + b * 256 : b * 2048, n = seg == 0 ? 256 : 2048;
            for (int c = 0; c < n / 64; ++c) {
                for (int idx = tid; idx < 4096; idx += NTHR) { const int i = idx >> 6, d = idx & 63, tp = c * 64 + i, t = dir ? n - 1 - tp : tp;
                    const bf16_t* rowp = QKV + (size_t)(base + t) * LD0;
                    sq[idx] = bf2f(rowp[C_GQ + h * 64 + d]) * 0.125f; sk[idx] = bf2f(rowp[C_GK + h * 64 + d]);
                    float z = bg[h * 64 + d];
#pragma unroll
                    for (int r = 0; r < 16; ++r) z += bf2f(rowp[zoff + r]) * wg[r * 256 + h * 64 + d];
                    const float ls = fminf(z, 0.f) - log1pf(expf(-fabsf(z)));
                    sa[idx] = expf(ls * (1.f / 16.f)); }
                for (int idx = tid; idx < 8192; idx += NTHR) { const int i = idx >> 7, e = idx & 127, tp = c * 64 + i, t = dir ? n - 1 - tp : tp;
                    sv[idx] = bf2f(QKV[(size_t)(base + t) * LD0 + C_GV + h * 128 + e]); }
                __syncthreads();
                if (tid < 128) {
                    const int e = tid;
#pragma unroll 1
                    for (int i = 0; i < 64; ++i) { const float ve = sv[i * 128 + e]; float o = 0.f;
#pragma unroll
                        for (int d = 0; d < 64; ++d) { float sd = sa[i * 64 + d] * S[d];
                            if (dir == 0) { sd += sk[i * 64 + d] * ve; o += sq[i * 64 + d] * sd; } else { o += sq[i * 64 + d] * sd; sd += sk[i * 64 + d] * ve; }
                            S[d] = sd; }
                        const int tp = c * 64 + i, t = dir ? n - 1 - tp : tp;
                        O[(size_t)(base + t) * 512 + h * 128 + e] = f2bf(o); }
                }
                __syncthreads();
            }
        }
    }
}
DI void phase_gla_finalize(const P& p) {
    const int tid = otid(), lane = tid & 63, w = tid >> 6;
    const int gw = blockIdx.x * 8 + w, NGW = gridDim.x * 8;
    const bf16_t* QKV = (const bf16_t*)(p.ws + WS_H); bf16_t* A = (bf16_t*)(p.ws + WS_A);
    const bf16_t* OF = (const bf16_t*)(p.ws + WS_OF); const bf16_t* OB = (const bf16_t*)(p.ws + WS_OB); const float* ng = p.in[15];
    for (int m = gw; m < MT; m += NGW) {
        const u32x4 rf = *(const u32x4*)(OF + (size_t)m * 512 + lane * 8), rb = *(const u32x4*)(OB + (size_t)m * 512 + lane * 8), rg = *(const u32x4*)(QKV + (size_t)m * LD0 + C_GR + lane * 8);
        float s[8], g[8]; float ss = 0.f;
#pragma unroll
        for (int j = 0; j < 4; ++j) { s[2 * j] = __uint_as_float(rf[j] << 16) + __uint_as_float(rb[j] << 16); s[2 * j + 1] = __uint_as_float(rf[j] & 0xffff0000u) + __uint_as_float(rb[j] & 0xffff0000u);
            g[2 * j] = __uint_as_float(rg[j] << 16); g[2 * j + 1] = __uint_as_float(rg[j] & 0xffff0000u); }
#pragma unroll
        for (int j = 0; j < 8; ++j) ss += s[j] * s[j];
        ss += __shfl_xor(ss, 1); ss += __shfl_xor(ss, 2); ss += __shfl_xor(ss, 4); ss += __shfl_xor(ss, 8);
        const float rms = 1.0f / sqrtf(ss * (1.f / 128.f) + LN_EPS);
        float o[8];
#pragma unroll
        for (int j = 0; j < 8; ++j) o[j] = s[j] * rms * ng[(lane & 15) * 8 + j] * silu_f(g[j]);
        u32x4 ov; ov.x = pk2(o[0], o[1]); ov.y = pk2(o[2], o[3]); ov.z = pk2(o[4], o[5]); ov.w = pk2(o[6], o[7]);
        *(u32x4*)(A + (size_t)m * DM + 512 + lane * 8) = ov;
    }
}
DI void phase_rope_naive(const P& p) {
    bf16_t* QKV = (bf16_t*)(p.ws + WS_H); const float* T = (const float*)(p.ws + WS_ROPE);
    for (size_t idx = (size_t)blockIdx.x * NTHR + otid(); idx < (size_t)MX * 1024; idx += (size_t)gridDim.x * NTHR) {
        const int m = (int)(idx >> 10), pi = (int)(idx & 1023), blk = pi >> 5, j = pi & 31, t = m & 2047;
        const int d0 = j < 16 ? j : 32 + (j - 16);
        const float c = T[(t * 32 + j) * 2], s = T[(t * 32 + j) * 2 + 1];
        bf16_t* u = QKV + (size_t)m * LD1 + blk * 64 + d0;
        const float u0 = bf2f(u[0]), u1 = bf2f(u[16]);
        u[0] = f2bf(u0 * c - u1 * s); u[16] = f2bf(u1 * c + u0 * s);
    }
}
DI void phase_diff_naive(const P& p) {
    const bf16_t* QKV = (const bf16_t*)(p.ws + WS_H); bf16_t* A = (bf16_t*)(p.ws + WS_A);
    float d1 = 0.f, d2 = 0.f;
    for (int i = 0; i < 64; ++i) { d1 += p.in[24][i] * p.in[25][i]; d2 += p.in[26][i] * p.in[27][i]; }
    const float lam = expf(d1) - expf(d2) + LAMBDA_INIT;
    const float* sg = p.in[28];
    for (int idx = blockIdx.x * NTHR + otid(); idx < MX * 32; idx += gridDim.x * NTHR) {
        const int quarter = idx & 3, head = (idx >> 2) & 7, m = idx >> 5, b = m >> 11;
        float res[32];
#pragma unroll 1
        for (int br = 0; br < 2; ++br) {
            float q[64], o[32]; float mx = -1e30f, l = 0.f;
            load_q64(q, QKV + (size_t)m * LD1 + head * 128 + br * 64);
#pragma unroll
            for (int e = 0; e < 32; ++e) o[e] = 0.f;
#pragma unroll 1
            for (int key = 0; key < 2304; ++key) { const size_t mk = key < 2048 ? (size_t)b * 2048 + key : (size_t)MX + b * 256 + (key - 2048);
                att_step<32>(q, QKV + mk * LD1 + 1024 + head * 128 + br * 64, QKV + mk * LD1 + 2048 + head * 128 + quarter * 32, 0.f, mx, l, o); }
            const float il = 1.f / l;
            if (br == 0) {
#pragma unroll
                for (int e = 0; e < 32; ++e) res[e] = o[e] * il;
            } else {
#pragma unroll
                for (int e = 0; e < 32; ++e) res[e] -= lam * o[e] * il;
            }
        }
        float ss = 0.f;
#pragma unroll
        for (int e = 0; e < 32; ++e) ss += res[e] * res[e];
        ss += __shfl_xor(ss, 1); ss += __shfl_xor(ss, 2);
        const float rms = 1.0f / sqrtf(ss * (1.f / 128.f) + LN_EPS);
        bf16_t* op = A + (size_t)m * DM + head * 128 + quarter * 32;
#pragma unroll
        for (int e = 0; e < 32; e += 2) *(unsigned*)(op + e) = pk2(res[e] * rms * sg[quarter * 32 + e] * (1.f - LAMBDA_INIT), res[e + 1] * rms * sg[quarter * 32 + e + 1] * (1.f - LAMBDA_INIT));
    }
}

__global__ void __launch_bounds__(NTHR) mk_fwd(P p) {
    extern __shared__ __attribute__((aligned(16))) unsigned char lds_raw[];
    float* lds = (float*)lds_raw;
    cg::grid_group grid = cg::this_grid();
    int ph = 0;
#define RUN(...) do { if (ph >= p.ph_lo && ph < p.ph_hi) { __VA_ARGS__; if (ph + 1 < p.ph_hi) grid.sync(); } ++ph; } while (0)
    bf16_t* A = (bf16_t*)(p.ws + WS_A); bf16_t* H = (bf16_t*)(p.ws + WS_H);

    RUN({ phase_adaln(p, lds); phase_rope_table(p); phase_convert(p, lds); });
    RUN(phase_rowpass(p, false, 0, false, true, 0, 0, 1, MT));
#pragma unroll 1
    for (int l = 0; l < 2; ++l) {
        RUN({ EpiSwiglu e{H}; naive_gemm(A, wt_ptr(p, l, WT_F1I), MT, 2 * DFF, DM, e, lds); });
        RUN({ EpiResid e{&p, l == 0 ? 0 : 1, l, 2, 0.5f}; naive_gemm(H, wt_ptr(p, l, WT_F1O), MT, DM, DFF, e, lds); });
        RUN(phase_rowpass(p, true, 1, true, true, l, 3, 4, MT));
        if (l == 0) {
            RUN({ EpiStore e{H, LD0}; naive_gemm(A, wt_ptr(p, l, WT_MI), MT, LD0, DM, e, lds); });
            RUN({ phase_gla_naive(p, lds); phase_na_naive(p); });
            RUN(phase_gla_finalize(p));
        } else {
            RUN({ EpiStore e{H, LD1}; naive_gemm(A, wt_ptr(p, l, WT_MI), MT, LD1, DM, e, lds); });
            RUN(phase_rope_naive(p));
            RUN(phase_diff_naive(p));
        }
        const int Mrows = l == 0 ? MT : MX;
        RUN({ EpiResid e{&p, 1, l, 5, 1.0f}; naive_gemm(A, wt_ptr(p, l, WT_MO), Mrows, DM, DM, e, lds); });
        RUN(phase_rowpass(p, true, 1, true, true, l, 6, 7, Mrows));
        RUN({ EpiSwiglu e{H}; naive_gemm(A, wt_ptr(p, l, WT_F2I), Mrows, 2 * DFF, DM, e, lds); });
        RUN({ EpiResid e{&p, 1, l, 8, 0.5f}; naive_gemm(H, wt_ptr(p, l, WT_F2O), Mrows, DM, DFF, e, lds); });
        RUN(phase_rowpass(p, true, 1, true, l == 0, 1, 0, 1, Mrows));
    }
#undef RUN
}

extern "C" void kernel_launch(void* const* d_in, const int* in_sizes, int n_in, void* d_out, int out_size, void* d_ws, size_t ws_size, hipStream_t stream) {
    static int grid = 0;
    if (grid == 0) {
        if (n_in != 31 || out_size != MX * DM || ws_size < WS_END) { fprintf(stderr, "kernel_launch: unexpected shapes (n_in %d out %d ws %zu)\n", n_in, out_size, ws_size); grid = -1; return; }
        int dev = 0, cus = 0, per_cu = 0;
        hipGetDevice(&dev); hipDeviceGetAttribute(&cus, hipDeviceAttributeMultiprocessorCount, dev);
        hipFuncSetAttribute((const void*)mk_fwd, hipFuncAttributeMaxDynamicSharedMemorySize, LDS_BYTES);
        hipOccupancyMaxActiveBlocksPerMultiprocessor(&per_cu, (const void*)mk_fwd, NTHR, LDS_BYTES);
        if (per_cu < 1) { fprintf(stderr, "kernel_launch: occupancy query says %d blocks per CU\n", per_cu); grid = -1; return; }
        grid = cus;
    }
    if (grid < 0) return;
    P p{};
    for (int i = 0; i < 31; ++i) p.in[i] = (const float*)d_in[i];
    p.out = (float*)d_out; p.ws = (unsigned char*)d_ws; p.ph_lo = 0; p.ph_hi = 1000;
    void* args[] = {&p};
    hipError_t e = hipLaunchCooperativeKernel((const void*)mk_fwd, dim3(grid), dim3(NTHR), args, LDS_BYTES, stream);
    if (e != hipSuccess) fprintf(stderr, "cooperative launch failed: %s (grid %d)\n", hipGetErrorString(e), grid);
}
```

```cpp
#include <hip/hip_runtime.h>
#include <hip/hip_cooperative_groups.h>
#include <cstdio>
#include <cstdint>
namespace cg = cooperative_groups;

typedef unsigned short bf16_t;
typedef float f32x4 __attribute__((ext_vector_type(4)));
typedef unsigned u32x4 __attribute__((ext_vector_type(4)));
typedef unsigned u32x2 __attribute__((ext_vector_type(2)));
#define DI __device__ __forceinline__

constexpr int NB = 8, SEQ = 2048, CTXL = 256, DM = 1024, DFF = 2816;
constexpr int MX = NB * SEQ, MH = NB * CTXL, MT = MX + MH;
constexpr float ALPHA = 1.41421356237309515f;
constexpr float LN_EPS = 1e-6f;
constexpr float LAMBDA_INIT = 0.35550906759f;
constexpr int NTHR = 512;

constexpr int LD0 = 3328, C_NQ = 0, C_NK = 512, C_NV = 1024, C_GQ = 1536, C_GK = 1792, C_GV = 2048, C_GR = 2560, C_ZF = 3072, C_ZB = 3088;
constexpr int LD1 = 3072;

constexpr size_t MiB = 1u << 20;
constexpr size_t WS_MOD = 0;
constexpr size_t WS_ROPE = 1 * MiB;
constexpr size_t WS_XH = 2 * MiB;
constexpr size_t WS_WT = 10 * MiB;
constexpr size_t WT_LAYER = 42 * MiB;
constexpr size_t WT_F1I = 0, WT_F1O = 11 * MiB, WT_MI = 16 * MiB + MiB / 2, WT_MO = 23 * MiB, WT_F2I = 25 * MiB, WT_F2O = 36 * MiB;
constexpr size_t WS_A = 94 * MiB;
constexpr size_t WS_H = 130 * MiB;
constexpr size_t WS_OF = 247 * MiB;
constexpr size_t WS_OB = 265 * MiB;
constexpr size_t WS_END = 283 * MiB;

constexpr int LDS_BYTES = 147456;

struct P { const float* in[31]; float* out; unsigned char* ws; int ph_lo, ph_hi; };

DI float bf2f(bf16_t h) { return __uint_as_float(((unsigned)h) << 16); }
DI bf16_t f2bf(float f) { unsigned u = __float_as_uint(f); return (bf16_t)((u + 0x7fffu + ((u >> 16) & 1u)) >> 16); }
DI unsigned pk2(float lo, float hi) { return (unsigned)f2bf(lo) | ((unsigned)f2bf(hi) << 16); }
DI float silu_f(float v) { return v / (1.f + expf(-v)); }
DI float wave_sum(float v) {
#pragma unroll
    for (int o = 1; o < 64; o <<= 1) v += __shfl_xor(v, o);
    return v;
}
DI int otid() { int t = threadIdx.x; asm volatile("" : "+v"(t)); return t; }
DI float* xres_ptr(const P& p, int m) { return m < MX ? p.out + (size_t)m * DM : (float*)(p.ws + WS_XH) + (size_t)(m - MX) * DM; }
DI const float* xin_ptr(const P& p, int m) { return m < MX ? p.in[0] + (size_t)m * DM : p.in[2] + (size_t)(m - MX) * DM; }
DI int modrow(int m) { return m < MX ? (m >> 11) : 8; }
DI const float* mod_ptr(const P& p, int l, int r, int chunk) { return (const float*)(p.ws + WS_MOD) + ((size_t)(l * 9 + r) * 9 + chunk) * DM; }
DI bf16_t* wt_ptr(const P& p, int l, size_t off) { return (bf16_t*)(p.ws + WS_WT + (size_t)l * WT_LAYER + off); }

DI void phase_adaln(const P& p, float* lds) {
    float* sc = lds; float* red = lds + 9 * 1024;
    const int tid = otid(), lane = tid & 63, w = tid >> 6;
    for (int i = tid; i < 9 * 1024; i += NTHR) { const int r = i >> 10, k = i & 1023; const float v = r < 8 ? p.in[1][r * 1024 + k] : p.in[3][k]; sc[i] = silu_f(v); }
    __syncthreads();
    for (int item = blockIdx.x; item < 288; item += gridDim.x) {
        const int l = item / 144, cb = item % 144, n = cb * 64 + lane;
        const float* W = p.in[l ? 18 : 4]; const float* bb = p.in[l ? 19 : 5];
        float acc[9];
#pragma unroll
        for (int r = 0; r < 9; ++r) acc[r] = 0.f;
#pragma unroll 4
        for (int k = w * 128; k < w * 128 + 128; ++k) { const float wv = W[(size_t)k * 9216 + n];
#pragma unroll
            for (int r = 0; r < 9; ++r) acc[r] += sc[r * 1024 + k] * wv; }
#pragma unroll
        for (int r = 0; r < 9; ++r) red[(w * 9 + r) * 64 + lane] = acc[r];
        __syncthreads();
        float* MOD = (float*)(p.ws + WS_MOD);
        for (int o = tid; o < 576; o += NTHR) { const int r = o >> 6, c = o & 63; float s = bb[cb * 64 + c];
#pragma unroll
            for (int w2 = 0; w2 < 8; ++w2) s += red[(w2 * 9 + r) * 64 + c];
            MOD[(size_t)(l * 9 + r) * 9216 + cb * 64 + c] = s; }
        __syncthreads();
    }
}
DI void phase_rope_table(const P& p) {
    float* T = (float*)(p.ws + WS_ROPE);
    for (int idx = blockIdx.x * NTHR + otid(); idx < 2048 * 32; idx += gridDim.x * NTHR) {
        const int t = idx >> 5, j = idx & 31, fi = j & 15; const float pos = (float)(j < 16 ? (t >> 6) : (t & 63));
        const float inv = powf(10000.f, -(float)(2 * fi) / 32.f); const float ang = pos * inv;
        T[idx * 2] = cosf(ang); T[idx * 2 + 1] = sinf(ang);
    }
}
DI void conv_item(const float* W, int K, int Nsrc, int src0, bf16_t* WT, int n0dst, int k0, float* scr, int lane) {
    if (src0 >= 0) {
#pragma unroll 8
        for (int i = 0; i < 32; ++i) { const int kk = 2 * i + (lane >> 5); scr[kk * 33 + (lane & 31)] = W[(size_t)(k0 + kk) * Nsrc + src0 + (lane & 31)]; }
    } else {
#pragma unroll 8
        for (int i = 0; i < 32; ++i) { const int kk = 2 * i + (lane >> 5); scr[kk * 33 + (lane & 31)] = 0.f; }
    }
    asm volatile("s_waitcnt lgkmcnt(0)" ::: "memory");
    const int c = lane & 7;
#pragma unroll
    for (int j = 0; j < 4; ++j) { const int n = (lane >> 3) + 8 * j; const float* s = scr + (8 * c) * 33 + n;
        u32x4 o; o.x = pk2(s[0 * 33], s[1 * 33]); o.y = pk2(s[2 * 33], s[3 * 33]); o.z = pk2(s[4 * 33], s[5 * 33]); o.w = pk2(s[6 * 33], s[7 * 33]);
        *(u32x4*)(WT + (size_t)(n0dst + n) * K + k0 + 8 * c) = o; }
    asm volatile("s_waitcnt lgkmcnt(0)" ::: "memory");
}
DI void conv_matrix_item(const float* W, int K, int Nsrc, int Ndst, int kind, bf16_t* WT, int item, float* scr, int lane) {
    const int nblk = Ndst / 32, kb = item / nblk, nb = item % nblk, n0 = nb * 32;
    int src0;
    if (kind == 1) { const int t = n0 >> 8, j = n0 & 255; src0 = j < 128 ? 128 * t + j : DFF + 128 * t + (j - 128); }
    else src0 = n0 < Nsrc ? n0 : -1;
    conv_item(W, K, Nsrc, src0, WT, n0, kb * 64, scr, lane);
}
DI void phase_convert(const P& p, float* lds) {
    const int tid = otid(), lane = tid & 63, w = tid >> 6;
    float* scr = lds + w * (64 * 33 + 16);
    const int gw = blockIdx.x * 8 + w, NGW = gridDim.x * 8;
    for (int l = 0; l < 2; ++l) {
        const int b = l ? 18 : 4;
        const int nmi = l ? 3072 : 3104, nmid = l ? 3072 : 3328;
        const int i0 = 16 * 176, i1 = 44 * 32, i2 = 16 * (nmid / 32), i3 = 16 * 32;
        const int total = i0 + i1 + i2 + i3 + i0 + i1;
        for (int it = gw; it < total; it += NGW) {
            int r = it;
            if (r < i0) { conv_matrix_item(p.in[b + 2], 1024, 5632, 5632, 1, wt_ptr(p, l, WT_F1I), r, scr, lane); continue; } r -= i0;
            if (r < i1) { conv_matrix_item(p.in[b + 3], 2816, 1024, 1024, 0, wt_ptr(p, l, WT_F1O), r, scr, lane); continue; } r -= i1;
            if (r < i2) { conv_matrix_item(p.in[b + 4], 1024, nmi, nmid, 0, wt_ptr(p, l, WT_MI), r, scr, lane); continue; } r -= i2;
            if (r < i3) { conv_matrix_item(p.in[b + 5], 1024, 1024, 1024, 0, wt_ptr(p, l, WT_MO), r, scr, lane); continue; } r -= i3;
            const int f2 = l ? 29 : 16;
            if (r < i0) { conv_matrix_item(p.in[f2], 1024, 5632, 5632, 1, wt_ptr(p, l, WT_F2I), r, scr, lane); continue; } r -= i0;
            conv_matrix_item(p.in[f2 + 1], 2816, 1024, 1024, 0, wt_ptr(p, l, WT_F2O), r, scr, lane);
        }
    }
}

DI void phase_rowpass(const P& p, bool do_ln, int src_mode, bool write_x, bool write_a, int l_mod, int ch_shift, int ch_scale, int M) {
    const int tid = otid(), lane = tid & 63, w = tid >> 6;
    const int gw = blockIdx.x * 8 + w, NGW = gridDim.x * 8;
    bf16_t* A = (bf16_t*)(p.ws + WS_A);
    for (int m = gw; m < M; m += NGW) {
        const f32x4* src = (const f32x4*)(src_mode == 0 ? xin_ptr(p, m) : (const float*)xres_ptr(p, m)) + lane;
        f32x4 v[4]; float s = 0.f;
#pragma unroll
        for (int j = 0; j < 4; ++j) { v[j] = src[64 * j]; s += (v[j].x + v[j].y) + (v[j].z + v[j].w); }
        if (do_ln) {
            const float mean = wave_sum(s) * (1.f / DM); float s2 = 0.f;
#pragma unroll
            for (int j = 0; j < 4; ++j) { v[j] = v[j] - mean; s2 += (v[j].x * v[j].x + v[j].y * v[j].y) + (v[j].z * v[j].z + v[j].w * v[j].w); }
            const float rstd = 1.0f / sqrtf(wave_sum(s2) * (1.f / DM) + LN_EPS);
#pragma unroll
            for (int j = 0; j < 4; ++j) v[j] = v[j] * rstd;
        }
        if (write_x) { f32x4* dst = (f32x4*)xres_ptr(p, m) + lane;
#pragma unroll
            for (int j = 0; j < 4; ++j) dst[64 * j] = v[j]; }
        if (write_a) {
            const f32x4* sh = (const f32x4*)mod_ptr(p, l_mod, modrow(m), ch_shift) + lane; const f32x4* scp = (const f32x4*)mod_ptr(p, l_mod, modrow(m), ch_scale) + lane;
            u32x2* o8 = (u32x2*)(A + (size_t)m * DM) + lane;
#pragma unroll
            for (int j = 0; j < 4; ++j) { const f32x4 a = v[j] * (scp[64 * j] + 1.0f) + sh[64 * j]; u32x2 o; o.x = pk2(a.x, a.y); o.y = pk2(a.z, a.w); o8[64 * j] = o; }
        }
    }
}

template <class Epi>
DI void naive_gemm(const bf16_t* A, const bf16_t* Wt, int M, int N, int K, const Epi& epi, float* lds) {
    float* sA = lds; float* sB = lds + 32 * 132;
    const int tid = otid(), tx = tid & 31, ty = tid >> 5;
    const int ntn = N / 256, ntm = M / 128, ntiles = ntm * ntn;
    for (int tile = blockIdx.x; tile < ntiles; tile += gridDim.x) {
        const int tn = tile % ntn, tm = tile / ntn, m0 = tm * 128, n0 = tn * 256;
        float acc[8][8];
#pragma unroll
        for (int i = 0; i < 8; ++i)
#pragma unroll
            for (int j = 0; j < 8; ++j) acc[i][j] = 0.f;
        for (int k0 = 0; k0 < K; k0 += 32) {
            const int row = tid >> 2, kc = (tid & 3) * 8;
            { const u32x4 raw = *(const u32x4*)(A + (size_t)(m0 + row) * K + k0 + kc);
#pragma unroll
              for (int j = 0; j < 4; ++j) { sA[(kc + 2 * j) * 132 + row] = __uint_as_float(raw[j] << 16); sA[(kc + 2 * j + 1) * 132 + row] = __uint_as_float(raw[j] & 0xffff0000u); } }
#pragma unroll
            for (int h = 0; h < 2; ++h) { const int rb = row + 128 * h; const u32x4 raw = *(const u32x4*)(Wt + (size_t)(n0 + rb) * K + k0 + kc);
#pragma unroll
              for (int j = 0; j < 4; ++j) { sB[(kc + 2 * j) * 264 + rb] = __uint_as_float(raw[j] << 16); sB[(kc + 2 * j + 1) * 264 + rb] = __uint_as_float(raw[j] & 0xffff0000u); } }
            __syncthreads();
#pragma unroll 4
            for (int kk = 0; kk < 32; ++kk) {
                const f32x4 a0 = *(const f32x4*)&sA[kk * 132 + ty * 8], a1 = *(const f32x4*)&sA[kk * 132 + ty * 8 + 4];
                const f32x4 b0 = *(const f32x4*)&sB[kk * 264 + tx * 4], b1 = *(const f32x4*)&sB[kk * 264 + 128 + tx * 4];
                const float a[8] = {a0.x, a0.y, a0.z, a0.w, a1.x, a1.y, a1.z, a1.w}; const float b[8] = {b0.x, b0.y, b0.z, b0.w, b1.x, b1.y, b1.z, b1.w};
#pragma unroll
                for (int i = 0; i < 8; ++i)
#pragma unroll
                    for (int j = 0; j < 8; ++j) acc[i][j] += a[i] * b[j];
            }
            __syncthreads();
        }
#pragma unroll
        for (int i = 0; i < 8; ++i)
#pragma unroll
            for (int j = 0; j < 4; ++j) epi.pair(m0 + ty * 8 + i, tn, tx * 4 + j, acc[i][j], acc[i][4 + j]);
    }
}
struct EpiSwiglu { bf16_t* H; DI void pair(int m, int t, int c, float va, float vg) const { H[(size_t)m * DFF + t * 128 + c] = f2bf(silu_f(va) * vg); } };
struct EpiStore { bf16_t* O; int ld; DI void pair(int m, int t, int c, float va, float vg) const { O[(size_t)m * ld + t * 256 + c] = f2bf(va); O[(size_t)m * ld + t * 256 + 128 + c] = f2bf(vg); } };
struct EpiResid { const P* p; int src_mode, l, chunk; float scale;
    DI void one(int m, int n, float v) const { const float* res = src_mode ? (const float*)xres_ptr(*p, m) : xin_ptr(*p, m); const float g = mod_ptr(*p, l, modrow(m), chunk)[n]; xres_ptr(*p, m)[n] = ALPHA * res[n] + g * scale * v; }
    DI void pair(int m, int t, int c, float va, float vg) const { one(m, t * 256 + c, va); one(m, t * 256 + 128 + c, vg); } };

namespace pg8 {
#define PG8_LAS __attribute__((address_space(3)))
typedef unsigned short bf16_t;
typedef short bf16x8 __attribute__((ext_vector_type(8)));
typedef float f32x4 __attribute__((ext_vector_type(4)));
typedef unsigned u32x4 __attribute__((ext_vector_type(4)));
constexpr int BM = 256, BK = 64, HALF = 128, HTB = HALF * BK * 2  , STAGE_BYTES = 8 * HTB, NXCD = 8, WGM = 8;

__host__ __device__ __forceinline__ int lds_byte(int r, int c) { const int st = (r >> 4) * 2 + (c >> 5), rr = r & 15, cc = c & 31, ob = rr * 64 + cc * 2; return st * 1024 + (ob ^ (((ob >> 9) & 1) << 5)); }
__host__ __device__ __forceinline__ void stage_rc(int b, int& R, int& C) { const int st = b / 1024, sb = b % 1024, swz = sb ^ (((sb >> 9) & 1) << 5); R = (st >> 1) * 16 + swz / 64; C = (st & 1) * 32 + (swz % 64) / 2; }
__host__ __device__ __forceinline__ int perm32(int rho) { const int n = rho >> 4, i = rho & 15; return 8 * (i >> 2) + 4 * n + (i & 3); }

struct Unit { int pm, pn; };
struct Gemm { const bf16_t* A; const bf16_t* Bt; int M, N, K; };

struct StaticOrder {
    int nM, nN, nwg, G, c;
    __host__ __device__ void init(int M, int N, int G_, int c_) { nM = M / BM; nN = N / BM; nwg = nM * nN; G = G_; c = c_; }
    __host__ __device__ bool next(int i, Unit& u) const {
        const long L = (long)i * G + c; if (L >= nwg) return false;
        int wgid = (int)L; { const int q = nwg / NXCD, r = nwg % NXCD, xcd = wgid % NXCD, off = wgid / NXCD; wgid = (xcd < r ? xcd * (q + 1) : r * (q + 1) + (xcd - r) * q) + off; }
        const int nig = WGM * nN, gid = wgid / nig, fm = gid * WGM, gsz = (nM - fm) < WGM ? (nM - fm) : WGM;
        u.pm = fm + ((wgid % nig) % gsz); u.pn = (wgid % nig) / gsz; return true;
    }
    __device__ __forceinline__ void a_ready(const Unit&) const {}
    __device__ __forceinline__ void done(const Unit&) const {}
};

__device__ __forceinline__ unsigned cvt_pk_bf16(float lo, float hi) { unsigned r; asm volatile("v_cvt_pk_bf16_f32 %0, %1, %2" : "=v"(r) : "v"(lo), "v"(hi)); return r; }
__device__ __forceinline__ float fast_silu(float a) { return a * __builtin_amdgcn_rcpf(1.0f + __builtin_amdgcn_exp2f(-1.4426950408889634f * a)); }
struct EpiSwigluF {
    static constexpr bool PERM = true, AFTER_DRAIN = false;
    bf16_t* H; int ldh;
    __device__ __forceinline__ void operator()(const f32x4 (&acc)[2][2][4][2], const Unit& u, int wr, int wc, int fr, int fq) const {
        const int row0 = u.pm * BM + wr * 64 + fr, col0 = u.pn * HALF + wc * 32 + 8 * fq;
#pragma unroll
        for (int ai = 0; ai < 2; ++ai)
#pragma unroll
            for (int m = 0; m < 4; ++m) { bf16_t* rowp = H + (size_t)(row0 + ai * HALF + m * 16) * ldh + col0;
                const f32x4 a0 = acc[ai][0][m][0], a1 = acc[ai][0][m][1], g0 = acc[ai][1][m][0], g1 = acc[ai][1][m][1];
                u32x4 w; w.x = cvt_pk_bf16(fast_silu(a0[0]) * g0[0], fast_silu(a0[1]) * g0[1]); w.y = cvt_pk_bf16(fast_silu(a0[2]) * g0[2], fast_silu(a0[3]) * g0[3]);
                w.z = cvt_pk_bf16(fast_silu(a1[0]) * g1[0], fast_silu(a1[1]) * g1[1]); w.w = cvt_pk_bf16(fast_silu(a1[2]) * g1[2], fast_silu(a1[3]) * g1[3]);
                *(u32x4*)rowp = w; }
    }
};
struct EpiStoreF {
    static constexpr bool PERM = true, AFTER_DRAIN = false;
    bf16_t* O; int ld; const float* T; int rope_tiles, rope_rows;
    __device__ __forceinline__ void operator()(const f32x4 (&acc)[2][2][4][2], const Unit& u, int wr, int wc, int fr, int fq) const {
        const int row0 = u.pm * BM + wr * 64 + fr, col0 = u.pn * BM + wc * 32 + 8 * fq;
        const bool rope = (u.pn < rope_tiles) && (u.pm * BM < rope_rows);
        const int jt = (wc & 1) * 16 + ((8 * fq) & 15);
        const float sgn = fq < 2 ? -1.f : 1.f;
#pragma unroll
        for (int ai = 0; ai < 2; ++ai)
#pragma unroll
            for (int m = 0; m < 4; ++m) { const int row = row0 + ai * HALF + m * 16; bf16_t* rowp = O + (size_t)row * ld + col0;
#pragma unroll
                for (int bj = 0; bj < 2; ++bj) { f32x4 v0 = acc[ai][bj][m][0], v1 = acc[ai][bj][m][1];
                    if (rope) {
                        const f32x4* tp = (const f32x4*)(T + ((size_t)(row & 2047) * 32 + jt) * 2);
                        const f32x4 t0 = tp[0], t1 = tp[1], t2 = tp[2], t3 = tp[3];
                        f32x4 p0, p1;
#pragma unroll
                        for (int j = 0; j < 4; ++j) { p0[j] = __shfl_xor(v0[j], 32); p1[j] = __shfl_xor(v1[j], 32); }
                        v0 = (f32x4){v0[0] * t0[0] + sgn * p0[0] * t0[1], v0[1] * t0[2] + sgn * p0[1] * t0[3], v0[2] * t1[0] + sgn * p0[2] * t1[1], v0[3] * t1[2] + sgn * p0[3] * t1[3]};
                        v1 = (f32x4){v1[0] * t2[0] + sgn * p1[0] * t2[1], v1[1] * t2[2] + sgn * p1[1] * t2[3], v1[2] * t3[0] + sgn * p1[2] * t3[1], v1[3] * t3[2] + sgn * p1[3] * t3[3]};
                    }
                    u32x4 w; w.x = cvt_pk_bf16(v0[0], v0[1]); w.y = cvt_pk_bf16(v0[2], v0[3]); w.z = cvt_pk_bf16(v1[0], v1[1]); w.w = cvt_pk_bf16(v1[2], v1[3]);
                    *(u32x4*)(rowp + bj * HALF) = w; } }
    }
};
struct EpiResidF {
    static constexpr bool PERM = false, AFTER_DRAIN = false;
    const float* xi; const float* hi; float* xo; float* ho; const float* gx; const float* gh; float scale, alpha;
    __device__ __forceinline__ void operator()(const f32x4 (&acc)[2][2][4][2], const Unit& u, int wr, int wc, int fr, int fq) const {
        const bool lat = u.pm < 64;
        const int rowt = (lat ? u.pm : u.pm - 64) * BM + wr * 64 + fr, col0 = u.pn * BM + wc * 32 + 4 * fq;
        const float* ri = lat ? xi : hi; float* ro = lat ? xo : ho; const float* g = lat ? gx + (size_t)9216 * (u.pm >> 3) : gh;
        f32x4 gv[2][2];
#pragma unroll
        for (int bj = 0; bj < 2; ++bj)
#pragma unroll
            for (int n = 0; n < 2; ++n) gv[bj][n] = *(const f32x4*)(g + col0 + bj * HALF + n * 16) * scale;
#pragma unroll
        for (int ai = 0; ai < 2; ++ai)
#pragma unroll
            for (int m = 0; m < 4; ++m) { const size_t off = (size_t)(rowt + ai * HALF + m * 16) * 1024 + col0;
#pragma unroll
                for (int bj = 0; bj < 2; ++bj)
#pragma unroll
                    for (int n = 0; n < 2; ++n) { const f32x4 r = *(const f32x4*)(ri + off + bj * HALF + n * 16);
                        *(f32x4*)(ro + off + bj * HALF + n * 16) = r * alpha + gv[bj][n] * acc[ai][bj][m][n]; } }
    }
};

template <class Epi, class Sched, bool ALIGN_EPI = false, bool SP2 = false>
__device__ __forceinline__ void gemm_phase(PG8_LAS unsigned char* lds, const Gemm g, const Sched& S, const Epi& E) {
    const int tid = otid(), wid = __builtin_amdgcn_readfirstlane(tid >> 6), lane = tid & 63, wr = wid >> 2, wc = wid & 3, fr = lane & 15, fq = lane >> 4;
    const int K = g.K, nt = K / BK;
    unsigned voffA[2], voffB[2];
#pragma unroll
    for (int i = 0; i < 2; ++i) { int R, C; stage_rc(tid * 16 + i * 8192, R, C); const int Rb = Epi::PERM ? ((R & ~31) + perm32(R & 31)) : R;
        voffA[i] = (unsigned)(R * K + C) * 2u; voffB[i] = (unsigned)(Rb * K + C) * 2u; }
    const size_t kstep = (size_t)(BK * 2);
    const size_t hstep = (size_t)HALF * K * 2;
    const size_t tstep = 2 * hstep;
    const unsigned ldsw = (unsigned)wid * 1024u;
    const int aoff = lds_byte(wr * 64 + fr, fq * 8), boff = lds_byte(wc * 32 + fr, fq * 8);
#define PG8_SA(b, h) (((b) * 2 + (h)) * HTB)
#define PG8_SB(b, h) ((4 + (b) * 2 + (h)) * HTB)
#define PG8_STAGE(bufoff, gbase, voff) do { _Pragma("unroll") for (int _i = 0; _i < 2; ++_i) \
        __builtin_amdgcn_global_load_lds((const unsigned*)((const char*)(gbase) + (voff)[_i]), (PG8_LAS unsigned*)(lds + (bufoff) + ldsw + _i * 8192), 16, 0, 0); } while (0)
#define PG8_LDA(dst, b, h) do { _Pragma("unroll") for (int m = 0; m < 4; ++m) _Pragma("unroll") for (int k = 0; k < 2; ++k) dst[m][k] = *(const PG8_LAS bf16x8*)(lds + PG8_SA(b, h) + aoff + m * 2048 + k * 1024); } while (0)
#define PG8_LDB(dst, b, h) do { _Pragma("unroll") for (int n = 0; n < 2; ++n) _Pragma("unroll") for (int k = 0; k < 2; ++k) dst[n][k] = *(const PG8_LAS bf16x8*)(lds + PG8_SB(b, h) + boff + n * 2048 + k * 1024); } while (0)
#define PG8_MMA(ai, bj, At, Bt) do { __builtin_amdgcn_s_setprio(1); _Pragma("unroll") for (int m = 0; m < 4; ++m) _Pragma("unroll") for (int n = 0; n < 2; ++n) _Pragma("unroll") for (int k = 0; k < 2; ++k) \
        acc[ai][bj][m][n] = __builtin_amdgcn_mfma_f32_16x16x32_bf16(Bt[n][k], At[m][k], acc[ai][bj][m][n], 0, 0, 0); __builtin_amdgcn_s_setprio(0); } while (0)
#define PG8_WAIT_V(n) asm volatile("s_waitcnt vmcnt(" #n ")" ::: "memory")
#define PG8_WAIT_L(n) asm volatile("s_waitcnt lgkmcnt(" #n ")" ::: "memory")
#define PG8_BAR __builtin_amdgcn_s_barrier()
#define PG8_SCHED __builtin_amdgcn_sched_barrier(0)
    Unit cur, nxt; int ui = 0;
    if (!S.next(0, cur)) return;
    f32x4 acc[2][2][4][2];
#pragma unroll
    for (int a = 0; a < 2; ++a)
#pragma unroll
        for (int b = 0; b < 2; ++b)
#pragma unroll
            for (int m = 0; m < 4; ++m)
#pragma unroll
                for (int n = 0; n < 2; ++n) acc[a][b][m][n] = (f32x4){0.f, 0.f, 0.f, 0.f};
    bf16x8 At[4][2], B0[2][2], B1[2][2];
    const char* cA = (const char*)g.A + (size_t)cur.pm * tstep; const char* cB = (const char*)g.Bt + (size_t)cur.pn * tstep;
    S.a_ready(cur);
    if constexpr (SP2) {
        PG8_STAGE(PG8_SB(0, 0), cB, voffB); PG8_STAGE(PG8_SB(0, 1), cB + hstep, voffB); PG8_STAGE(PG8_SA(0, 0), cA, voffA); PG8_STAGE(PG8_SA(0, 1), cA + hstep, voffA);
        if (wr == 1) PG8_BAR;
        PG8_WAIT_V(2); PG8_BAR;
        PG8_STAGE(PG8_SB(1, 0), cB + kstep, voffB); PG8_STAGE(PG8_SA(1, 0), cA + kstep, voffA); PG8_STAGE(PG8_SB(1, 1), cB + hstep + kstep, voffB);
        PG8_WAIT_V(6); PG8_BAR;
    } else {
        PG8_STAGE(PG8_SB(0, 0), cB, voffB); PG8_STAGE(PG8_SA(0, 0), cA, voffA); PG8_STAGE(PG8_SB(0, 1), cB + hstep, voffB); PG8_STAGE(PG8_SA(0, 1), cA + hstep, voffA);
        if (wr == 1) PG8_BAR;
        PG8_WAIT_V(4); PG8_BAR;
        PG8_STAGE(PG8_SB(1, 0), cB + kstep, voffB); PG8_STAGE(PG8_SA(1, 0), cA + kstep, voffA); PG8_STAGE(PG8_SB(1, 1), cB + hstep + kstep, voffB);
        PG8_WAIT_V(6); PG8_BAR;
    }
    for (;;) {
        const bool has_next = S.next(ui + 1, nxt);
        const char* nA = has_next ? (const char*)g.A + (size_t)nxt.pm * tstep : cA; const char* nB = has_next ? (const char*)g.Bt + (size_t)nxt.pn * tstep : cB;
        for (int t = 0; t < nt; t += 2) {
            const bool last = (t == nt - 2);
            const char* a1 = cA + (size_t)(t + 1) * kstep;
            const char* a2 = last ? nA : cA + (size_t)(t + 2) * kstep; const char* b2 = last ? nB : cB + (size_t)(t + 2) * kstep;
            const char* a3 = a2 + kstep; const char* b3 = b2 + kstep;
            if (last && has_next) S.a_ready(nxt);
            if constexpr (SP2) {
            PG8_LDB(B0, 0, 0); PG8_LDB(B1, 0, 1); PG8_SCHED; PG8_LDA(At, 0, 0); PG8_STAGE(PG8_SA(1, 1), a1 + hstep, voffA);
            PG8_WAIT_V(8); PG8_WAIT_L(0); PG8_BAR; PG8_MMA(0, 0, At, B0); PG8_MMA(0, 1, At, B1); PG8_BAR; PG8_SCHED;
            PG8_LDA(At, 0, 1); PG8_STAGE(PG8_SB(0, 0), b2, voffB); PG8_STAGE(PG8_SB(0, 1), b2 + hstep, voffB); PG8_STAGE(PG8_SA(0, 0), a2, voffA);
            PG8_WAIT_V(8); PG8_WAIT_L(0); PG8_BAR; PG8_MMA(1, 0, At, B0); PG8_MMA(1, 1, At, B1); PG8_BAR; PG8_SCHED;
            PG8_LDB(B0, 1, 0); PG8_LDB(B1, 1, 1); PG8_SCHED; PG8_LDA(At, 1, 0); PG8_STAGE(PG8_SA(0, 1), a2 + hstep, voffA);
            PG8_WAIT_V(8); PG8_WAIT_L(0); PG8_BAR; PG8_MMA(0, 0, At, B0); PG8_MMA(0, 1, At, B1); PG8_BAR; PG8_SCHED;
            PG8_LDA(At, 1, 1); PG8_STAGE(PG8_SB(1, 0), b3, voffB); PG8_STAGE(PG8_SB(1, 1), b3 + hstep, voffB); PG8_STAGE(PG8_SA(1, 0), a3, voffA);
            PG8_WAIT_V(8); PG8_WAIT_L(0); PG8_BAR; PG8_MMA(1, 0, At, B0); PG8_MMA(1, 1, At, B1); PG8_BAR; PG8_SCHED;
            } else {
            PG8_LDB(B0, 0, 0); PG8_SCHED; PG8_LDA(At, 0, 0); PG8_STAGE(PG8_SA(1, 1), a1 + hstep, voffA);
            PG8_WAIT_L(8); PG8_BAR; PG8_WAIT_L(0); PG8_MMA(0, 0, At, B0); PG8_BAR; PG8_SCHED;
            PG8_LDB(B1, 0, 1); PG8_STAGE(PG8_SB(0, 0), b2, voffB);
            PG8_BAR; PG8_WAIT_L(0); PG8_MMA(0, 1, At, B1); PG8_BAR;
            PG8_LDA(At, 0, 1); PG8_STAGE(PG8_SA(0, 0), a2, voffA);
            PG8_BAR; PG8_WAIT_L(0); PG8_MMA(1, 0, At, B0); PG8_BAR; PG8_SCHED;
            PG8_STAGE(PG8_SB(0, 1), b2 + hstep, voffB);
            PG8_WAIT_V(6); PG8_BAR; PG8_MMA(1, 1, At, B1); PG8_BAR;
            PG8_LDB(B0, 1, 0); PG8_SCHED; PG8_LDA(At, 1, 0); PG8_STAGE(PG8_SA(0, 1), a2 + hstep, voffA);
            PG8_WAIT_L(8); PG8_BAR; PG8_WAIT_L(0); PG8_MMA(0, 0, At, B0); PG8_BAR; PG8_SCHED;
            PG8_LDB(B1, 1, 1); PG8_STAGE(PG8_SB(1, 0), b3, voffB);
            PG8_BAR; PG8_WAIT_L(0); PG8_MMA(0, 1, At, B1); PG8_BAR;
            PG8_LDA(At, 1, 1); PG8_STAGE(PG8_SA(1, 0), a3, voffA);
            PG8_BAR; PG8_WAIT_L(0); PG8_MMA(1, 0, At, B0); PG8_BAR; PG8_SCHED;
            PG8_STAGE(PG8_SB(1, 1), b3 + hstep, voffB);
            PG8_WAIT_V(6); PG8_BAR; PG8_MMA(1, 1, At, B1); PG8_BAR;
            }
        }
        if constexpr (ALIGN_EPI) { if (wr == 0) PG8_BAR; }
        if constexpr (!Epi::AFTER_DRAIN) { E(acc, cur, wr, wc, fr, fq); S.done(cur); }
        if (!has_next) break;
#pragma unroll
        for (int a = 0; a < 2; ++a)
#pragma unroll
            for (int b = 0; b < 2; ++b)
#pragma unroll
                for (int m = 0; m < 4; ++m)
#pragma unroll
                    for (int n = 0; n < 2; ++n) acc[a][b][m][n] = (f32x4){0.f, 0.f, 0.f, 0.f};
        cur = nxt; cA = nA; cB = nB; ++ui;
        if constexpr (ALIGN_EPI) { if (wr == 1) PG8_BAR; }
    }
    PG8_WAIT_V(0);
    if constexpr (!ALIGN_EPI) { if (wr == 0) PG8_BAR; }
    PG8_BAR;
    if constexpr (Epi::AFTER_DRAIN) { E.fused(acc, cur, wr, wc, fr, fq, lds, wid, lane); S.done(cur); }
#undef PG8_SA
#undef PG8_SB
#undef PG8_STAGE
#undef PG8_LDA
#undef PG8_LDB
#undef PG8_MMA
#undef PG8_WAIT_V
#undef PG8_WAIT_L
#undef PG8_BAR
#undef PG8_SCHED
}
}
template <int NV>
DI void att_step(const float (&q)[64], const bf16_t* kp, const bf16_t* vp, float bias, float& mx, float& l, float (&o)[NV]) {
    float dot = 0.f;
#pragma unroll
    for (int c = 0; c < 8; ++c) { const u32x4 raw = *(const u32x4*)(kp + c * 8);
#pragma unroll
        for (int j = 0; j < 4; ++j) { dot += q[c * 8 + 2 * j] * __uint_as_float(raw[j] << 16); dot += q[c * 8 + 2 * j + 1] * __uint_as_float(raw[j] & 0xffff0000u); } }
    const float s = dot * 0.125f + bias;
    const float mn = fmaxf(mx, s), corr = expf(mx - mn), pr = expf(s - mn);
    mx = mn; l = l * corr + pr;
#pragma unroll
    for (int c = 0; c < NV / 8; ++c) { const u32x4 raw = *(const u32x4*)(vp + c * 8);
#pragma unroll
        for (int j = 0; j < 4; ++j) { o[c * 8 + 2 * j] = o[c * 8 + 2 * j] * corr + pr * __uint_as_float(raw[j] << 16); o[c * 8 + 2 * j + 1] = o[c * 8 + 2 * j + 1] * corr + pr * __uint_as_float(raw[j] & 0xffff0000u); } }
}
DI void load_q64(float (&q)[64], const bf16_t* qp) {
#pragma unroll
    for (int c = 0; c < 8; ++c) { const u32x4 raw = *(const u32x4*)(qp + c * 8);
#pragma unroll
        for (int j = 0; j < 4; ++j) { q[c * 8 + 2 * j] = __uint_as_float(raw[j] << 16); q[c * 8 + 2 * j + 1] = __uint_as_float(raw[j] & 0xffff0000u); } }
}
DI void phase_na_naive(const P& p) {
    const bf16_t* QKV = (const bf16_t*)(p.ws + WS_H); bf16_t* A = (bf16_t*)(p.ws + WS_A); const float* rpb = p.in[10];
    for (int idx = blockIdx.x * NTHR + otid(); idx < MT * 8; idx += gridDim.x * NTHR) {
        const int head = idx & 7, m = idx >> 3;
        float q[64], o[64]; float mx = -1e30f, l = 0.f;
        load_q64(q, QKV + (size_t)m * LD0 + C_NQ + head * 64);
#pragma unroll
        for (int d = 0; d < 64; ++d) o[d] = 0.f;
        int b;
        if (m < MX) {
            b = m >> 11; const int t = m & 2047, r = t >> 6, c = t & 63;
            const int rs = min(max(r - 4, 0), 24), cs = min(max(c - 8, 0), 48);
#pragma unroll 1
            for (int i = 0; i < 8; ++i)
#pragma unroll 1
                for (int w = 0; w < 16; ++w) { const int rr = rs + i, ww = cs + w; const size_t mk = (size_t)b * 2048 + rr * 64 + ww;
                    const float bias = rpb[(head * 15 + (rr - r + 7)) * 31 + (ww - c + 15)];
                    att_step<64>(q, QKV + mk * LD0 + C_NK + head * 64, QKV + mk * LD0 + C_NV + head * 64, bias, mx, l, o); }
        } else b = (m - MX) >> 8;
#pragma unroll 1
        for (int lk = 0; lk < 256; ++lk) { const size_t mk = (size_t)MX + b * 256 + lk;
            att_step<64>(q, QKV + mk * LD0 + C_NK + head * 64, QKV + mk * LD0 + C_NV + head * 64, 0.f, mx, l, o); }
        const float il = 1.f / l; bf16_t* op = A + (size_t)m * DM + head * 64;
#pragma unroll
        for (int d = 0; d < 64; d += 2) *(unsigned*)(op + d) = pk2(o[d] * il, o[d + 1] * il);
    }
}
DI void phase_gla_naive(const P& p, float* lds) {
    float* sq = lds; float* sk = lds + 4096; float* sa = lds + 8192; float* sv = lds + 12288;
    const bf16_t* QKV = (const bf16_t*)(p.ws + WS_H);
    const int tid = otid();
    for (int chain = blockIdx.x; chain < 64; chain += gridDim.x) {
        const int dir = chain & 1, h = (chain >> 1) & 3, b = chain >> 3;
        const float* wg = p.in[dir ? 13 : 11]; const float* bg = p.in[dir ? 14 : 12];
        bf16_t* O = (bf16_t*)(p.ws + (dir ? WS_OB : WS_OF));
        const int zoff = dir ? C_ZB : C_ZF;
        float S[64];
#pragma unroll
        for (int d = 0; d < 64; ++d) S[d] = 0.f;
        for (int seg = 0; seg < 2; ++seg) {
            const int base = seg == 0 ? MX + b * 256 : b * 2048, n = seg == 0 ? 256 : 2048;
            for (int c = 0; c < n / 64; ++c) {
                for (int idx = tid; idx < 4096; idx += NTHR) { const int i = idx >> 6, d = idx & 63, tp = c * 64 + i, t = dir ? n - 1 - tp : tp;
                    const bf16_t* rowp = QKV + (size_t)(base + t) * LD0;
                    sq[idx] = bf2f(rowp[C_GQ + h * 64 + d]) * 0.125f; sk[idx] = bf2f(rowp[C_GK + h * 64 + d]);
                    float z = bg[h * 64 + d];
#pragma unroll
                    for (int r = 0; r < 16; ++r) z += bf2f(rowp[zoff + r]) * wg[r * 256 + h * 64 + d];
                    const float ls = fminf(z, 0.f) - log1pf(expf(-fabsf(z)));
                    sa[idx] = expf(ls * (1.f / 16.f)); }
                for (int idx = tid; idx < 8192; idx += NTHR) { const int i = idx >> 7, e = idx & 127, tp = c * 64 + i, t = dir ? n - 1 - tp : tp;
                    sv[idx] = bf2f(QKV[(size_t)(base + t) * LD0 + C_GV + h * 128 + e]); }
                __syncthreads();
                if (tid < 128) {
                    const int e = tid;
#pragma unroll 1
                    for (int i = 0; i < 64; ++i) { const float ve = sv[i * 128 + e]; float o = 0.f;
#pragma unroll
                        for (int d = 0; d < 64; ++d) { float sd = sa[i * 64 + d] * S[d];
                            if (dir == 0) { sd += sk[i * 64 + d] * ve; o += sq[i * 64 + d] * sd; } else { o += sq[i * 64 + d] * sd; sd += sk[i * 64 + d] * ve; }
                            S[d] = sd; }
                        const int tp = c * 64 + i, t = dir ? n - 1 - tp : tp;
                        O[(size_t)(base + t) * 512 + h * 128 + e] = f2bf(o); }
                }
                __syncthreads();
            }
        }
    }
}
DI void phase_gla_finalize(const P& p) {
    const int tid = otid(), lane = tid & 63, w = tid >> 6;
    const int gw = blockIdx.x * 8 + w, NGW = gridDim.x * 8;
    const bf16_t* QKV = (const bf16_t*)(p.ws + WS_H); bf16_t* A = (bf16_t*)(p.ws + WS_A);
    const bf16_t* OF = (const bf16_t*)(p.ws + WS_OF); const bf16_t* OB = (const bf16_t*)(p.ws + WS_OB); const float* ng = p.in[15];
    for (int m = gw; m < MT; m += NGW) {
        const u32x4 rf = *(const u32x4*)(OF + (size_t)m * 512 + lane * 8), rb = *(const u32x4*)(OB + (size_t)m * 512 + lane * 8), rg = *(const u32x4*)(QKV + (size_t)m * LD0 + C_GR + lane * 8);
        float s[8], g[8]; float ss = 0.f;
#pragma unroll
        for (int j = 0; j < 4; ++j) { s[2 * j] = __uint_as_float(rf[j] << 16) + __uint_as_float(rb[j] << 16); s[2 * j + 1] = __uint_as_float(rf[j] & 0xffff0000u) + __uint_as_float(rb[j] & 0xffff0000u);
            g[2 * j] = __uint_as_float(rg[j] << 16); g[2 * j + 1] = __uint_as_float(rg[j] & 0xffff0000u); }
#pragma unroll
        for (int j = 0; j < 8; ++j) ss += s[j] * s[j];
        ss += __shfl_xor(ss, 1); ss += __shfl_xor(ss, 2); ss += __shfl_xor(ss, 4); ss += __shfl_xor(ss, 8);
        const float rms = 1.0f / sqrtf(ss * (1.f / 128.f) + LN_EPS);
        float o[8];
#pragma unroll
        for (int j = 0; j < 8; ++j) o[j] = s[j] * rms * ng[(lane & 15) * 8 + j] * silu_f(g[j]);
        u32x4 ov; ov.x = pk2(o[0], o[1]); ov.y = pk2(o[2], o[3]); ov.z = pk2(o[4], o[5]); ov.w = pk2(o[6], o[7]);
        *(u32x4*)(A + (size_t)m * DM + 512 + lane * 8) = ov;
    }
}
DI void phase_rope_naive(const P& p) {
    bf16_t* QKV = (bf16_t*)(p.ws + WS_H); const float* T = (const float*)(p.ws + WS_ROPE);
    for (size_t idx = (size_t)blockIdx.x * NTHR + otid(); idx < (size_t)MX * 1024; idx += (size_t)gridDim.x * NTHR) {
        const int m = (int)(idx >> 10), pi = (int)(idx & 1023), blk = pi >> 5, j = pi & 31, t = m & 2047;
        const int d0 = j < 16 ? j : 32 + (j - 16);
        const float c = T[(t * 32 + j) * 2], s = T[(t * 32 + j) * 2 + 1];
        bf16_t* u = QKV + (size_t)m * LD1 + blk * 64 + d0;
        const float u0 = bf2f(u[0]), u1 = bf2f(u[16]);
        u[0] = f2bf(u0 * c - u1 * s); u[16] = f2bf(u1 * c + u0 * s);
    }
}
DI void phase_diff_naive(const P& p) {
    const bf16_t* QKV = (const bf16_t*)(p.ws + WS_H); bf16_t* A = (bf16_t*)(p.ws + WS_A);
    float d1 = 0.f, d2 = 0.f;
    for (int i = 0; i < 64; ++i) { d1 += p.in[24][i] * p.in[25][i]; d2 += p.in[26][i] * p.in[27][i]; }
    const float lam = expf(d1) - expf(d2) + LAMBDA_INIT;
    const float* sg = p.in[28];
    for (int idx = blockIdx.x * NTHR + otid(); idx < MX * 32; idx += gridDim.x * NTHR) {
        const int quarter = idx & 3, head = (idx >> 2) & 7, m = idx >> 5, b = m >> 11;
        float res[32];
#pragma unroll 1
        for (int br = 0; br < 2; ++br) {
            float q[64], o[32]; float mx = -1e30f, l = 0.f;
            load_q64(q, QKV + (size_t)m * LD1 + head * 128 + br * 64);
#pragma unroll
            for (int e = 0; e < 32; ++e) o[e] = 0.f;
#pragma unroll 1
            for (int key = 0; key < 2304; ++key) { const size_t mk = key < 2048 ? (size_t)b * 2048 + key : (size_t)MX + b * 256 + (key - 2048);
                att_step<32>(q, QKV + mk * LD1 + 1024 + head * 128 + br * 64, QKV + mk * LD1 + 2048 + head * 128 + quarter * 32, 0.f, mx, l, o); }
            const float il = 1.f / l;
            if (br == 0) {
#pragma unroll
                for (int e = 0; e < 32; ++e) res[e] = o[e] * il;
            } else {
#pragma unroll
                for (int e = 0; e < 32; ++e) res[e] -= lam * o[e] * il;
            }
        }
        float ss = 0.f;
#pragma unroll
        for (int e = 0; e < 32; ++e) ss += res[e] * res[e];
        ss += __shfl_xor(ss, 1); ss += __shfl_xor(ss, 2);
        const float rms = 1.0f / sqrtf(ss * (1.f / 128.f) + LN_EPS);
        bf16_t* op = A + (size_t)m * DM + head * 128 + quarter * 32;
#pragma unroll
        for (int e = 0; e < 32; e += 2) *(unsigned*)(op + e) = pk2(res[e] * rms * sg[quarter * 32 + e] * (1.f - LAMBDA_INIT), res[e + 1] * rms * sg[quarter * 32 + e + 1] * (1.f - LAMBDA_INIT));
    }
}

__global__ void __launch_bounds__(NTHR) mk_fwd(P p) {
    extern __shared__ __attribute__((aligned(16))) unsigned char lds_raw[];
    float* lds = (float*)lds_raw;
    cg::grid_group grid = cg::this_grid();
    int ph = 0;
#define RUN(...) do { if (ph >= p.ph_lo && ph < p.ph_hi) { __VA_ARGS__; if (ph + 1 < p.ph_hi) grid.sync(); } ++ph; } while (0)
    bf16_t* A = (bf16_t*)(p.ws + WS_A); bf16_t* H = (bf16_t*)(p.ws + WS_H);

    RUN({ phase_adaln(p, lds); phase_rope_table(p); phase_convert(p, lds); });
    RUN(phase_rowpass(p, false, 0, false, true, 0, 0, 1, MT));
    __attribute__((address_space(3))) unsigned char* glds = (__attribute__((address_space(3))) unsigned char*)lds_raw;
    float* XH = (float*)(p.ws + WS_XH); const float* ROPE = (const float*)(p.ws + WS_ROPE);
    const int G = (int)gridDim.x, cid = (int)blockIdx.x;
#define GEMM_SWIGLU(Aop, Wt, Mrows) do { pg8::Gemm g{Aop, Wt, Mrows, 2 * DFF, DM}; pg8::StaticOrder S; S.init(Mrows, 2 * DFF, G, cid); pg8::EpiSwigluF E{H, DFF}; \
        pg8::gemm_phase<pg8::EpiSwigluF, pg8::StaticOrder, true, true>(glds, g, S, E); } while (0)
#define GEMM_STORE(Aop, Wt, Mrows, N, ropet) do { pg8::Gemm g{Aop, Wt, Mrows, N, DM}; pg8::StaticOrder S; S.init(Mrows, N, G, cid); pg8::EpiStoreF E{H, N, ROPE, ropet, MX}; \
        pg8::gemm_phase<pg8::EpiStoreF, pg8::StaticOrder, true, true>(glds, g, S, E); } while (0)
#define GEMM_RESID(Aop, Wt, Mrows, K, xi, hi, chunk, sc) do { pg8::Gemm g{Aop, Wt, Mrows, DM, K}; pg8::StaticOrder S; S.init(Mrows, DM, G, cid); \
        pg8::EpiResidF E{xi, hi, p.out, XH, mod_ptr(p, l, 0, chunk), mod_ptr(p, l, 8, chunk), sc, ALPHA}; \
        pg8::gemm_phase<pg8::EpiResidF, pg8::StaticOrder, true, true>(glds, g, S, E); } while (0)
#pragma unroll 1
    for (int l = 0; l < 2; ++l) {
        RUN(GEMM_SWIGLU(A, wt_ptr(p, l, WT_F1I), MT));
        RUN(GEMM_RESID(H, wt_ptr(p, l, WT_F1O), MT, DFF, (l == 0 ? p.in[0] : (const float*)p.out), (l == 0 ? p.in[2] : (const float*)XH), 2, 0.5f));
        RUN(phase_rowpass(p, true, 1, true, true, l, 3, 4, MT));
        if (l == 0) {
            RUN(GEMM_STORE(A, wt_ptr(p, l, WT_MI), MT, LD0, 0));
            RUN({ phase_gla_naive(p, lds); phase_na_naive(p); });
            RUN(phase_gla_finalize(p));
        } else {
            RUN(GEMM_STORE(A, wt_ptr(p, l, WT_MI), MT, LD1, 8));
            RUN(phase_diff_naive(p));
        }
        const int Mrows = l == 0 ? MT : MX;
        RUN(GEMM_RESID(A, wt_ptr(p, l, WT_MO), Mrows, DM, (const float*)p.out, (const float*)XH, 5, 1.0f));
        RUN(phase_rowpass(p, true, 1, true, true, l, 6, 7, Mrows));
        RUN(GEMM_SWIGLU(A, wt_ptr(p, l, WT_F2I), Mrows));
        RUN(GEMM_RESID(H, wt_ptr(p, l, WT_F2O), Mrows, DFF, (const float*)p.out, (const float*)XH, 8, 0.5f));
        RUN(phase_rowpass(p, true, 1, true, l == 0, 1, 0, 1, Mrows));
    }
#undef RUN
}

extern "C" void kernel_launch(void* const* d_in, const int* in_sizes, int n_in, void* d_out, int out_size, void* d_ws, size_t ws_size, hipStream_t stream) {
    static int grid = 0;
    if (grid == 0) {
        if (n_in != 31 || out_size != MX * DM || ws_size < WS_END) { fprintf(stderr, "kernel_launch: unexpected shapes (n_in %d out %d ws %zu)\n", n_in, out_size, ws_size); grid = -1; return; }
        int dev = 0, cus = 0, per_cu = 0;
        hipGetDevice(&dev); hipDeviceGetAttribute(&cus, hipDeviceAttributeMultiprocessorCount, dev);
        hipFuncSetAttribute((const void*)mk_fwd, hipFuncAttributeMaxDynamicSharedMemorySize, LDS_BYTES);
        hipOccupancyMaxActiveBlocksPerMultiprocessor(&per_cu, (const void*)mk_fwd, NTHR, LDS_BYTES);
        if (per_cu < 1) { fprintf(stderr, "kernel_launch: occupancy query says %d blocks per CU\n", per_cu); grid = -1; return; }
        grid = cus;
    }
    if (grid < 0) return;
    P p{};
    for (int i = 0; i < 31; ++i) p.in[i] = (const float*)d_in[i];
    p.out = (float*)d_out; p.ws = (unsigned char*)d_ws; p.ph_lo = 0; p.ph_hi = 1000;
    void* args[] = {&p};
    hipError_t e = hipLaunchCooperativeKernel((const void*)mk_fwd, dim3(grid), dim3(NTHR), args, LDS_BYTES, stream);
    if (e != hipSuccess) fprintf(stderr, "cooperative launch failed: %s (grid %d)\n", hipGetErrorString(e), grid);
}
```

```cpp
#include <hip/hip_runtime.h>
#include <hip/hip_cooperative_groups.h>
#include <cstdio>
#include <cstdint>
namespace cg = cooperative_groups;

typedef unsigned short bf16_t;
typedef float f32x4 __attribute__((ext_vector_type(4)));
typedef unsigned u32x4 __attribute__((ext_vector_type(4)));
typedef unsigned u32x2 __attribute__((ext_vector_type(2)));
#define DI __device__ __forceinline__

constexpr int NB = 8, SEQ = 2048, CTXL = 256, DM = 1024, DFF = 2816;
constexpr int MX = NB * SEQ, MH = NB * CTXL, MT = MX + MH;
constexpr float ALPHA = 1.41421356237309515f;
constexpr float LN_EPS = 1e-6f;
constexpr float LAMBDA_INIT = 0.35550906759f;
constexpr int NTHR = 512;

constexpr int LD0 = 3328, C_NQ = 0, C_NK = 512, C_NV = 1024, C_GQ = 1536, C_GK = 1792, C_GV = 2048, C_GR = 2560, C_ZF = 3072, C_ZB = 3088;
constexpr int LD1 = 3072;

constexpr size_t MiB = 1u << 20;
constexpr size_t WS_MOD = 0;
constexpr size_t WS_ROPE = 1 * MiB;
constexpr size_t WS_XH = 2 * MiB;
constexpr size_t WS_WT = 10 * MiB;
constexpr size_t WT_LAYER = 42 * MiB;
constexpr size_t WT_F1I = 0, WT_F1O = 11 * MiB, WT_MI = 16 * MiB + MiB / 2, WT_MO = 23 * MiB, WT_F2I = 25 * MiB, WT_F2O = 36 * MiB;
constexpr size_t WS_A = 94 * MiB;
constexpr size_t WS_H = 130 * MiB;
constexpr size_t WS_OF = 247 * MiB;
constexpr size_t WS_OB = 265 * MiB;
constexpr size_t WS_END = 283 * MiB;

constexpr int LDS_BYTES = 147456;

struct P { const float* in[31]; float* out; unsigned char* ws; int ph_lo, ph_hi; };

DI float bf2f(bf16_t h) { return __uint_as_float(((unsigned)h) << 16); }
DI bf16_t f2bf(float f) { unsigned u = __float_as_uint(f); return (bf16_t)((u + 0x7fffu + ((u >> 16) & 1u)) >> 16); }
DI unsigned pk2(float lo, float hi) { return (unsigned)f2bf(lo) | ((unsigned)f2bf(hi) << 16); }
DI float silu_f(float v) { return v / (1.f + expf(-v)); }
DI float wave_sum(float v) {
#pragma unroll
    for (int o = 1; o < 64; o <<= 1) v += __shfl_xor(v, o);
    return v;
}
DI int otid() { int t = threadIdx.x; asm volatile("" : "+v"(t)); return t; }
DI float* xres_ptr(const P& p, int m) { return m < MX ? p.out + (size_t)m * DM : (float*)(p.ws + WS_XH) + (size_t)(m - MX) * DM; }
DI const float* xin_ptr(const P& p, int m) { return m < MX ? p.in[0] + (size_t)m * DM : p.in[2] + (size_t)(m - MX) * DM; }
DI int modrow(int m) { return m < MX ? (m >> 11) : 8; }
DI const float* mod_ptr(const P& p, int l, int r, int chunk) { return (const float*)(p.ws + WS_MOD) + ((size_t)(l * 9 + r) * 9 + chunk) * DM; }
DI bf16_t* wt_ptr(const P& p, int l, size_t off) { return (bf16_t*)(p.ws + WS_WT + (size_t)l * WT_LAYER + off); }

DI void phase_adaln(const P& p, float* lds) {
    float* sc = lds; float* red = lds + 9 * 1024;
    const int tid = otid(), lane = tid & 63, w = tid >> 6;
    for (int i = tid; i < 9 * 1024; i += NTHR) { const int r = i >> 10, k = i & 1023; const float v = r < 8 ? p.in[1][r * 1024 + k] : p.in[3][k]; sc[i] = silu_f(v); }
    __syncthreads();
    for (int item = blockIdx.x; item < 288; item += gridDim.x) {
        const int l = item / 144, cb = item % 144, n = cb * 64 + lane;
        const float* W = p.in[l ? 18 : 4]; const float* bb = p.in[l ? 19 : 5];
        float acc[9];
#pragma unroll
        for (int r = 0; r < 9; ++r) acc[r] = 0.f;
#pragma unroll 4
        for (int k = w * 128; k < w * 128 + 128; ++k) { const float wv = W[(size_t)k * 9216 + n];
#pragma unroll
            for (int r = 0; r < 9; ++r) acc[r] += sc[r * 1024 + k] * wv; }
#pragma unroll
        for (int r = 0; r < 9; ++r) red[(w * 9 + r) * 64 + lane] = acc[r];
        __syncthreads();
        float* MOD = (float*)(p.ws + WS_MOD);
        for (int o = tid; o < 576; o += NTHR) { const int r = o >> 6, c = o & 63; float s = bb[cb * 64 + c];
#pragma unroll
            for (int w2 = 0; w2 < 8; ++w2) s += red[(w2 * 9 + r) * 64 + c];
            MOD[(size_t)(l * 9 + r) * 9216 + cb * 64 + c] = s; }
        __syncthreads();
    }
}
DI void phase_rope_table(const P& p) {
    float* T = (float*)(p.ws + WS_ROPE);
    for (int idx = blockIdx.x * NTHR + otid(); idx < 2048 * 32; idx += gridDim.x * NTHR) {
        const int t = idx >> 5, j = idx & 31, fi = j & 15; const float pos = (float)(j < 16 ? (t >> 6) : (t & 63));
        const float inv = powf(10000.f, -(float)(2 * fi) / 32.f); const float ang = pos * inv;
        T[idx * 2] = cosf(ang); T[idx * 2 + 1] = sinf(ang);
    }
}
DI void conv_item(const float* W, int K, int Nsrc, int src0, bf16_t* WT, int n0dst, int k0, float* scr, int lane) {
    if (src0 >= 0) {
#pragma unroll 8
        for (int i = 0; i < 32; ++i) { const int kk = 2 * i + (lane >> 5); scr[kk * 33 + (lane & 31)] = W[(size_t)(k0 + kk) * Nsrc + src0 + (lane & 31)]; }
    } else {
#pragma unroll 8
        for (int i = 0; i < 32; ++i) { const int kk = 2 * i + (lane >> 5); scr[kk * 33 + (lane & 31)] = 0.f; }
    }
    asm volatile("s_waitcnt lgkmcnt(0)" ::: "memory");
    const int c = lane & 7;
#pragma unroll
    for (int j = 0; j < 4; ++j) { const int n = (lane >> 3) + 8 * j; const float* s = scr + (8 * c) * 33 + n;
        u32x4 o; o.x = pk2(s[0 * 33], s[1 * 33]); o.y = pk2(s[2 * 33], s[3 * 33]); o.z = pk2(s[4 * 33], s[5 * 33]); o.w = pk2(s[6 * 33], s[7 * 33]);
        *(u32x4*)(WT + (size_t)(n0dst + n) * K + k0 + 8 * c) = o; }
    asm volatile("s_waitcnt lgkmcnt(0)" ::: "memory");
}
DI void conv_matrix_item(const float* W, int K, int Nsrc, int Ndst, int kind, bf16_t* WT, int item, float* scr, int lane) {
    const int nblk = Ndst / 32, kb = item / nblk, nb = item % nblk, n0 = nb * 32;
    int src0;
    if (kind == 1) { const int t = n0 >> 8, j = n0 & 255; src0 = j < 128 ? 128 * t + j : DFF + 128 * t + (j - 128); }
    else src0 = n0 < Nsrc ? n0 : -1;
    conv_item(W, K, Nsrc, src0, WT, n0, kb * 64, scr, lane);
}
DI void phase_convert(const P& p, float* lds) {
    const int tid = otid(), lane = tid & 63, w = tid >> 6;
    float* scr = lds + w * (64 * 33 + 16);
    const int gw = blockIdx.x * 8 + w, NGW = gridDim.x * 8;
    for (int l = 0; l < 2; ++l) {
        const int b = l ? 18 : 4;
        const int nmi = l ? 3072 : 3104, nmid = l ? 3072 : 3328;
        const int i0 = 16 * 176, i1 = 44 * 32, i2 = 16 * (nmid / 32), i3 = 16 * 32;
        const int total = i0 + i1 + i2 + i3 + i0 + i1;
        for (int it = gw; it < total; it += NGW) {
            int r = it;
            if (r < i0) { conv_matrix_item(p.in[b + 2], 1024, 5632, 5632, 1, wt_ptr(p, l, WT_F1I), r, scr, lane); continue; } r -= i0;
            if (r < i1) { conv_matrix_item(p.in[b + 3], 2816, 1024, 1024, 0, wt_ptr(p, l, WT_F1O), r, scr, lane); continue; } r -= i1;
            if (r < i2) { conv_matrix_item(p.in[b + 4], 1024, nmi, nmid, 0, wt_ptr(p, l, WT_MI), r, scr, lane); continue; } r -= i2;
            if (r < i3) { conv_matrix_item(p.in[b + 5], 1024, 1024, 1024, 0, wt_ptr(p, l, WT_MO), r, scr, lane); continue; } r -= i3;
            const int f2 = l ? 29 : 16;
            if (r < i0) { conv_matrix_item(p.in[f2], 1024, 5632, 5632, 1, wt_ptr(p, l, WT_F2I), r, scr, lane); continue; } r -= i0;
            conv_matrix_item(p.in[f2 + 1], 2816, 1024, 1024, 0, wt_ptr(p, l, WT_F2O), r, scr, lane);
        }
    }
}

DI void phase_rowpass(const P& p, bool do_ln, int src_mode, bool write_x, bool write_a, int l_mod, int ch_shift, int ch_scale, int M) {
    const int tid = otid(), lane = tid & 63, w = tid >> 6;
    const int gw = blockIdx.x * 8 + w, NGW = gridDim.x * 8;
    bf16_t* A = (bf16_t*)(p.ws + WS_A);
    for (int m = gw; m < M; m += NGW) {
        const f32x4* src = (const f32x4*)(src_mode == 0 ? xin_ptr(p, m) : (const float*)xres_ptr(p, m)) + lane;
        f32x4 v[4]; float s = 0.f;
#pragma unroll
        for (int j = 0; j < 4; ++j) { v[j] = src[64 * j]; s += (v[j].x + v[j].y) + (v[j].z + v[j].w); }
        if (do_ln) {
            const float mean = wave_sum(s) * (1.f / DM); float s2 = 0.f;
#pragma unroll
            for (int j = 0; j < 4; ++j) { v[j] = v[j] - mean; s2 += (v[j].x * v[j].x + v[j].y * v[j].y) + (v[j].z * v[j].z + v[j].w * v[j].w); }
            const float rstd = 1.0f / sqrtf(wave_sum(s2) * (1.f / DM) + LN_EPS);
#pragma unroll
            for (int j = 0; j < 4; ++j) v[j] = v[j] * rstd;
        }
        if (write_x) { f32x4* dst = (f32x4*)xres_ptr(p, m) + lane;
#pragma unroll
            for (int j = 0; j < 4; ++j) dst[64 * j] = v[j]; }
        if (write_a) {
            const f32x4* sh = (const f32x4*)mod_ptr(p, l_mod, modrow(m), ch_shift) + lane; const f32x4* scp = (const f32x4*)mod_ptr(p, l_mod, modrow(m), ch_scale) + lane;
            u32x2* o8 = (u32x2*)(A + (size_t)m * DM) + lane;
#pragma unroll
            for (int j = 0; j < 4; ++j) { const f32x4 a = v[j] * (scp[64 * j] + 1.0f) + sh[64 * j]; u32x2 o; o.x = pk2(a.x, a.y); o.y = pk2(a.z, a.w); o8[64 * j] = o; }
        }
    }
}

template <class Epi>
DI void naive_gemm(const bf16_t* A, const bf16_t* Wt, int M, int N, int K, const Epi& epi, float* lds) {
    float* sA = lds; float* sB = lds + 32 * 132;
    const int tid = otid(), tx = tid & 31, ty = tid >> 5;
    const int ntn = N / 256, ntm = M / 128, ntiles = ntm * ntn;
    for (int tile = blockIdx.x; tile < ntiles; tile += gridDim.x) {
        const int tn = tile % ntn, tm = tile / ntn, m0 = tm * 128, n0 = tn * 256;
        float acc[8][8];
#pragma unroll
        for (int i = 0; i < 8; ++i)
#pragma unroll
            for (int j = 0; j < 8; ++j) acc[i][j] = 0.f;
        for (int k0 = 0; k0 < K; k0 += 32) {
            const int row = tid >> 2, kc = (tid & 3) * 8;
            { const u32x4 raw = *(const u32x4*)(A + (size_t)(m0 + row) * K + k0 + kc);
#pragma unroll
              for (int j = 0; j < 4; ++j) { sA[(kc + 2 * j) * 132 + row] = __uint_as_float(raw[j] << 16); sA[(kc + 2 * j + 1) * 132 + row] = __uint_as_float(raw[j] & 0xffff0000u); } }
#pragma unroll
            for (int h = 0; h < 2; ++h) { const int rb = row + 128 * h; const u32x4 raw = *(const u32x4*)(Wt + (size_t)(n0 + rb) * K + k0 + kc);
#pragma unroll
              for (int j = 0; j < 4; ++j) { sB[(kc + 2 * j) * 264 + rb] = __uint_as_float(raw[j] << 16); sB[(kc + 2 * j + 1) * 264 + rb] = __uint_as_float(raw[j] & 0xffff0000u); } }
            __syncthreads();
#pragma unroll 4
            for (int kk = 0; kk < 32; ++kk) {
                const f32x4 a0 = *(const f32x4*)&sA[kk * 132 + ty * 8], a1 = *(const f32x4*)&sA[kk * 132 + ty * 8 + 4];
                const f32x4 b0 = *(const f32x4*)&sB[kk * 264 + tx * 4], b1 = *(const f32x4*)&sB[kk * 264 + 128 + tx * 4];
                const float a[8] = {a0.x, a0.y, a0.z, a0.w, a1.x, a1.y, a1.z, a1.w}; const float b[8] = {b0.x, b0.y, b0.z, b0.w, b1.x, b1.y, b1.z, b1.w};
#pragma unroll
                for (int i = 0; i < 8; ++i)
#pragma unroll
                    for (int j = 0; j < 8; ++j) acc[i][j] += a[i] * b[j];
            }
            __syncthreads();
        }
#pragma unroll
        for (int i = 0; i < 8; ++i)
#pragma unroll
            for (int j = 0; j < 4; ++j) epi.pair(m0 + ty * 8 + i, tn, tx * 4 + j, acc[i][j], acc[i][4 + j]);
    }
}
struct EpiSwiglu { bf16_t* H; DI void pair(int m, int t, int c, float va, float vg) const { H[(size_t)m * DFF + t * 128 + c] = f2bf(silu_f(va) * vg); } };
struct EpiStore { bf16_t* O; int ld; DI void pair(int m, int t, int c, float va, float vg) const { O[(size_t)m * ld + t * 256 + c] = f2bf(va); O[(size_t)m * ld + t * 256 + 128 + c] = f2bf(vg); } };
struct EpiResid { const P* p; int src_mode, l, chunk; float scale;
    DI void one(int m, int n, float v) const { const float* res = src_mode ? (const float*)xres_ptr(*p, m) : xin_ptr(*p, m); const float g = mod_ptr(*p, l, modrow(m), chunk)[n]; xres_ptr(*p, m)[n] = ALPHA * res[n] + g * scale * v; }
    DI void pair(int m, int t, int c, float va, float vg) const { one(m, t * 256 + c, va); one(m, t * 256 + 128 + c, vg); } };

namespace pg8 {
#define PG8_LAS __attribute__((address_space(3)))
typedef unsigned short bf16_t;
typedef short bf16x8 __attribute__((ext_vector_type(8)));
typedef float f32x4 __attribute__((ext_vector_type(4)));
typedef unsigned u32x4 __attribute__((ext_vector_type(4)));
constexpr int BM = 256, BK = 64, HALF = 128, HTB = HALF * BK * 2  , STAGE_BYTES = 8 * HTB, NXCD = 8, WGM = 8;

__host__ __device__ __forceinline__ int lds_byte(int r, int c) { const int st = (r >> 4) * 2 + (c >> 5), rr = r & 15, cc = c & 31, ob = rr * 64 + cc * 2; return st * 1024 + (ob ^ (((ob >> 9) & 1) << 5)); }
__host__ __device__ __forceinline__ void stage_rc(int b, int& R, int& C) { const int st = b / 1024, sb = b % 1024, swz = sb ^ (((sb >> 9) & 1) << 5); R = (st >> 1) * 16 + swz / 64; C = (st & 1) * 32 + (swz % 64) / 2; }
__host__ __device__ __forceinline__ int perm32(int rho) { const int n = rho >> 4, i = rho & 15; return 8 * (i >> 2) + 4 * n + (i & 3); }

struct Unit { int pm, pn; };
struct Gemm { const bf16_t* A; const bf16_t* Bt; int M, N, K; };

struct StaticOrder {
    int nM, nN, nwg, G, c;
    __host__ __device__ void init(int M, int N, int G_, int c_) { nM = M / BM; nN = N / BM; nwg = nM * nN; G = G_; c = c_; }
    __host__ __device__ bool next(int i, Unit& u) const {
        const long L = (long)i * G + c; if (L >= nwg) return false;
        int wgid = (int)L; { const int q = nwg / NXCD, r = nwg % NXCD, xcd = wgid % NXCD, off = wgid / NXCD; wgid = (xcd < r ? xcd * (q + 1) : r * (q + 1) + (xcd - r) * q) + off; }
        const int nig = WGM * nN, gid = wgid / nig, fm = gid * WGM, gsz = (nM - fm) < WGM ? (nM - fm) : WGM;
        u.pm = fm + ((wgid % nig) % gsz); u.pn = (wgid % nig) / gsz; return true;
    }
    __device__ __forceinline__ void a_ready(const Unit&) const {}
    __device__ __forceinline__ void done(const Unit&) const {}
};

__device__ __forceinline__ unsigned cvt_pk_bf16(float lo, float hi) { unsigned r; asm volatile("v_cvt_pk_bf16_f32 %0, %1, %2" : "=v"(r) : "v"(lo), "v"(hi)); return r; }
__device__ __forceinline__ float fast_silu(float a) { return a * __builtin_amdgcn_rcpf(1.0f + __builtin_amdgcn_exp2f(-1.4426950408889634f * a)); }
struct EpiSwigluF {
    static constexpr bool PERM = true, AFTER_DRAIN = false;
    bf16_t* H; int ldh;
    __device__ __forceinline__ void operator()(const f32x4 (&acc)[2][2][4][2], const Unit& u, int wr, int wc, int fr, int fq) const {
        const int row0 = u.pm * BM + wr * 64 + fr, col0 = u.pn * HALF + wc * 32 + 8 * fq;
#pragma unroll
        for (int ai = 0; ai < 2; ++ai)
#pragma unroll
            for (int m = 0; m < 4; ++m) { bf16_t* rowp = H + (size_t)(row0 + ai * HALF + m * 16) * ldh + col0;
                const f32x4 a0 = acc[ai][0][m][0], a1 = acc[ai][0][m][1], g0 = acc[ai][1][m][0], g1 = acc[ai][1][m][1];
                u32x4 w; w.x = cvt_pk_bf16(fast_silu(a0[0]) * g0[0], fast_silu(a0[1]) * g0[1]); w.y = cvt_pk_bf16(fast_silu(a0[2]) * g0[2], fast_silu(a0[3]) * g0[3]);
                w.z = cvt_pk_bf16(fast_silu(a1[0]) * g1[0], fast_silu(a1[1]) * g1[1]); w.w = cvt_pk_bf16(fast_silu(a1[2]) * g1[2], fast_silu(a1[3]) * g1[3]);
                *(u32x4*)rowp = w; }
    }
};
struct EpiStoreF {
    static constexpr bool PERM = true, AFTER_DRAIN = false;
    bf16_t* O; int ld; const float* T; int rope_tiles, rope_rows;
    __device__ __forceinline__ void operator()(const f32x4 (&acc)[2][2][4][2], const Unit& u, int wr, int wc, int fr, int fq) const {
        const int row0 = u.pm * BM + wr * 64 + fr, col0 = u.pn * BM + wc * 32 + 8 * fq;
        const bool rope = (u.pn < rope_tiles) && (u.pm * BM < rope_rows);
        const int jt = (wc & 1) * 16 + ((8 * fq) & 15);
        const float sgn = fq < 2 ? -1.f : 1.f;
#pragma unroll
        for (int ai = 0; ai < 2; ++ai)
#pragma unroll
            for (int m = 0; m < 4; ++m) { const int row = row0 + ai * HALF + m * 16; bf16_t* rowp = O + (size_t)row * ld + col0;
#pragma unroll
                for (int bj = 0; bj < 2; ++bj) { f32x4 v0 = acc[ai][bj][m][0], v1 = acc[ai][bj][m][1];
                    if (rope) {
                        const f32x4* tp = (const f32x4*)(T + ((size_t)(row & 2047) * 32 + jt) * 2);
                        const f32x4 t0 = tp[0], t1 = tp[1], t2 = tp[2], t3 = tp[3];
                        f32x4 p0, p1;
#pragma unroll
                        for (int j = 0; j < 4; ++j) { p0[j] = __shfl_xor(v0[j], 32); p1[j] = __shfl_xor(v1[j], 32); }
                        v0 = (f32x4){v0[0] * t0[0] + sgn * p0[0] * t0[1], v0[1] * t0[2] + sgn * p0[1] * t0[3], v0[2] * t1[0] + sgn * p0[2] * t1[1], v0[3] * t1[2] + sgn * p0[3] * t1[3]};
                        v1 = (f32x4){v1[0] * t2[0] + sgn * p1[0] * t2[1], v1[1] * t2[2] + sgn * p1[1] * t2[3], v1[2] * t3[0] + sgn * p1[2] * t3[1], v1[3] * t3[2] + sgn * p1[3] * t3[3]};
                    }
                    u32x4 w; w.x = cvt_pk_bf16(v0[0], v0[1]); w.y = cvt_pk_bf16(v0[2], v0[3]); w.z = cvt_pk_bf16(v1[0], v1[1]); w.w = cvt_pk_bf16(v1[2], v1[3]);
                    *(u32x4*)(rowp + bj * HALF) = w; } }
    }
};
struct EpiResidF {
    static constexpr bool PERM = false, AFTER_DRAIN = false;
    const float* xi; const float* hi; float* xo; float* ho; const float* gx; const float* gh; float scale, alpha;
    __device__ __forceinline__ void operator()(const f32x4 (&acc)[2][2][4][2], const Unit& u, int wr, int wc, int fr, int fq) const {
        const bool lat = u.pm < 64;
        const int rowt = (lat ? u.pm : u.pm - 64) * BM + wr * 64 + fr, col0 = u.pn * BM + wc * 32 + 4 * fq;
        const float* ri = lat ? xi : hi; float* ro = lat ? xo : ho; const float* g = lat ? gx + (size_t)9216 * (u.pm >> 3) : gh;
        f32x4 gv[2][2];
#pragma unroll
        for (int bj = 0; bj < 2; ++bj)
#pragma unroll
            for (int n = 0; n < 2; ++n) gv[bj][n] = *(const f32x4*)(g + col0 + bj * HALF + n * 16) * scale;
#pragma unroll
        for (int ai = 0; ai < 2; ++ai)
#pragma unroll
            for (int m = 0; m < 4; ++m) { const size_t off = (size_t)(rowt + ai * HALF + m * 16) * 1024 + col0;
#pragma unroll
                for (int bj = 0; bj < 2; ++bj)
#pragma unroll
                    for (int n = 0; n < 2; ++n) { const f32x4 r = *(const f32x4*)(ri + off + bj * HALF + n * 16);
                        *(f32x4*)(ro + off + bj * HALF + n * 16) = r * alpha + gv[bj][n] * acc[ai][bj][m][n]; } }
    }
};

template <class Epi, class Sched, bool ALIGN_EPI = false, bool SP2 = false>
__device__ __forceinline__ void gemm_phase(PG8_LAS unsigned char* lds, const Gemm g, const Sched& S, const Epi& E) {
    const int tid = otid(), wid = __builtin_amdgcn_readfirstlane(tid >> 6), lane = tid & 63, wr = wid >> 2, wc = wid & 3, fr = lane & 15, fq = lane >> 4;
    const int K = g.K, nt = K / BK;
    unsigned voffA[2], voffB[2];
#pragma unroll
    for (int i = 0; i < 2; ++i) { int R, C; stage_rc(tid * 16 + i * 8192, R, C); const int Rb = Epi::PERM ? ((R & ~31) + perm32(R & 31)) : R;
        voffA[i] = (unsigned)(R * K + C) * 2u; voffB[i] = (unsigned)(Rb * K + C) * 2u; }
    const size_t kstep = (size_t)(BK * 2);
    const size_t hstep = (size_t)HALF * K * 2;
    const size_t tstep = 2 * hstep;
    const unsigned ldsw = (unsigned)wid * 1024u;
    const int aoff = lds_byte(wr * 64 + fr, fq * 8), boff = lds_byte(wc * 32 + fr, fq * 8);
#define PG8_SA(b, h) (((b) * 2 + (h)) * HTB)
#define PG8_SB(b, h) ((4 + (b) * 2 + (h)) * HTB)
#define PG8_STAGE(bufoff, gbase, voff) do { _Pragma("unroll") for (int _i = 0; _i < 2; ++_i) \
        __builtin_amdgcn_global_load_lds((const unsigned*)((const char*)(gbase) + (voff)[_i]), (PG8_LAS unsigned*)(lds + (bufoff) + ldsw + _i * 8192), 16, 0, 0); } while (0)
#define PG8_LDA(dst, b, h) do { _Pragma("unroll") for (int m = 0; m < 4; ++m) _Pragma("unroll") for (int k = 0; k < 2; ++k) dst[m][k] = *(const PG8_LAS bf16x8*)(lds + PG8_SA(b, h) + aoff + m * 2048 + k * 1024); } while (0)
#define PG8_LDB(dst, b, h) do { _Pragma("unroll") for (int n = 0; n < 2; ++n) _Pragma("unroll") for (int k = 0; k < 2; ++k) dst[n][k] = *(const PG8_LAS bf16x8*)(lds + PG8_SB(b, h) + boff + n * 2048 + k * 1024); } while (0)
#define PG8_MMA(ai, bj, At, Bt) do { __builtin_amdgcn_s_setprio(1); _Pragma("unroll") for (int m = 0; m < 4; ++m) _Pragma("unroll") for (int n = 0; n < 2; ++n) _Pragma("unroll") for (int k = 0; k < 2; ++k) \
        acc[ai][bj][m][n] = __builtin_amdgcn_mfma_f32_16x16x32_bf16(Bt[n][k], At[m][k], acc[ai][bj][m][n], 0, 0, 0); __builtin_amdgcn_s_setprio(0); } while (0)
#define PG8_WAIT_V(n) asm volatile("s_waitcnt vmcnt(" #n ")" ::: "memory")
#define PG8_WAIT_L(n) asm volatile("s_waitcnt lgkmcnt(" #n ")" ::: "memory")
#define PG8_BAR __builtin_amdgcn_s_barrier()
#define PG8_SCHED __builtin_amdgcn_sched_barrier(0)
    Unit cur, nxt; int ui = 0;
    if (!S.next(0, cur)) return;
    f32x4 acc[2][2][4][2];
#pragma unroll
    for (int a = 0; a < 2; ++a)
#pragma unroll
        for (int b = 0; b < 2; ++b)
#pragma unroll
            for (int m = 0; m < 4; ++m)
#pragma unroll
                for (int n = 0; n < 2; ++n) acc[a][b][m][n] = (f32x4){0.f, 0.f, 0.f, 0.f};
    bf16x8 At[4][2], B0[2][2], B1[2][2];
    const char* cA = (const char*)g.A + (size_t)cur.pm * tstep; const char* cB = (const char*)g.Bt + (size_t)cur.pn * tstep;
    S.a_ready(cur);
    if constexpr (SP2) {
        PG8_STAGE(PG8_SB(0, 0), cB, voffB); PG8_STAGE(PG8_SB(0, 1), cB + hstep, voffB); PG8_STAGE(PG8_SA(0, 0), cA, voffA); PG8_STAGE(PG8_SA(0, 1), cA + hstep, voffA);
        if (wr == 1) PG8_BAR;
        PG8_WAIT_V(2); PG8_BAR;
        PG8_STAGE(PG8_SB(1, 0), cB + kstep, voffB); PG8_STAGE(PG8_SA(1, 0), cA + kstep, voffA); PG8_STAGE(PG8_SB(1, 1), cB + hstep + kstep, voffB);
        PG8_WAIT_V(6); PG8_BAR;
    } else {
        PG8_STAGE(PG8_SB(0, 0), cB, voffB); PG8_STAGE(PG8_SA(0, 0), cA, voffA); PG8_STAGE(PG8_SB(0, 1), cB + hstep, voffB); PG8_STAGE(PG8_SA(0, 1), cA + hstep, voffA);
        if (wr == 1) PG8_BAR;
        PG8_WAIT_V(4); PG8_BAR;
        PG8_STAGE(PG8_SB(1, 0), cB + kstep, voffB); PG8_STAGE(PG8_SA(1, 0), cA + kstep, voffA); PG8_STAGE(PG8_SB(1, 1), cB + hstep + kstep, voffB);
        PG8_WAIT_V(6); PG8_BAR;
    }
    for (;;) {
        const bool has_next = S.next(ui + 1, nxt);
        const char* nA = has_next ? (const char*)g.A + (size_t)nxt.pm * tstep : cA; const char* nB = has_next ? (const char*)g.Bt + (size_t)nxt.pn * tstep : cB;
        for (int t = 0; t < nt; t += 2) {
            const bool last = (t == nt - 2);
            const char* a1 = cA + (size_t)(t + 1) * kstep;
            const char* a2 = last ? nA : cA + (size_t)(t + 2) * kstep; const char* b2 = last ? nB : cB + (size_t)(t + 2) * kstep;
            const char* a3 = a2 + kstep; const char* b3 = b2 + kstep;
            if (last && has_next) S.a_ready(nxt);
            if constexpr (SP2) {
            PG8_LDB(B0, 0, 0); PG8_LDB(B1, 0, 1); PG8_SCHED; PG8_LDA(At, 0, 0); PG8_STAGE(PG8_SA(1, 1), a1 + hstep, voffA);
            PG8_WAIT_V(8); PG8_WAIT_L(0); PG8_BAR; PG8_MMA(0, 0, At, B0); PG8_MMA(0, 1, At, B1); PG8_BAR; PG8_SCHED;
            PG8_LDA(At, 0, 1); PG8_STAGE(PG8_SB(0, 0), b2, voffB); PG8_STAGE(PG8_SB(0, 1), b2 + hstep, voffB); PG8_STAGE(PG8_SA(0, 0), a2, voffA);
            PG8_WAIT_V(8); PG8_WAIT_L(0); PG8_BAR; PG8_MMA(1, 0, At, B0); PG8_MMA(1, 1, At, B1); PG8_BAR; PG8_SCHED;
            PG8_LDB(B0, 1, 0); PG8_LDB(B1, 1, 1); PG8_SCHED; PG8_LDA(At, 1, 0); PG8_STAGE(PG8_SA(0, 1), a2 + hstep, voffA);
            PG8_WAIT_V(8); PG8_WAIT_L(0); PG8_BAR; PG8_MMA(0, 0, At, B0); PG8_MMA(0, 1, At, B1); PG8_BAR; PG8_SCHED;
            PG8_LDA(At, 1, 1); PG8_STAGE(PG8_SB(1, 0), b3, voffB); PG8_STAGE(PG8_SB(1, 1), b3 + hstep, voffB); PG8_STAGE(PG8_SA(1, 0), a3, voffA);
            PG8_WAIT_V(8); PG8_WAIT_L(0); PG8_BAR; PG8_MMA(1, 0, At, B0); PG8_MMA(1, 1, At, B1); PG8_BAR; PG8_SCHED;
            } else {
            PG8_LDB(B0, 0, 0); PG8_SCHED; PG8_LDA(At, 0, 0); PG8_STAGE(PG8_SA(1, 1), a1 + hstep, voffA);
            PG8_WAIT_L(8); PG8_BAR; PG8_WAIT_L(0); PG8_MMA(0, 0, At, B0); PG8_BAR; PG8_SCHED;
            PG8_LDB(B1, 0, 1); PG8_STAGE(PG8_SB(0, 0), b2, voffB);
            PG8_BAR; PG8_WAIT_L(0); PG8_MMA(0, 1, At, B1); PG8_BAR;
            PG8_LDA(At, 0, 1); PG8_STAGE(PG8_SA(0, 0), a2, voffA);
            PG8_BAR; PG8_WAIT_L(0); PG8_MMA(1, 0, At, B0); PG8_BAR; PG8_SCHED;
            PG8_STAGE(PG8_SB(0, 1), b2 + hstep, voffB);
            PG8_WAIT_V(6); PG8_BAR; PG8_MMA(1, 1, At, B1); PG8_BAR;
            PG8_LDB(B0, 1, 0); PG8_SCHED; PG8_LDA(At, 1, 0); PG8_STAGE(PG8_SA(0, 1), a2 + hstep, voffA);
            PG8_WAIT_L(8); PG8_BAR; PG8_WAIT_L(0); PG8_MMA(0, 0, At, B0); PG8_BAR; PG8_SCHED;
            PG8_LDB(B1, 1, 1); PG8_STAGE(PG8_SB(1, 0), b3, voffB);
            PG8_BAR; PG8_WAIT_L(0); PG8_MMA(0, 1, At, B1); PG8_BAR;
            PG8_LDA(At, 1, 1); PG8_STAGE(PG8_SA(1, 0), a3, voffA);
            PG8_BAR; PG8_WAIT_L(0); PG8_MMA(1, 0, At, B0); PG8_BAR; PG8_SCHED;
            PG8_STAGE(PG8_SB(1, 1), b3 + hstep, voffB);
            PG8_WAIT_V(6); PG8_BAR; PG8_MMA(1, 1, At, B1); PG8_BAR;
            }
        }
        if constexpr (ALIGN_EPI) { if (wr == 0) PG8_BAR; }
        if constexpr (!Epi::AFTER_DRAIN) { E(acc, cur, wr, wc, fr, fq); S.done(cur); }
        if (!has_next) break;
#pragma unroll
        for (int a = 0; a < 2; ++a)
#pragma unroll
            for (int b = 0; b < 2; ++b)
#pragma unroll
                for (int m = 0; m < 4; ++m)
#pragma unroll
                    for (int n = 0; n < 2; ++n) acc[a][b][m][n] = (f32x4){0.f, 0.f, 0.f, 0.f};
        cur = nxt; cA = nA; cB = nB; ++ui;
        if constexpr (ALIGN_EPI) { if (wr == 1) PG8_BAR; }
    }
    PG8_WAIT_V(0);
    if constexpr (!ALIGN_EPI) { if (wr == 0) PG8_BAR; }
    PG8_BAR;
    if constexpr (Epi::AFTER_DRAIN) { E.fused(acc, cur, wr, wc, fr, fq, lds, wid, lane); S.done(cur); }
#undef PG8_SA
#undef PG8_SB
#undef PG8_STAGE
#undef PG8_LDA
#undef PG8_LDB
#undef PG8_MMA
#undef PG8_WAIT_V
#undef PG8_WAIT_L
#undef PG8_BAR
#undef PG8_SCHED
}
}
template <int NV>
DI void att_step(const float (&q)[64], const bf16_t* kp, const bf16_t* vp, float bias, float& mx, float& l, float (&o)[NV]) {
    float dot = 0.f;
#pragma unroll
    for (int c = 0; c < 8; ++c) { const u32x4 raw = *(const u32x4*)(kp + c * 8);
#pragma unroll
        for (int j = 0; j < 4; ++j) { dot += q[c * 8 + 2 * j] * __uint_as_float(raw[j] << 16); dot += q[c * 8 + 2 * j + 1] * __uint_as_float(raw[j] & 0xffff0000u); } }
    const float s = dot * 0.125f + bias;
    const float mn = fmaxf(mx, s), corr = expf(mx - mn), pr = expf(s - mn);
    mx = mn; l = l * corr + pr;
#pragma unroll
    for (int c = 0; c < NV / 8; ++c) { const u32x4 raw = *(const u32x4*)(vp + c * 8);
#pragma unroll
        for (int j = 0; j < 4; ++j) { o[c * 8 + 2 * j] = o[c * 8 + 2 * j] * corr + pr * __uint_as_float(raw[j] << 16); o[c * 8 + 2 * j + 1] = o[c * 8 + 2 * j + 1] * corr + pr * __uint_as_float(raw[j] & 0xffff0000u); } }
}
DI void load_q64(float (&q)[64], const bf16_t* qp) {
#pragma unroll
    for (int c = 0; c < 8; ++c) { const u32x4 raw = *(const u32x4*)(qp + c * 8);
#pragma unroll
        for (int j = 0; j < 4; ++j) { q[c * 8 + 2 * j] = __uint_as_float(raw[j] << 16); q[c * 8 + 2 * j + 1] = __uint_as_float(raw[j] & 0xffff0000u); } }
}
DI void phase_na_naive(const P& p) {
    const bf16_t* QKV = (const bf16_t*)(p.ws + WS_H); bf16_t* A = (bf16_t*)(p.ws + WS_A); const float* rpb = p.in[10];
    for (int idx = blockIdx.x * NTHR + otid(); idx < MT * 8; idx += gridDim.x * NTHR) {
        const int head = idx & 7, m = idx >> 3;
        float q[64], o[64]; float mx = -1e30f, l = 0.f;
        load_q64(q, QKV + (size_t)m * LD0 + C_NQ + head * 64);
#pragma unroll
        for (int d = 0; d < 64; ++d) o[d] = 0.f;
        int b;
        if (m < MX) {
            b = m >> 11; const int t = m & 2047, r = t >> 6, c = t & 63;
            const int rs = min(max(r - 4, 0), 24), cs = min(max(c - 8, 0), 48);
#pragma unroll 1
            for (int i = 0; i < 8; ++i)
#pragma unroll 1
                for (int w = 0; w < 16; ++w) { const int rr = rs + i, ww = cs + w; const size_t mk = (size_t)b * 2048 + rr * 64 + ww;
                    const float bias = rpb[(head * 15 + (rr - r + 7)) * 31 + (ww - c + 15)];
                    att_step<64>(q, QKV + mk * LD0 + C_NK + head * 64, QKV + mk * LD0 + C_NV + head * 64, bias, mx, l, o); }
        } else b = (m - MX) >> 8;
#pragma unroll 1
        for (int lk = 0; lk < 256; ++lk) { const size_t mk = (size_t)MX + b * 256 + lk;
            att_step<64>(q, QKV + mk * LD0 + C_NK + head * 64, QKV + mk * LD0 + C_NV + head * 64, 0.f, mx, l, o); }
        const float il = 1.f / l; bf16_t* op = A + (size_t)m * DM + head * 64;
#pragma unroll
        for (int d = 0; d < 64; d += 2) *(unsigned*)(op + d) = pk2(o[d] * il, o[d + 1] * il);
    }
}
DI void phase_gla_naive(const P& p, float* lds) {
    float* sq = lds; float* sk = lds + 4096; float* sa = lds + 8192; float* sv = lds + 12288;
    const bf16_t* QKV = (const bf16_t*)(p.ws + WS_H);
    const int tid = otid();
    for (int chain = blockIdx.x; chain < 64; chain += gridDim.x) {
        const int dir = chain & 1, h = (chain >> 1) & 3, b = chain >> 3;
        const float* wg = p.in[dir ? 13 : 11]; const float* bg = p.in[dir ? 14 : 12];
        bf16_t* O = (bf16_t*)(p.ws + (dir ? WS_OB : WS_OF));
        const int zoff = dir ? C_ZB : C_ZF;
        float S[64];
#pragma unroll
        for (int d = 0; d < 64; ++d) S[d] = 0.f;
        for (int seg = 0; seg < 2; ++seg) {
            const int base = seg == 0 ? MX + b * 256 : b * 2048, n = seg == 0 ? 256 : 2048;
            for (int c = 0; c < n / 64; ++c) {
                for (int idx = tid; idx < 4096; idx += NTHR) { const int i = idx >> 6, d = idx & 63, tp = c * 64 + i, t = dir ? n - 1 - tp : tp;
                    const bf16_t* rowp = QKV + (size_t)(base + t) * LD0;
                    sq[idx] = bf2f(rowp[C_GQ + h * 64 + d]) * 0.125f; sk[idx] = bf2f(rowp[C_GK + h * 64 + d]);
                    float z = bg[h * 64 + d];
#pragma unroll
                    for (int r = 0; r < 16; ++r) z += bf2f(rowp[zoff + r]) * wg[r * 256 + h * 64 + d];
                    const float ls = fminf(z, 0.f) - log1pf(expf(-fabsf(z)));
                    sa[idx] = expf(ls * (1.f / 16.f)); }
                for (int idx = tid; idx < 8192; idx += NTHR) { const int i = idx >> 7, e = idx & 127, tp = c * 64 + i, t = dir ? n - 1 - tp : tp;
                    sv[idx] = bf2f(QKV[(size_t)(base + t) * LD0 + C_GV + h * 128 + e]); }
                __syncthreads();
                if (tid < 128) {
                    const int e = tid;
#pragma unroll 1
                    for (int i = 0; i < 64; ++i) { const float ve = sv[i * 128 + e]; float o = 0.f;
#pragma unroll
                        for (int d = 0; d < 64; ++d) { float sd = sa[i * 64 + d] * S[d];
                            if (dir == 0) { sd += sk[i * 64 + d] * ve; o += sq[i * 64 + d] * sd; } else { o += sq[i * 64 + d] * sd; sd += sk[i * 64 + d] * ve; }
                            S[d] = sd; }
                        const int tp = c * 64 + i, t = dir ? n - 1 - tp : tp;
                        O[(size_t)(base + t) * 512 + h * 128 + e] = f2bf(o); }
                }
                __syncthreads();
            }
        }
    }
}
DI void phase_gla_finalize(const P& p) {
    const int tid = otid(), lane = tid & 63, w = tid >> 6;
    const int gw = blockIdx.x * 8 + w, NGW = gridDim.x * 8;
    const bf16_t* QKV = (const bf16_t*)(p.ws + WS_H); bf16_t* A = (bf16_t*)(p.ws + WS_A);
    const bf16_t* OF = (const bf16_t*)(p.ws + WS_OF); const bf16_t* OB = (const bf16_t*)(p.ws + WS_OB); const float* ng = p.in[15];
    for (int m = gw; m < MT; m += NGW) {
        const u32x4 rf = *(const u32x4*)(OF + (size_t)m * 512 + lane * 8), rb = *(const u32x4*)(OB + (size_t)m * 512 + lane * 8), rg = *(const u32x4*)(QKV + (size_t)m * LD0 + C_GR + lane * 8);
        float s[8], g[8]; float ss = 0.f;
#pragma unroll
        for (int j = 0; j < 4; ++j) { s[2 * j] = __uint_as_float(rf[j] << 16) + __uint_as_float(rb[j] << 16); s[2 * j + 1] = __uint_as_float(rf[j] & 0xffff0000u) + __uint_as_float(rb[j] & 0xffff0000u);
            g[2 * j] = __uint_as_float(rg[j] << 16); g[2 * j + 1] = __uint_as_float(rg[j] & 0xffff0000u); }
#pragma unroll
        for (int j = 0; j < 8; ++j) ss += s[j] * s[j];
        ss += __shfl_xor(ss, 1); ss += __shfl_xor(ss, 2); ss += __shfl_xor(ss, 4); ss += __shfl_xor(ss, 8);
        const float rms = 1.0f / sqrtf(ss * (1.f / 128.f) + LN_EPS);
        float o[8];
#pragma unroll
        for (int j = 0; j < 8; ++j) o[j] = s[j] * rms * ng[(lane & 15) * 8 + j] * silu_f(g[j]);
        u32x4 ov; ov.x = pk2(o[0], o[1]); ov.y = pk2(o[2], o[3]); ov.z = pk2(o[4], o[5]); ov.w = pk2(o[6], o[7]);
        *(u32x4*)(A + (size_t)m * DM + 512 + lane * 8) = ov;
    }
}
DI void phase_rope_naive(const P& p) {
    bf16_t* QKV = (bf16_t*)(p.ws + WS_H); const float* T = (const float*)(p.ws + WS_ROPE);
    for (size_t idx = (size_t)blockIdx.x * NTHR + otid(); idx < (size_t)MX * 1024; idx += (size_t)gridDim.x * NTHR) {
        const int m = (int)(idx >> 10), pi = (int)(idx & 1023), blk = pi >> 5, j = pi & 31, t = m & 2047;
        const int d0 = j < 16 ? j : 32 + (j - 16);
        const float c = T[(t * 32 + j) * 2], s = T[(t * 32 + j) * 2 + 1];
        bf16_t* u = QKV + (size_t)m * LD1 + blk * 64 + d0;
        const float u0 = bf2f(u[0]), u1 = bf2f(u[16]);
        u[0] = f2bf(u0 * c - u1 * s); u[16] = f2bf(u1 * c + u0 * s);
    }
}
DI void phase_diff_naive(const P& p) {
    const bf16_t* QKV = (const bf16_t*)(p.ws + WS_H); bf16_t* A = (bf16_t*)(p.ws + WS_A);
    float d1 = 0.f, d2 = 0.f;
    for (int i = 0; i < 64; ++i) { d1 += p.in[24][i] * p.in[25][i]; d2 += p.in[26][i] * p.in[27][i]; }
    const float lam = expf(d1) - expf(d2) + LAMBDA_INIT;
    const float* sg = p.in[28];
    for (int idx = blockIdx.x * NTHR + otid(); idx < MX * 32; idx += gridDim.x * NTHR) {
        const int quarter = idx & 3, head = (idx >> 2) & 7, m = idx >> 5, b = m >> 11;
        float res[32];
#pragma unroll 1
        for (int br = 0; br < 2; ++br) {
            float q[64], o[32]; float mx = -1e30f, l = 0.f;
            load_q64(q, QKV + (size_t)m * LD1 + head * 128 + br * 64);
#pragma unroll
            for (int e = 0; e < 32; ++e) o[e] = 0.f;
#pragma unroll 1
            for (int key = 0; key < 2304; ++key) { const size_t mk = key < 2048 ? (size_t)b * 2048 + key : (size_t)MX + b * 256 + (key - 2048);
                att_step<32>(q, QKV + mk * LD1 + 1024 + head * 128 + br * 64, QKV + mk * LD1 + 2048 + head * 128 + quarter * 32, 0.f, mx, l, o); }
            const float il = 1.f / l;
            if (br == 0) {
#pragma unroll
                for (int e = 0; e < 32; ++e) res[e] = o[e] * il;
            } else {
#pragma unroll
                for (int e = 0; e < 32; ++e) res[e] -= lam * o[e] * il;
            }
        }
        float ss = 0.f;
#pragma unroll
        for (int e = 0; e < 32; ++e) ss += res[e] * res[e];
        ss += __shfl_xor(ss, 1); ss += __shfl_xor(ss, 2);
        const float rms = 1.0f / sqrtf(ss * (1.f / 128.f) + LN_EPS);
        bf16_t* op = A + (size_t)m * DM + head * 128 + quarter * 32;
#pragma unroll
        for (int e = 0; e < 32; e += 2) *(unsigned*)(op + e) = pk2(res[e] * rms * sg[quarter * 32 + e] * (1.f - LAMBDA_INIT), res[e + 1] * rms * sg[quarter * 32 + e + 1] * (1.f - LAMBDA_INIT));
    }
}


namespace att {
#define ALDS __attribute__((address_space(3)))
typedef short bf16x8 __attribute__((ext_vector_type(8)));
typedef short s16x4 __attribute__((ext_vector_type(4)));
typedef float f32x16 __attribute__((ext_vector_type(16)));
typedef float f32x2_t __attribute__((ext_vector_type(2)));
typedef __bf16 bf16x2_t __attribute__((ext_vector_type(2)));
constexpr int KV_STAGE = 32768;
constexpr int OFF_BIAS = 65536;
constexpr int BIAS_STRIDE = 640;
constexpr int OFF_SG = 65536 + 8192;
constexpr float LOG2E = 1.4426950408889634f;
DI unsigned cvtpk(float lo, float hi) { f32x2_t v = {lo, hi}; bf16x2_t b = __builtin_convertvector(v, bf16x2_t); return __builtin_bit_cast(unsigned, b); }
DI unsigned fxor(unsigned row) { return ((row & 3u) << 2) | ((row >> 2) & 3u); }
DI unsigned off_b(unsigned row, unsigned ch) { return 256u * row + 16u * (ch ^ fxor(row)); }
DI s16x4 vtr(const ALDS unsigned char* p) { typedef short v4i16_t __attribute__((ext_vector_type(4))); return __builtin_bit_cast(s16x4, __builtin_amdgcn_ds_read_tr16_b64_v4i16((ALDS v4i16_t*)p)); }
DI float half_swap(float v) { return __shfl_xor(v, 32); }

template <class RowPtr>
DI void dma_image(ALDS unsigned char* img, int wid, int lane, const RowPtr& rowptr) {
#pragma unroll
    for (int i = 0; i < 2; ++i) { const int ci = 2 * wid + i; const unsigned row = 4u * ci + (lane >> 4), pos = lane & 15, ch = pos ^ fxor(row);
        const unsigned char* src = rowptr((int)row) + 16u * ch;
        __builtin_amdgcn_global_load_lds((const unsigned*)src, (ALDS unsigned*)(img + 1024 * ci), 16, 0, 0); }
}

struct WaveState { float m, l; };

template <int NC, class TFn>
DI void step(f32x16 (&OT)[NC], WaveState& st, const bf16x8 (&qf)[4], const ALDS unsigned char* Kimg, const ALDS unsigned char* Vimg, const unsigned (&kaddr)[4], const unsigned (&vaddr)[NC][2], float cscale, const TFn& tfn) {
    f32x16 S[2];
#pragma unroll
    for (int j = 0; j < 2; ++j) {
#pragma unroll
        for (int r = 0; r < 16; ++r) S[j][r] = 0.f;
#pragma unroll
        for (int d0 = 0; d0 < 4; ++d0) { const bf16x8 kf = *(const ALDS bf16x8*)(Kimg + kaddr[d0] + 8192 * j); S[j] = __builtin_amdgcn_mfma_f32_32x32x16_bf16(kf, qf[d0], S[j], 0, 0, 0); }
    }
    float mx = -1e30f;
#pragma unroll
    for (int j = 0; j < 2; ++j)
#pragma unroll
        for (int r = 0; r < 16; ++r) { S[j][r] = tfn(j, r, S[j][r] * cscale); mx = fmaxf(mx, S[j][r]); }
    mx = fmaxf(mx, half_swap(mx));
    const float mn = fmaxf(st.m, mx), alpha = __builtin_amdgcn_exp2f(st.m - mn);
    st.m = mn;
    float rs = 0.f;
#pragma unroll
    for (int j = 0; j < 2; ++j)
#pragma unroll
        for (int r = 0; r < 16; ++r) { S[j][r] = __builtin_amdgcn_exp2f(S[j][r] - mn); rs += S[j][r]; }
    st.l = st.l * alpha + rs;
    if (__any(alpha != 1.0f)) {
#pragma unroll
        for (int c = 0; c < NC; ++c)
#pragma unroll
            for (int r = 0; r < 16; ++r) OT[c][r] *= alpha;
    }
#pragma unroll
    for (int j = 0; j < 2; ++j)
#pragma unroll
        for (int ks = 0; ks < 2; ++ks) {
            u32x4 pw; pw.x = cvtpk(S[j][8 * ks], S[j][8 * ks + 1]); pw.y = cvtpk(S[j][8 * ks + 2], S[j][8 * ks + 3]); pw.z = cvtpk(S[j][8 * ks + 4], S[j][8 * ks + 5]); pw.w = cvtpk(S[j][8 * ks + 6], S[j][8 * ks + 7]);
            const bf16x8 pf = __builtin_bit_cast(bf16x8, pw);
#pragma unroll
            for (int c = 0; c < NC; ++c) { const s16x4 lo = vtr(Vimg + vaddr[c][0] + 8192 * j + 4096 * ks), hi = vtr(Vimg + vaddr[c][1] + 8192 * j + 4096 * ks);
                const bf16x8 vf = {lo[0], lo[1], lo[2], lo[3], hi[0], hi[1], hi[2], hi[3]};
                OT[c] = __builtin_amdgcn_mfma_f32_32x32x16_bf16(vf, pf, OT[c], 0, 0, 0); }
        }
}
DI void make_kaddr(unsigned (&kaddr)[4], int lane, int ks_base) {
    const unsigned i = lane & 31, h = lane >> 5, rowp = (i & ~12u) | ((i & 4u) << 1) | ((i & 8u) >> 1);
#pragma unroll
    for (int d0 = 0; d0 < 4; ++d0) kaddr[d0] = off_b(rowp, 2u * (ks_base + d0) + h);
}
template <int NC>
DI void make_vaddr(unsigned (&vaddr)[NC][2], int lane, int c_base) {
    const unsigned h = lane >> 5, blk = (lane >> 4) & 1, q = (lane & 15) >> 2, p = lane & 3;
#pragma unroll
    for (int c = 0; c < NC; ++c)
#pragma unroll
        for (int t = 0; t < 2; ++t) vaddr[c][t] = off_b(8u * h + 4u * t + q, 4u * (c_base + c) + 2u * blk + (p >> 1)) + 8u * (p & 1);
}
DI void load_q(bf16x8 (&qf)[4], const bf16_t* qrow, int lane) {
    const int h = lane >> 5;
#pragma unroll
    for (int d0 = 0; d0 < 4; ++d0) qf[d0] = *(const bf16x8*)(qrow + 16 * d0 + 8 * h);
}
#define ATT_WAIT_BAR() do { asm volatile("s_waitcnt vmcnt(0) lgkmcnt(0)" ::: "memory"); __builtin_amdgcn_s_barrier(); asm volatile("" ::: "memory"); } while (0)

DI void phase_diff(const P& p, unsigned char* lds_generic) {
    ALDS unsigned char* lds = (ALDS unsigned char*)lds_generic;
    const int tid = otid(), lane = tid & 63, wid = __builtin_amdgcn_readfirstlane(tid >> 6), g = wid >> 2, qb = wid & 3, h = lane >> 5;
    const bf16_t* QKV = (const bf16_t*)(p.ws + WS_H); bf16_t* A = (bf16_t*)(p.ws + WS_A);
    float d1 = 0.f, d2 = 0.f;
    for (int i = 0; i < 64; ++i) { d1 += p.in[24][i] * p.in[25][i]; d2 += p.in[26][i] * p.in[27][i]; }
    const float lam = expf(d1) - expf(d2) + LAMBDA_INIT;
    ALDS float* sgl = (ALDS float*)(lds + OFF_SG);
    if (tid < 128) sgl[tid] = p.in[28][tid] * (1.f - LAMBDA_INIT);
    unsigned kaddr[4], vaddr[4][2];
    make_kaddr(kaddr, lane, 4 * g); make_vaddr<4>(vaddr, lane, 0);
    const float cscale = 0.125f * LOG2E;
    for (int unit = blockIdx.x; unit < 1024; unit += gridDim.x) {
        const int b = unit >> 7, head = (unit >> 4) & 7, qblk = unit & 15;
        const int mq = b * 2048 + qblk * 128 + qb * 32 + (lane & 31);
        bf16x8 qf[4]; load_q(qf, QKV + (size_t)mq * LD1 + head * 128 + g * 64, lane);
        f32x16 OT[4];
#pragma unroll
        for (int c = 0; c < 4; ++c)
#pragma unroll
            for (int r = 0; r < 16; ++r) OT[c][r] = 0.f;
        WaveState st{-1e30f, 0.f};
        auto issue = [&](int s) {
            ALDS unsigned char* base = lds + (s & 1) * KV_STAGE;
            auto krow = [&](int row) { const int key = s * 64 + row; const size_t m = key < 2048 ? (size_t)b * 2048 + key : (size_t)MX + b * 256 + (key - 2048); return (const unsigned char*)(QKV + m * LD1 + 1024 + head * 128); };
            auto vrow = [&](int row) { const int key = s * 64 + row; const size_t m = key < 2048 ? (size_t)b * 2048 + key : (size_t)MX + b * 256 + (key - 2048); return (const unsigned char*)(QKV + m * LD1 + 2048 + head * 128); };
            dma_image(base, wid, lane, krow); dma_image(base + 16384, wid, lane, vrow);
        };
        issue(0);
#pragma unroll 1
        for (int s = 0; s < 36; ++s) {
            ATT_WAIT_BAR();
            if (s + 1 < 36) issue(s + 1);
            const ALDS unsigned char* base = lds + (s & 1) * KV_STAGE;
            step<4>(OT, st, qf, base, base + 16384, kaddr, vaddr, cscale, [](int, int, float v) { return v; });
        }
        const float inv = 1.0f / (st.l + half_swap(st.l));
        ATT_WAIT_BAR();
        ALDS float* exch = (ALDS float*)lds + qb * 4096;
        if (g == 1) {
#pragma unroll
            for (int c = 0; c < 4; ++c)
#pragma unroll
                for (int r = 0; r < 16; ++r) exch[(c * 16 + r) * 64 + lane] = OT[c][r] * inv;
        }
        ATT_WAIT_BAR();
        if (g == 0) {
            float ss = 0.f;
#pragma unroll
            for (int c = 0; c < 4; ++c)
#pragma unroll
                for (int r = 0; r < 16; ++r) { const float o = OT[c][r] * inv - lam * exch[(c * 16 + r) * 64 + lane]; OT[c][r] = o; ss += o * o; }
            ss += half_swap(ss);
            const float rms = 1.0f / sqrtf(ss * (1.f / 128.f) + LN_EPS);
            bf16_t* orow = A + (size_t)mq * DM + head * 128;
#pragma unroll
            for (int c = 0; c < 4; ++c)
#pragma unroll
                for (int r4 = 0; r4 < 4; ++r4) { const int e0 = 32 * c + 8 * r4 + 4 * h; const f32x4 sg = *(const ALDS f32x4*)(sgl + e0);
                    u32x2 w; w.x = cvtpk(OT[c][4 * r4] * rms * sg[0], OT[c][4 * r4 + 1] * rms * sg[1]); w.y = cvtpk(OT[c][4 * r4 + 2] * rms * sg[2], OT[c][4 * r4 + 3] * rms * sg[3]);
                    *(u32x2*)(orow + e0) = w; }
        }
        ATT_WAIT_BAR();
    }
}

DI void phase_na(const P& p, unsigned char* lds_generic) {
    ALDS unsigned char* lds = (ALDS unsigned char*)lds_generic;
    const int tid = otid(), lane = tid & 63, wid = __builtin_amdgcn_readfirstlane(tid >> 6), g = wid >> 2, qb = wid & 3, h = lane >> 5;
    const bf16_t* QKV = (const bf16_t*)(p.ws + WS_H); bf16_t* A = (bf16_t*)(p.ws + WS_A);
    ALDS float* biasl = (ALDS float*)(lds + OFF_BIAS);
    unsigned kaddr[4], vaddr[2][2];
    make_kaddr(kaddr, lane, 4 * g); make_vaddr<2>(vaddr, lane, 2 * g);
    const float cscale = 0.125f * LOG2E;
    int cur_hp = -1;
    for (int unit = blockIdx.x; unit < 576; unit += gridDim.x) {
        int b, hp, mq, r_q = 0, cq = 0, rs0 = 0, nloc = 0; bool lat = unit < 512;
        if (lat) { b = unit >> 6; hp = (unit >> 4) & 3; const int rp = unit & 15; r_q = 2 * rp + (qb >> 1); cq = 32 * (qb & 1) + (lane & 31);
            mq = b * 2048 + r_q * 64 + cq; rs0 = min(max(2 * rp - 4, 0), 24); const int rs1 = min(max(2 * rp + 1 - 4, 0), 24); nloc = rs1 + 8 - rs0; }
        else { const int u = unit - 512; b = u >> 3; hp = (u >> 1) & 3; mq = MX + b * 256 + (u & 1) * 128 + qb * 32 + (lane & 31); }
        const int head = 2 * hp + g;
        if (hp != cur_hp) {
            ATT_WAIT_BAR();
            for (int i = tid; i < 2 * BIAS_STRIDE; i += NTHR) { const int hh = i / BIAS_STRIDE, k = i % BIAS_STRIDE - 64; biasl[i] = (k >= 0 && k < 465) ? p.in[10][(2 * hp + hh) * 465 + k] * LOG2E : 0.f; }
            cur_hp = hp;
        }
        bf16x8 qf[4]; load_q(qf, QKV + (size_t)mq * LD0 + C_NQ + head * 64, lane);
        f32x16 OT[2];
#pragma unroll
        for (int c = 0; c < 2; ++c)
#pragma unroll
            for (int r = 0; r < 16; ++r) OT[c][r] = 0.f;
        WaveState st{-1e30f, 0.f};
        const int nsteps = nloc + 4;
        auto issue = [&](int s) {
            ALDS unsigned char* base = lds + (s & 1) * KV_STAGE;
            const size_t m0 = s < nloc ? (size_t)b * 2048 + (rs0 + s) * 64 : (size_t)MX + b * 256 + (s - nloc) * 64;
            auto krow = [&](int row) { return (const unsigned char*)(QKV + (m0 + row) * LD0 + C_NK + hp * 128); };
            auto vrow = [&](int row) { return (const unsigned char*)(QKV + (m0 + row) * LD0 + C_NV + hp * 128); };
            dma_image(base, wid, lane, krow); dma_image(base + 16384, wid, lane, vrow);
        };
        issue(0);
        const int rsq = min(max(r_q - 4, 0), 24), cs = min(max(cq - 8, 0), 48);
#pragma unroll 1
        for (int s = 0; s < nsteps; ++s) {
            ATT_WAIT_BAR();
            if (s + 1 < nsteps) issue(s + 1);
            const ALDS unsigned char* base = lds + (s & 1) * KV_STAGE;
            if (s < nloc) {
                const int rr = rs0 + s;
                if (rr >= rsq && rr < rsq + 8) {
                    const ALDS float* bl = biasl + g * BIAS_STRIDE + 64 + (rr - r_q + 7) * 31 + 15 - cq + 8 * h;
                    step<2>(OT, st, qf, base, base + 16384, kaddr, vaddr, cscale, [&](int j, int r, float v) {
                        const int w = 32 * j + 16 * (r >> 3) + 8 * h + (r & 7);
                        const float bv = bl[32 * j + 16 * (r >> 3) + (r & 7)];
                        return ((unsigned)(w - cs) < 16u) ? v + bv : -1e30f; });
                }
            } else step<2>(OT, st, qf, base, base + 16384, kaddr, vaddr, cscale, [](int, int, float v) { return v; });
        }
        const float inv = 1.0f / (st.l + half_swap(st.l));
        bf16_t* orow = A + (size_t)mq * DM + head * 64;
#pragma unroll
        for (int c = 0; c < 2; ++c)
#pragma unroll
            for (int r4 = 0; r4 < 4; ++r4) { const int e0 = 32 * c + 8 * r4 + 4 * h;
                u32x2 w; w.x = cvtpk(OT[c][4 * r4] * inv, OT[c][4 * r4 + 1] * inv); w.y = cvtpk(OT[c][4 * r4 + 2] * inv, OT[c][4 * r4 + 3] * inv);
                *(u32x2*)(orow + e0) = w; }
        ATT_WAIT_BAR();
    }
    ATT_WAIT_BAR();
}
#undef ALDS
}

__global__ void __launch_bounds__(NTHR) mk_fwd(P p) {
    extern __shared__ __attribute__((aligned(16))) unsigned char lds_raw[];
    float* lds = (float*)lds_raw;
    cg::grid_group grid = cg::this_grid();
    int ph = 0;
#define RUN(...) do { if (ph >= p.ph_lo && ph < p.ph_hi) { __VA_ARGS__; if (ph + 1 < p.ph_hi) grid.sync(); } ++ph; } while (0)
    bf16_t* A = (bf16_t*)(p.ws + WS_A); bf16_t* H = (bf16_t*)(p.ws + WS_H);

    RUN({ phase_adaln(p, lds); phase_rope_table(p); phase_convert(p, lds); });
    RUN(phase_rowpass(p, false, 0, false, true, 0, 0, 1, MT));
    __attribute__((address_space(3))) unsigned char* glds = (__attribute__((address_space(3))) unsigned char*)lds_raw;
    float* XH = (float*)(p.ws + WS_XH); const float* ROPE = (const float*)(p.ws + WS_ROPE);
    const int G = (int)gridDim.x, cid = (int)blockIdx.x;
#define GEMM_SWIGLU(Aop, Wt, Mrows) do { pg8::Gemm g{Aop, Wt, Mrows, 2 * DFF, DM}; pg8::StaticOrder S; S.init(Mrows, 2 * DFF, G, cid); pg8::EpiSwigluF E{H, DFF}; \
        pg8::gemm_phase<pg8::EpiSwigluF, pg8::StaticOrder, true, true>(glds, g, S, E); } while (0)
#define GEMM_STORE(Aop, Wt, Mrows, N, ropet) do { pg8::Gemm g{Aop, Wt, Mrows, N, DM}; pg8::StaticOrder S; S.init(Mrows, N, G, cid); pg8::EpiStoreF E{H, N, ROPE, ropet, MX}; \
        pg8::gemm_phase<pg8::EpiStoreF, pg8::StaticOrder, true, true>(glds, g, S, E); } while (0)
#define GEMM_RESID(Aop, Wt, Mrows, K, xi, hi, chunk, sc) do { pg8::Gemm g{Aop, Wt, Mrows, DM, K}; pg8::StaticOrder S; S.init(Mrows, DM, G, cid); \
        pg8::EpiResidF E{xi, hi, p.out, XH, mod_ptr(p, l, 0, chunk), mod_ptr(p, l, 8, chunk), sc, ALPHA}; \
        pg8::gemm_phase<pg8::EpiResidF, pg8::StaticOrder, true, true>(glds, g, S, E); } while (0)
#pragma unroll 1
    for (int l = 0; l < 2; ++l) {
        RUN(GEMM_SWIGLU(A, wt_ptr(p, l, WT_F1I), MT));
        RUN(GEMM_RESID(H, wt_ptr(p, l, WT_F1O), MT, DFF, (l == 0 ? p.in[0] : (const float*)p.out), (l == 0 ? p.in[2] : (const float*)XH), 2, 0.5f));
        RUN(phase_rowpass(p, true, 1, true, true, l, 3, 4, MT));
        if (l == 0) {
            RUN(GEMM_STORE(A, wt_ptr(p, l, WT_MI), MT, LD0, 0));
            RUN({ phase_gla_naive(p, lds); __syncthreads(); att::phase_na(p, lds_raw); });
            RUN(phase_gla_finalize(p));
        } else {
            RUN(GEMM_STORE(A, wt_ptr(p, l, WT_MI), MT, LD1, 8));
            RUN(att::phase_diff(p, lds_raw));
        }
        const int Mrows = l == 0 ? MT : MX;
        RUN(GEMM_RESID(A, wt_ptr(p, l, WT_MO), Mrows, DM, (const float*)p.out, (const float*)XH, 5, 1.0f));
        RUN(phase_rowpass(p, true, 1, true, true, l, 6, 7, Mrows));
        RUN(GEMM_SWIGLU(A, wt_ptr(p, l, WT_F2I), Mrows));
        RUN(GEMM_RESID(H, wt_ptr(p, l, WT_F2O), Mrows, DFF, (const float*)p.out, (const float*)XH, 8, 0.5f));
        RUN(phase_rowpass(p, true, 1, true, l == 0, 1, 0, 1, Mrows));
    }
#undef RUN
}

extern "C" void kernel_launch(void* const* d_in, const int* in_sizes, int n_in, void* d_out, int out_size, void* d_ws, size_t ws_size, hipStream_t stream) {
    static int grid = 0;
    if (grid == 0) {
        if (n_in != 31 || out_size != MX * DM || ws_size < WS_END) { fprintf(stderr, "kernel_launch: unexpected shapes (n_in %d out %d ws %zu)\n", n_in, out_size, ws_size); grid = -1; return; }
        int dev = 0, cus = 0, per_cu = 0;
        hipGetDevice(&dev); hipDeviceGetAttribute(&cus, hipDeviceAttributeMultiprocessorCount, dev);
        hipFuncSetAttribute((const void*)mk_fwd, hipFuncAttributeMaxDynamicSharedMemorySize, LDS_BYTES);
        hipOccupancyMaxActiveBlocksPerMultiprocessor(&per_cu, (const void*)mk_fwd, NTHR, LDS_BYTES);
        if (per_cu < 1) { fprintf(stderr, "kernel_launch: occupancy query says %d blocks per CU\n", per_cu); grid = -1; return; }
        grid = cus;
    }
    if (grid < 0) return;
    P p{};
    for (int i = 0; i < 31; ++i) p.in[i] = (const float*)d_in[i];
    p.out = (float*)d_out; p.ws = (unsigned char*)d_ws; p.ph_lo = 0; p.ph_hi = 1000;
    void* args[] = {&p};
    hipError_t e = hipLaunchCooperativeKernel((const void*)mk_fwd, dim3(grid), dim3(NTHR), args, LDS_BYTES, stream);
    if (e != hipSuccess) fprintf(stderr, "cooperative launch failed: %s (grid %d)\n", hipGetErrorString(e), grid);
}
```

```cpp
#include <hip/hip_runtime.h>
#include <hip/hip_cooperative_groups.h>
#include <cstdio>
#include <cstdint>
namespace cg = cooperative_groups;

typedef unsigned short bf16_t;
typedef float f32x4 __attribute__((ext_vector_type(4)));
typedef unsigned u32x4 __attribute__((ext_vector_type(4)));
typedef unsigned u32x2 __attribute__((ext_vector_type(2)));
#define DI __device__ __forceinline__

constexpr int NB = 8, SEQ = 2048, CTXL = 256, DM = 1024, DFF = 2816;
constexpr int MX = NB * SEQ, MH = NB * CTXL, MT = MX + MH;
constexpr float ALPHA = 1.41421356237309515f;
constexpr float LN_EPS = 1e-6f;
constexpr float LAMBDA_INIT = 0.35550906759f;
constexpr int NTHR = 512;

constexpr int LD0 = 3328, C_NQ = 0, C_NK = 512, C_NV = 1024, C_GQ = 1536, C_GK = 1792, C_GV = 2048, C_GR = 2560, C_ZF = 3072, C_ZB = 3088;
constexpr int LD1 = 3072;

constexpr size_t MiB = 1u << 20;
constexpr size_t WS_MOD = 0;
constexpr size_t WS_ROPE = 1 * MiB;
constexpr size_t WS_XH = 2 * MiB;
constexpr size_t WS_WT = 10 * MiB;
constexpr size_t WT_LAYER = 42 * MiB;
constexpr size_t WT_F1I = 0, WT_F1O = 11 * MiB, WT_MI = 16 * MiB + MiB / 2, WT_MO = 23 * MiB, WT_F2I = 25 * MiB, WT_F2O = 36 * MiB;
constexpr size_t WS_A = 94 * MiB;
constexpr size_t WS_H = 130 * MiB;
constexpr size_t WS_OF = 247 * MiB;
constexpr size_t WS_OB = 265 * MiB;
constexpr size_t WS_END = 284 * MiB;

constexpr int LDS_BYTES = 147456;

struct P { const float* in[31]; float* out; unsigned char* ws; int ph_lo, ph_hi; };

DI float bf2f(bf16_t h) { return __uint_as_float(((unsigned)h) << 16); }
DI bf16_t f2bf(float f) { unsigned u = __float_as_uint(f); return (bf16_t)((u + 0x7fffu + ((u >> 16) & 1u)) >> 16); }
DI unsigned pk2(float lo, float hi) { return (unsigned)f2bf(lo) | ((unsigned)f2bf(hi) << 16); }
DI float silu_f(float v) { return v / (1.f + expf(-v)); }
DI float wave_sum(float v) {
#pragma unroll
    for (int o = 1; o < 64; o <<= 1) v += __shfl_xor(v, o);
    return v;
}
DI int otid() { int t = threadIdx.x; asm volatile("" : "+v"(t)); return t; }
DI float* xres_ptr(const P& p, int m) { return m < MX ? p.out + (size_t)m * DM : (float*)(p.ws + WS_XH) + (size_t)(m - MX) * DM; }
DI const float* xin_ptr(const P& p, int m) { return m < MX ? p.in[0] + (size_t)m * DM : p.in[2] + (size_t)(m - MX) * DM; }
DI int modrow(int m) { return m < MX ? (m >> 11) : 8; }
DI const float* mod_ptr(const P& p, int l, int r, int chunk) { return (const float*)(p.ws + WS_MOD) + ((size_t)(l * 9 + r) * 9 + chunk) * DM; }
DI bf16_t* wt_ptr(const P& p, int l, size_t off) { return (bf16_t*)(p.ws + WS_WT + (size_t)l * WT_LAYER + off); }

DI void phase_adaln(const P& p, float* lds) {
    float* sc = lds; float* red = lds + 9 * 1024;
    const int tid = otid(), lane = tid & 63, w = tid >> 6;
    for (int i = tid; i < 9 * 1024; i += NTHR) { const int r = i >> 10, k = i & 1023; const float v = r < 8 ? p.in[1][r * 1024 + k] : p.in[3][k]; sc[i] = silu_f(v); }
    __syncthreads();
    for (int item = blockIdx.x; item < 288; item += gridDim.x) {
        const int l = item / 144, cb = item % 144, n = cb * 64 + lane;
        const float* W = p.in[l ? 18 : 4]; const float* bb = p.in[l ? 19 : 5];
        float acc[9];
#pragma unroll
        for (int r = 0; r < 9; ++r) acc[r] = 0.f;
#pragma unroll 4
        for (int k = w * 128; k < w * 128 + 128; ++k) { const float wv = W[(size_t)k * 9216 + n];
#pragma unroll
            for (int r = 0; r < 9; ++r) acc[r] += sc[r * 1024 + k] * wv; }
#pragma unroll
        for (int r = 0; r < 9; ++r) red[(w * 9 + r) * 64 + lane] = acc[r];
        __syncthreads();
        float* MOD = (float*)(p.ws + WS_MOD);
        for (int o = tid; o < 576; o += NTHR) { const int r = o >> 6, c = o & 63; float s = bb[cb * 64 + c];
#pragma unroll
            for (int w2 = 0; w2 < 8; ++w2) s += red[(w2 * 9 + r) * 64 + c];
            MOD[(size_t)(l * 9 + r) * 9216 + cb * 64 + c] = s; }
        __syncthreads();
    }
}
DI void phase_rope_table(const P& p) {
    float* T = (float*)(p.ws + WS_ROPE);
    for (int idx = blockIdx.x * NTHR + otid(); idx < 2048 * 32; idx += gridDim.x * NTHR) {
        const int t = idx >> 5, j = idx & 31, fi = j & 15; const float pos = (float)(j < 16 ? (t >> 6) : (t & 63));
        const float inv = powf(10000.f, -(float)(2 * fi) / 32.f); const float ang = pos * inv;
        T[idx * 2] = cosf(ang); T[idx * 2 + 1] = sinf(ang);
    }
}
DI void conv_item(const float* W, int K, int Nsrc, int src0, bf16_t* WT, int n0dst, int k0, float* scr, int lane) {
    if (src0 >= 0) {
#pragma unroll 8
        for (int i = 0; i < 32; ++i) { const int kk = 2 * i + (lane >> 5); scr[kk * 33 + (lane & 31)] = W[(size_t)(k0 + kk) * Nsrc + src0 + (lane & 31)]; }
    } else {
#pragma unroll 8
        for (int i = 0; i < 32; ++i) { const int kk = 2 * i + (lane >> 5); scr[kk * 33 + (lane & 31)] = 0.f; }
    }
    asm volatile("s_waitcnt lgkmcnt(0)" ::: "memory");
    const int c = lane & 7;
#pragma unroll
    for (int j = 0; j < 4; ++j) { const int n = (lane >> 3) + 8 * j; const float* s = scr + (8 * c) * 33 + n;
        u32x4 o; o.x = pk2(s[0 * 33], s[1 * 33]); o.y = pk2(s[2 * 33], s[3 * 33]); o.z = pk2(s[4 * 33], s[5 * 33]); o.w = pk2(s[6 * 33], s[7 * 33]);
        *(u32x4*)(WT + (size_t)(n0dst + n) * K + k0 + 8 * c) = o; }
    asm volatile("s_waitcnt lgkmcnt(0)" ::: "memory");
}
DI void conv_matrix_item(const float* W, int K, int Nsrc, int Ndst, int kind, bf16_t* WT, int item, float* scr, int lane) {
    const int nblk = Ndst / 32, kb = item / nblk, nb = item % nblk, n0 = nb * 32;
    int src0;
    if (kind == 1) { const int t = n0 >> 8, j = n0 & 255; src0 = j < 128 ? 128 * t + j : DFF + 128 * t + (j - 128); }
    else src0 = n0 < Nsrc ? n0 : -1;
    conv_item(W, K, Nsrc, src0, WT, n0, kb * 64, scr, lane);
}
DI void phase_convert(const P& p, float* lds) {
    const int tid = otid(), lane = tid & 63, w = tid >> 6;
    float* scr = lds + w * (64 * 33 + 16);
    const int gw = blockIdx.x * 8 + w, NGW = gridDim.x * 8;
    for (int l = 0; l < 2; ++l) {
        const int b = l ? 18 : 4;
        const int nmi = l ? 3072 : 3104, nmid = l ? 3072 : 3328;
        const int i0 = 16 * 176, i1 = 44 * 32, i2 = 16 * (nmid / 32), i3 = 16 * 32;
        const int total = i0 + i1 + i2 + i3 + i0 + i1;
        for (int it = gw; it < total; it += NGW) {
            int r = it;
            if (r < i0) { conv_matrix_item(p.in[b + 2], 1024, 5632, 5632, 1, wt_ptr(p, l, WT_F1I), r, scr, lane); continue; } r -= i0;
            if (r < i1) { conv_matrix_item(p.in[b + 3], 2816, 1024, 1024, 0, wt_ptr(p, l, WT_F1O), r, scr, lane); continue; } r -= i1;
            if (r < i2) { conv_matrix_item(p.in[b + 4], 1024, nmi, nmid, 0, wt_ptr(p, l, WT_MI), r, scr, lane); continue; } r -= i2;
            if (r < i3) { conv_matrix_item(p.in[b + 5], 1024, 1024, 1024, 0, wt_ptr(p, l, WT_MO), r, scr, lane); continue; } r -= i3;
            const int f2 = l ? 29 : 16;
            if (r < i0) { conv_matrix_item(p.in[f2], 1024, 5632, 5632, 1, wt_ptr(p, l, WT_F2I), r, scr, lane); continue; } r -= i0;
            conv_matrix_item(p.in[f2 + 1], 2816, 1024, 1024, 0, wt_ptr(p, l, WT_F2O), r, scr, lane);
        }
    }
}

DI void phase_rowpass(const P& p, bool do_ln, int src_mode, bool write_x, bool write_a, int l_mod, int ch_shift, int ch_scale, int M) {
    const int tid = otid(), lane = tid & 63, w = tid >> 6;
    const int gw = blockIdx.x * 8 + w, NGW = gridDim.x * 8;
    bf16_t* A = (bf16_t*)(p.ws + WS_A);
    for (int m = gw; m < M; m += NGW) {
        const f32x4* src = (const f32x4*)(src_mode == 0 ? xin_ptr(p, m) : (const float*)xres_ptr(p, m)) + lane;
        f32x4 v[4]; float s = 0.f;
#pragma unroll
        for (int j = 0; j < 4; ++j) { v[j] = src[64 * j]; s += (v[j].x + v[j].y) + (v[j].z + v[j].w); }
        if (do_ln) {
            const float mean = wave_sum(s) * (1.f / DM); float s2 = 0.f;
#pragma unroll
            for (int j = 0; j < 4; ++j) { v[j] = v[j] - mean; s2 += (v[j].x * v[j].x + v[j].y * v[j].y) + (v[j].z * v[j].z + v[j].w * v[j].w); }
            const float rstd = 1.0f / sqrtf(wave_sum(s2) * (1.f / DM) + LN_EPS);
#pragma unroll
            for (int j = 0; j < 4; ++j) v[j] = v[j] * rstd;
        }
        if (write_x) { f32x4* dst = (f32x4*)xres_ptr(p, m) + lane;
#pragma unroll
            for (int j = 0; j < 4; ++j) dst[64 * j] = v[j]; }
        if (write_a) {
            const f32x4* sh = (const f32x4*)mod_ptr(p, l_mod, modrow(m), ch_shift) + lane; const f32x4* scp = (const f32x4*)mod_ptr(p, l_mod, modrow(m), ch_scale) + lane;
            u32x2* o8 = (u32x2*)(A + (size_t)m * DM) + lane;
#pragma unroll
            for (int j = 0; j < 4; ++j) { const f32x4 a = v[j] * (scp[64 * j] + 1.0f) + sh[64 * j]; u32x2 o; o.x = pk2(a.x, a.y); o.y = pk2(a.z, a.w); o8[64 * j] = o; }
        }
    }
}

template <class Epi>
DI void naive_gemm(const bf16_t* A, const bf16_t* Wt, int M, int N, int K, const Epi& epi, float* lds) {
    float* sA = lds; float* sB = lds + 32 * 132;
    const int tid = otid(), tx = tid & 31, ty = tid >> 5;
    const int ntn = N / 256, ntm = M / 128, ntiles = ntm * ntn;
    for (int tile = blockIdx.x; tile < ntiles; tile += gridDim.x) {
        const int tn = tile % ntn, tm = tile / ntn, m0 = tm * 128, n0 = tn * 256;
        float acc[8][8];
#pragma unroll
        for (int i = 0; i < 8; ++i)
#pragma unroll
            for (int j = 0; j < 8; ++j) acc[i][j] = 0.f;
        for (int k0 = 0; k0 < K; k0 += 32) {
            const int row = tid >> 2, kc = (tid & 3) * 8;
            { const u32x4 raw = *(const u32x4*)(A + (size_t)(m0 + row) * K + k0 + kc);
#pragma unroll
              for (int j = 0; j < 4; ++j) { sA[(kc + 2 * j) * 132 + row] = __uint_as_float(raw[j] << 16); sA[(kc + 2 * j + 1) * 132 + row] = __uint_as_float(raw[j] & 0xffff0000u); } }
#pragma unroll
            for (int h = 0; h < 2; ++h) { const int rb = row + 128 * h; const u32x4 raw = *(const u32x4*)(Wt + (size_t)(n0 + rb) * K + k0 + kc);
#pragma unroll
              for (int j = 0; j < 4; ++j) { sB[(kc + 2 * j) * 264 + rb] = __uint_as_float(raw[j] << 16); sB[(kc + 2 * j + 1) * 264 + rb] = __uint_as_float(raw[j] & 0xffff0000u); } }
            __syncthreads();
#pragma unroll 4
            for (int kk = 0; kk < 32; ++kk) {
                const f32x4 a0 = *(const f32x4*)&sA[kk * 132 + ty * 8], a1 = *(const f32x4*)&sA[kk * 132 + ty * 8 + 4];
                const f32x4 b0 = *(const f32x4*)&sB[kk * 264 + tx * 4], b1 = *(const f32x4*)&sB[kk * 264 + 128 + tx * 4];
                const float a[8] = {a0.x, a0.y, a0.z, a0.w, a1.x, a1.y, a1.z, a1.w}; const float b[8] = {b0.x, b0.y, b0.z, b0.w, b1.x, b1.y, b1.z, b1.w};
#pragma unroll
                for (int i = 0; i < 8; ++i)
#pragma unroll
                    for (int j = 0; j < 8; ++j) acc[i][j] += a[i] * b[j];
            }
            __syncthreads();
        }
#pragma unroll
        for (int i = 0; i < 8; ++i)
#pragma unroll
            for (int j = 0; j < 4; ++j) epi.pair(m0 + ty * 8 + i, tn, tx * 4 + j, acc[i][j], acc[i][4 + j]);
    }
}
struct EpiSwiglu { bf16_t* H; DI void pair(int m, int t, int c, float va, float vg) const { H[(size_t)m * DFF + t * 128 + c] = f2bf(silu_f(va) * vg); } };
struct EpiStore { bf16_t* O; int ld; DI void pair(int m, int t, int c, float va, float vg) const { O[(size_t)m * ld + t * 256 + c] = f2bf(va); O[(size_t)m * ld + t * 256 + 128 + c] = f2bf(vg); } };
struct EpiResid { const P* p; int src_mode, l, chunk; float scale;
    DI void one(int m, int n, float v) const { const float* res = src_mode ? (const float*)xres_ptr(*p, m) : xin_ptr(*p, m); const float g = mod_ptr(*p, l, modrow(m), chunk)[n]; xres_ptr(*p, m)[n] = ALPHA * res[n] + g * scale * v; }
    DI void pair(int m, int t, int c, float va, float vg) const { one(m, t * 256 + c, va); one(m, t * 256 + 128 + c, vg); } };

namespace pg8 {
#define PG8_LAS __attribute__((address_space(3)))
typedef unsigned short bf16_t;
typedef short bf16x8 __attribute__((ext_vector_type(8)));
typedef float f32x4 __attribute__((ext_vector_type(4)));
typedef unsigned u32x4 __attribute__((ext_vector_type(4)));
constexpr int BM = 256, BK = 64, HALF = 128, HTB = HALF * BK * 2  , STAGE_BYTES = 8 * HTB, NXCD = 8, WGM = 8;

__host__ __device__ __forceinline__ int lds_byte(int r, int c) { const int st = (r >> 4) * 2 + (c >> 5), rr = r & 15, cc = c & 31, ob = rr * 64 + cc * 2; return st * 1024 + (ob ^ (((ob >> 9) & 1) << 5)); }
__host__ __device__ __forceinline__ void stage_rc(int b, int& R, int& C) { const int st = b / 1024, sb = b % 1024, swz = sb ^ (((sb >> 9) & 1) << 5); R = (st >> 1) * 16 + swz / 64; C = (st & 1) * 32 + (swz % 64) / 2; }
__host__ __device__ __forceinline__ int perm32(int rho) { const int n = rho >> 4, i = rho & 15; return 8 * (i >> 2) + 4 * n + (i & 3); }

struct Unit { int pm, pn; };
struct Gemm { const bf16_t* A; const bf16_t* Bt; int M, N, K; };

struct StaticOrder {
    int nM, nN, nwg, G, c;
    __host__ __device__ void init(int M, int N, int G_, int c_) { nM = M / BM; nN = N / BM; nwg = nM * nN; G = G_; c = c_; }
    __host__ __device__ bool next(int i, Unit& u) const {
        const long L = (long)i * G + c; if (L >= nwg) return false;
        int wgid = (int)L; { const int q = nwg / NXCD, r = nwg % NXCD, xcd = wgid % NXCD, off = wgid / NXCD; wgid = (xcd < r ? xcd * (q + 1) : r * (q + 1) + (xcd - r) * q) + off; }
        const int nig = WGM * nN, gid = wgid / nig, fm = gid * WGM, gsz = (nM - fm) < WGM ? (nM - fm) : WGM;
        u.pm = fm + ((wgid % nig) % gsz); u.pn = (wgid % nig) / gsz; return true;
    }
    __device__ __forceinline__ void a_ready(const Unit&) const {}
    __device__ __forceinline__ void done(const Unit&) const {}
};

__device__ __forceinline__ unsigned cvt_pk_bf16(float lo, float hi) { unsigned r; asm volatile("v_cvt_pk_bf16_f32 %0, %1, %2" : "=v"(r) : "v"(lo), "v"(hi)); return r; }
__device__ __forceinline__ float fast_silu(float a) { return a * __builtin_amdgcn_rcpf(1.0f + __builtin_amdgcn_exp2f(-1.4426950408889634f * a)); }
struct EpiSwigluF {
    static constexpr bool PERM = true, AFTER_DRAIN = false;
    bf16_t* H; int ldh;
    __device__ __forceinline__ void operator()(const f32x4 (&acc)[2][2][4][2], const Unit& u, int wr, int wc, int fr, int fq) const {
        const int row0 = u.pm * BM + wr * 64 + fr, col0 = u.pn * HALF + wc * 32 + 8 * fq;
#pragma unroll
        for (int ai = 0; ai < 2; ++ai)
#pragma unroll
            for (int m = 0; m < 4; ++m) { bf16_t* rowp = H + (size_t)(row0 + ai * HALF + m * 16) * ldh + col0;
                const f32x4 a0 = acc[ai][0][m][0], a1 = acc[ai][0][m][1], g0 = acc[ai][1][m][0], g1 = acc[ai][1][m][1];
                u32x4 w; w.x = cvt_pk_bf16(fast_silu(a0[0]) * g0[0], fast_silu(a0[1]) * g0[1]); w.y = cvt_pk_bf16(fast_silu(a0[2]) * g0[2], fast_silu(a0[3]) * g0[3]);
                w.z = cvt_pk_bf16(fast_silu(a1[0]) * g1[0], fast_silu(a1[1]) * g1[1]); w.w = cvt_pk_bf16(fast_silu(a1[2]) * g1[2], fast_silu(a1[3]) * g1[3]);
                *(u32x4*)rowp = w; }
    }
};
struct EpiStoreF {
    static constexpr bool PERM = true, AFTER_DRAIN = false;
    bf16_t* O; int ld; const float* T; int rope_tiles, rope_rows;
    __device__ __forceinline__ void operator()(const f32x4 (&acc)[2][2][4][2], const Unit& u, int wr, int wc, int fr, int fq) const {
        const int row0 = u.pm * BM + wr * 64 + fr, col0 = u.pn * BM + wc * 32 + 8 * fq;
        const bool rope = (u.pn < rope_tiles) && (u.pm * BM < rope_rows);
        const int jt = (wc & 1) * 16 + ((8 * fq) & 15);
        const float sgn = fq < 2 ? -1.f : 1.f;
#pragma unroll
        for (int ai = 0; ai < 2; ++ai)
#pragma unroll
            for (int m = 0; m < 4; ++m) { const int row = row0 + ai * HALF + m * 16; bf16_t* rowp = O + (size_t)row * ld + col0;
#pragma unroll
                for (int bj = 0; bj < 2; ++bj) { f32x4 v0 = acc[ai][bj][m][0], v1 = acc[ai][bj][m][1];
                    if (rope) {
                        const f32x4* tp = (const f32x4*)(T + ((size_t)(row & 2047) * 32 + jt) * 2);
                        const f32x4 t0 = tp[0], t1 = tp[1], t2 = tp[2], t3 = tp[3];
                        f32x4 p0, p1;
#pragma unroll
                        for (int j = 0; j < 4; ++j) { p0[j] = __shfl_xor(v0[j], 32); p1[j] = __shfl_xor(v1[j], 32); }
                        v0 = (f32x4){v0[0] * t0[0] + sgn * p0[0] * t0[1], v0[1] * t0[2] + sgn * p0[1] * t0[3], v0[2] * t1[0] + sgn * p0[2] * t1[1], v0[3] * t1[2] + sgn * p0[3] * t1[3]};
                        v1 = (f32x4){v1[0] * t2[0] + sgn * p1[0] * t2[1], v1[1] * t2[2] + sgn * p1[1] * t2[3], v1[2] * t3[0] + sgn * p1[2] * t3[1], v1[3] * t3[2] + sgn * p1[3] * t3[3]};
                    }
                    u32x4 w; w.x = cvt_pk_bf16(v0[0], v0[1]); w.y = cvt_pk_bf16(v0[2], v0[3]); w.z = cvt_pk_bf16(v1[0], v1[1]); w.w = cvt_pk_bf16(v1[2], v1[3]);
                    *(u32x4*)(rowp + bj * HALF) = w; } }
    }
};
struct EpiResidF {
    static constexpr bool PERM = false, AFTER_DRAIN = false;
    const float* xi; const float* hi; float* xo; float* ho; const float* gx; const float* gh; float scale, alpha;
    __device__ __forceinline__ void operator()(const f32x4 (&acc)[2][2][4][2], const Unit& u, int wr, int wc, int fr, int fq) const {
        const bool lat = u.pm < 64;
        const int rowt = (lat ? u.pm : u.pm - 64) * BM + wr * 64 + fr, col0 = u.pn * BM + wc * 32 + 4 * fq;
        const float* ri = lat ? xi : hi; float* ro = lat ? xo : ho; const float* g = lat ? gx + (size_t)9216 * (u.pm >> 3) : gh;
        f32x4 gv[2][2];
#pragma unroll
        for (int bj = 0; bj < 2; ++bj)
#pragma unroll
            for (int n = 0; n < 2; ++n) gv[bj][n] = *(const f32x4*)(g + col0 + bj * HALF + n * 16) * scale;
#pragma unroll
        for (int ai = 0; ai < 2; ++ai)
#pragma unroll
            for (int m = 0; m < 4; ++m) { const size_t off = (size_t)(rowt + ai * HALF + m * 16) * 1024 + col0;
#pragma unroll
                for (int bj = 0; bj < 2; ++bj)
#pragma unroll
                    for (int n = 0; n < 2; ++n) { const f32x4 r = *(const f32x4*)(ri + off + bj * HALF + n * 16);
                        *(f32x4*)(ro + off + bj * HALF + n * 16) = r * alpha + gv[bj][n] * acc[ai][bj][m][n]; } }
    }
};

template <class Epi, class Sched, bool ALIGN_EPI = false, bool SP2 = false>
__device__ __forceinline__ void gemm_phase(PG8_LAS unsigned char* lds, const Gemm g, const Sched& S, const Epi& E) {
    const int tid = otid(), wid = __builtin_amdgcn_readfirstlane(tid >> 6), lane = tid & 63, wr = wid >> 2, wc = wid & 3, fr = lane & 15, fq = lane >> 4;
    const int K = g.K, nt = K / BK;
    unsigned voffA[2], voffB[2];
#pragma unroll
    for (int i = 0; i < 2; ++i) { int R, C; stage_rc(tid * 16 + i * 8192, R, C); const int Rb = Epi::PERM ? ((R & ~31) + perm32(R & 31)) : R;
        voffA[i] = (unsigned)(R * K + C) * 2u; voffB[i] = (unsigned)(Rb * K + C) * 2u; }
    const size_t kstep = (size_t)(BK * 2);
    const size_t hstep = (size_t)HALF * K * 2;
    const size_t tstep = 2 * hstep;
    const unsigned ldsw = (unsigned)wid * 1024u;
    const int aoff = lds_byte(wr * 64 + fr, fq * 8), boff = lds_byte(wc * 32 + fr, fq * 8);
#define PG8_SA(b, h) (((b) * 2 + (h)) * HTB)
#define PG8_SB(b, h) ((4 + (b) * 2 + (h)) * HTB)
#define PG8_STAGE(bufoff, gbase, voff) do { _Pragma("unroll") for (int _i = 0; _i < 2; ++_i) \
        __builtin_amdgcn_global_load_lds((const unsigned*)((const char*)(gbase) + (voff)[_i]), (PG8_LAS unsigned*)(lds + (bufoff) + ldsw + _i * 8192), 16, 0, 0); } while (0)
#define PG8_LDA(dst, b, h) do { _Pragma("unroll") for (int m = 0; m < 4; ++m) _Pragma("unroll") for (int k = 0; k < 2; ++k) dst[m][k] = *(const PG8_LAS bf16x8*)(lds + PG8_SA(b, h) + aoff + m * 2048 + k * 1024); } while (0)
#define PG8_LDB(dst, b, h) do { _Pragma("unroll") for (int n = 0; n < 2; ++n) _Pragma("unroll") for (int k = 0; k < 2; ++k) dst[n][k] = *(const PG8_LAS bf16x8*)(lds + PG8_SB(b, h) + boff + n * 2048 + k * 1024); } while (0)
#define PG8_MMA(ai, bj, At, Bt) do { __builtin_amdgcn_s_setprio(1); _Pragma("unroll") for (int m = 0; m < 4; ++m) _Pragma("unroll") for (int n = 0; n < 2; ++n) _Pragma("unroll") for (int k = 0; k < 2; ++k) \
        acc[ai][bj][m][n] = __builtin_amdgcn_mfma_f32_16x16x32_bf16(Bt[n][k], At[m][k], acc[ai][bj][m][n], 0, 0, 0); __builtin_amdgcn_s_setprio(0); } while (0)
#define PG8_WAIT_V(n) asm volatile("s_waitcnt vmcnt(" #n ")" ::: "memory")
#define PG8_WAIT_L(n) asm volatile("s_waitcnt lgkmcnt(" #n ")" ::: "memory")
#define PG8_BAR __builtin_amdgcn_s_barrier()
#define PG8_SCHED __builtin_amdgcn_sched_barrier(0)
    Unit cur, nxt; int ui = 0;
    if (!S.next(0, cur)) return;
    f32x4 acc[2][2][4][2];
#pragma unroll
    for (int a = 0; a < 2; ++a)
#pragma unroll
        for (int b = 0; b < 2; ++b)
#pragma unroll
            for (int m = 0; m < 4; ++m)
#pragma unroll
                for (int n = 0; n < 2; ++n) acc[a][b][m][n] = (f32x4){0.f, 0.f, 0.f, 0.f};
    bf16x8 At[4][2], B0[2][2], B1[2][2];
    const char* cA = (const char*)g.A + (size_t)cur.pm * tstep; const char* cB = (const char*)g.Bt + (size_t)cur.pn * tstep;
    S.a_ready(cur);
    if constexpr (SP2) {
        PG8_STAGE(PG8_SB(0, 0), cB, voffB); PG8_STAGE(PG8_SB(0, 1), cB + hstep, voffB); PG8_STAGE(PG8_SA(0, 0), cA, voffA); PG8_STAGE(PG8_SA(0, 1), cA + hstep, voffA);
        if (wr == 1) PG8_BAR;
        PG8_WAIT_V(2); PG8_BAR;
        PG8_STAGE(PG8_SB(1, 0), cB + kstep, voffB); PG8_STAGE(PG8_SA(1, 0), cA + kstep, voffA); PG8_STAGE(PG8_SB(1, 1), cB + hstep + kstep, voffB);
        PG8_WAIT_V(6); PG8_BAR;
    } else {
        PG8_STAGE(PG8_SB(0, 0), cB, voffB); PG8_STAGE(PG8_SA(0, 0), cA, voffA); PG8_STAGE(PG8_SB(0, 1), cB + hstep, voffB); PG8_STAGE(PG8_SA(0, 1), cA + hstep, voffA);
        if (wr == 1) PG8_BAR;
        PG8_WAIT_V(4); PG8_BAR;
        PG8_STAGE(PG8_SB(1, 0), cB + kstep, voffB); PG8_STAGE(PG8_SA(1, 0), cA + kstep, voffA); PG8_STAGE(PG8_SB(1, 1), cB + hstep + kstep, voffB);
        PG8_WAIT_V(6); PG8_BAR;
    }
    for (;;) {
        const bool has_next = S.next(ui + 1, nxt);
        const char* nA = has_next ? (const char*)g.A + (size_t)nxt.pm * tstep : cA; const char* nB = has_next ? (const char*)g.Bt + (size_t)nxt.pn * tstep : cB;
        for (int t = 0; t < nt; t += 2) {
            const bool last = (t == nt - 2);
            const char* a1 = cA + (size_t)(t + 1) * kstep;
            const char* a2 = last ? nA : cA + (size_t)(t + 2) * kstep; const char* b2 = last ? nB : cB + (size_t)(t + 2) * kstep;
            const char* a3 = a2 + kstep; const char* b3 = b2 + kstep;
            if (last && has_next) S.a_ready(nxt);
            if constexpr (SP2) {
            PG8_LDB(B0, 0, 0); PG8_LDB(B1, 0, 1); PG8_SCHED; PG8_LDA(At, 0, 0); PG8_STAGE(PG8_SA(1, 1), a1 + hstep, voffA);
            PG8_WAIT_V(8); PG8_WAIT_L(0); PG8_BAR; PG8_MMA(0, 0, At, B0); PG8_MMA(0, 1, At, B1); PG8_BAR; PG8_SCHED;
            PG8_LDA(At, 0, 1); PG8_STAGE(PG8_SB(0, 0), b2, voffB); PG8_STAGE(PG8_SB(0, 1), b2 + hstep, voffB); PG8_STAGE(PG8_SA(0, 0), a2, voffA);
            PG8_WAIT_V(8); PG8_WAIT_L(0); PG8_BAR; PG8_MMA(1, 0, At, B0); PG8_MMA(1, 1, At, B1); PG8_BAR; PG8_SCHED;
            PG8_LDB(B0, 1, 0); PG8_LDB(B1, 1, 1); PG8_SCHED; PG8_LDA(At, 1, 0); PG8_STAGE(PG8_SA(0, 1), a2 + hstep, voffA);
            PG8_WAIT_V(8); PG8_WAIT_L(0); PG8_BAR; PG8_MMA(0, 0, At, B0); PG8_MMA(0, 1, At, B1); PG8_BAR; PG8_SCHED;
            PG8_LDA(At, 1, 1); PG8_STAGE(PG8_SB(1, 0), b3, voffB); PG8_STAGE(PG8_SB(1, 1), b3 + hstep, voffB); PG8_STAGE(PG8_SA(1, 0), a3, voffA);
            PG8_WAIT_V(8); PG8_WAIT_L(0); PG8_BAR; PG8_MMA(1, 0, At, B0); PG8_MMA(1, 1, At, B1); PG8_BAR; PG8_SCHED;
            } else {
            PG8_LDB(B0, 0, 0); PG8_SCHED; PG8_LDA(At, 0, 0); PG8_STAGE(PG8_SA(1, 1), a1 + hstep, voffA);
            PG8_WAIT_L(8); PG8_BAR; PG8_WAIT_L(0); PG8_MMA(0, 0, At, B0); PG8_BAR; PG8_SCHED;
            PG8_LDB(B1, 0, 1); PG8_STAGE(PG8_SB(0, 0), b2, voffB);
            PG8_BAR; PG8_WAIT_L(0); PG8_MMA(0, 1, At, B1); PG8_BAR;
            PG8_LDA(At, 0, 1); PG8_STAGE(PG8_SA(0, 0), a2, voffA);
            PG8_BAR; PG8_WAIT_L(0); PG8_MMA(1, 0, At, B0); PG8_BAR; PG8_SCHED;
            PG8_STAGE(PG8_SB(0, 1), b2 + hstep, voffB);
            PG8_WAIT_V(6); PG8_BAR; PG8_MMA(1, 1, At, B1); PG8_BAR;
            PG8_LDB(B0, 1, 0); PG8_SCHED; PG8_LDA(At, 1, 0); PG8_STAGE(PG8_SA(0, 1), a2 + hstep, voffA);
            PG8_WAIT_L(8); PG8_BAR; PG8_WAIT_L(0); PG8_MMA(0, 0, At, B0); PG8_BAR; PG8_SCHED;
            PG8_LDB(B1, 1, 1); PG8_STAGE(PG8_SB(1, 0), b3, voffB);
            PG8_BAR; PG8_WAIT_L(0); PG8_MMA(0, 1, At, B1); PG8_BAR;
            PG8_LDA(At, 1, 1); PG8_STAGE(PG8_SA(1, 0), a3, voffA);
            PG8_BAR; PG8_WAIT_L(0); PG8_MMA(1, 0, At, B0); PG8_BAR; PG8_SCHED;
            PG8_STAGE(PG8_SB(1, 1), b3 + hstep, voffB);
            PG8_WAIT_V(6); PG8_BAR; PG8_MMA(1, 1, At, B1); PG8_BAR;
            }
        }
        if constexpr (ALIGN_EPI) { if (wr == 0) PG8_BAR; }
        if constexpr (!Epi::AFTER_DRAIN) { E(acc, cur, wr, wc, fr, fq); S.done(cur); }
        if (!has_next) break;
#pragma unroll
        for (int a = 0; a < 2; ++a)
#pragma unroll
            for (int b = 0; b < 2; ++b)
#pragma unroll
                for (int m = 0; m < 4; ++m)
#pragma unroll
                    for (int n = 0; n < 2; ++n) acc[a][b][m][n] = (f32x4){0.f, 0.f, 0.f, 0.f};
        cur = nxt; cA = nA; cB = nB; ++ui;
        if constexpr (ALIGN_EPI) { if (wr == 1) PG8_BAR; }
    }
    PG8_WAIT_V(0);
    if constexpr (!ALIGN_EPI) { if (wr == 0) PG8_BAR; }
    PG8_BAR;
    if constexpr (Epi::AFTER_DRAIN) { E.fused(acc, cur, wr, wc, fr, fq, lds, wid, lane); S.done(cur); }
#undef PG8_SA
#undef PG8_SB
#undef PG8_STAGE
#undef PG8_LDA
#undef PG8_LDB
#undef PG8_MMA
#undef PG8_WAIT_V
#undef PG8_WAIT_L
#undef PG8_BAR
#undef PG8_SCHED
}
}
template <int NV>
DI void att_step(const float (&q)[64], const bf16_t* kp, const bf16_t* vp, float bias, float& mx, float& l, float (&o)[NV]) {
    float dot = 0.f;
#pragma unroll
    for (int c = 0; c < 8; ++c) { const u32x4 raw = *(const u32x4*)(kp + c * 8);
#pragma unroll
        for (int j = 0; j < 4; ++j) { dot += q[c * 8 + 2 * j] * __uint_as_float(raw[j] << 16); dot += q[c * 8 + 2 * j + 1] * __uint_as_float(raw[j] & 0xffff0000u); } }
    const float s = dot * 0.125f + bias;
    const float mn = fmaxf(mx, s), corr = expf(mx - mn), pr = expf(s - mn);
    mx = mn; l = l * corr + pr;
#pragma unroll
    for (int c = 0; c < NV / 8; ++c) { const u32x4 raw = *(const u32x4*)(vp + c * 8);
#pragma unroll
        for (int j = 0; j < 4; ++j) { o[c * 8 + 2 * j] = o[c * 8 + 2 * j] * corr + pr * __uint_as_float(raw[j] << 16); o[c * 8 + 2 * j + 1] = o[c * 8 + 2 * j + 1] * corr + pr * __uint_as_float(raw[j] & 0xffff0000u); } }
}
DI void load_q64(float (&q)[64], const bf16_t* qp) {
#pragma unroll
    for (int c = 0; c < 8; ++c) { const u32x4 raw = *(const u32x4*)(qp + c * 8);
#pragma unroll
        for (int j = 0; j < 4; ++j) { q[c * 8 + 2 * j] = __uint_as_float(raw[j] << 16); q[c * 8 + 2 * j + 1] = __uint_as_float(raw[j] & 0xffff0000u); } }
}
DI void phase_na_naive(const P& p) {
    const bf16_t* QKV = (const bf16_t*)(p.ws + WS_H); bf16_t* A = (bf16_t*)(p.ws + WS_A); const float* rpb = p.in[10];
    for (int idx = blockIdx.x * NTHR + otid(); idx < MT * 8; idx += gridDim.x * NTHR) {
        const int head = idx & 7, m = idx >> 3;
        float q[64], o[64]; float mx = -1e30f, l = 0.f;
        load_q64(q, QKV + (size_t)m * LD0 + C_NQ + head * 64);
#pragma unroll
        for (int d = 0; d < 64; ++d) o[d] = 0.f;
        int b;
        if (m < MX) {
            b = m >> 11; const int t = m & 2047, r = t >> 6, c = t & 63;
            const int rs = min(max(r - 4, 0), 24), cs = min(max(c - 8, 0), 48);
#pragma unroll 1
            for (int i = 0; i < 8; ++i)
#pragma unroll 1
                for (int w = 0; w < 16; ++w) { const int rr = rs + i, ww = cs + w; const size_t mk = (size_t)b * 2048 + rr * 64 + ww;
                    const float bias = rpb[(head * 15 + (rr - r + 7)) * 31 + (ww - c + 15)];
                    att_step<64>(q, QKV + mk * LD0 + C_NK + head * 64, QKV + mk * LD0 + C_NV + head * 64, bias, mx, l, o); }
        } else b = (m - MX) >> 8;
#pragma unroll 1
        for (int lk = 0; lk < 256; ++lk) { const size_t mk = (size_t)MX + b * 256 + lk;
            att_step<64>(q, QKV + mk * LD0 + C_NK + head * 64, QKV + mk * LD0 + C_NV + head * 64, 0.f, mx, l, o); }
        const float il = 1.f / l; bf16_t* op = A + (size_t)m * DM + head * 64;
#pragma unroll
        for (int d = 0; d < 64; d += 2) *(unsigned*)(op + d) = pk2(o[d] * il, o[d + 1] * il);
    }
}
DI void phase_gla_naive(const P& p, float* lds) {
    float* sq = lds; float* sk = lds + 4096; float* sa = lds + 8192; float* sv = lds + 12288;
    const bf16_t* QKV = (const bf16_t*)(p.ws + WS_H);
    const int tid = otid();
    for (int chain = blockIdx.x; chain < 64; chain += gridDim.x) {
        const int dir = chain & 1, h = (chain >> 1) & 3, b = chain >> 3;
        const float* wg = p.in[dir ? 13 : 11]; const float* bg = p.in[dir ? 14 : 12];
        bf16_t* O = (bf16_t*)(p.ws + (dir ? WS_OB : WS_OF));
        const int zoff = dir ? C_ZB : C_ZF;
        float S[64];
#pragma unroll
        for (int d = 0; d < 64; ++d) S[d] = 0.f;
        for (int seg = 0; seg < 2; ++seg) {
            const int base = seg == 0 ? MX + b * 256 : b * 2048, n = seg == 0 ? 256 : 2048;
            for (int c = 0; c < n / 64; ++c) {
                for (int idx = tid; idx < 4096; idx += NTHR) { const int i = idx >> 6, d = idx & 63, tp = c * 64 + i, t = dir ? n - 1 - tp : tp;
                    const bf16_t* rowp = QKV + (size_t)(base + t) * LD0;
                    sq[idx] = bf2f(rowp[C_GQ + h * 64 + d]) * 0.125f; sk[idx] = bf2f(rowp[C_GK + h * 64 + d]);
                    float z = bg[h * 64 + d];
#pragma unroll
                    for (int r = 0; r < 16; ++r) z += bf2f(rowp[zoff + r]) * wg[r * 256 + h * 64 + d];
                    const float ls = fminf(z, 0.f) - log1pf(expf(-fabsf(z)));
                    sa[idx] = expf(ls * (1.f / 16.f)); }
                for (int idx = tid; idx < 8192; idx += NTHR) { const int i = idx >> 7, e = idx & 127, tp = c * 64 + i, t = dir ? n - 1 - tp : tp;
                    sv[idx] = bf2f(QKV[(size_t)(base + t) * LD0 + C_GV + h * 128 + e]); }
                __syncthreads();
                if (tid < 128) {
                    const int e = tid;
#pragma unroll 1
                    for (int i = 0; i < 64; ++i) { const float ve = sv[i * 128 + e]; float o = 0.f;
#pragma unroll
                        for (int d = 0; d < 64; ++d) { float sd = sa[i * 64 + d] * S[d];
                            if (dir == 0) { sd += sk[i * 64 + d] * ve; o += sq[i * 64 + d] * sd; } else { o += sq[i * 64 + d] * sd; sd += sk[i * 64 + d] * ve; }
                            S[d] = sd; }
                        const int tp = c * 64 + i, t = dir ? n - 1 - tp : tp;
                        O[(size_t)(base + t) * 512 + h * 128 + e] = f2bf(o); }
                }
                __syncthreads();
            }
        }
    }
}
DI void phase_gla_finalize(const P& p) {
    const int tid = otid(), lane = tid & 63, w = tid >> 6;
    const int gw = blockIdx.x * 8 + w, NGW = gridDim.x * 8;
    const bf16_t* QKV = (const bf16_t*)(p.ws + WS_H); bf16_t* A = (bf16_t*)(p.ws + WS_A);
    const bf16_t* OF = (const bf16_t*)(p.ws + WS_OF); const bf16_t* OB = (const bf16_t*)(p.ws + WS_OB); const float* ng = p.in[15];
    for (int m = gw; m < MT; m += NGW) {
        const u32x4 rf = *(const u32x4*)(OF + (size_t)m * 512 + lane * 8), rb = *(const u32x4*)(OB + (size_t)m * 512 + lane * 8), rg = *(const u32x4*)(QKV + (size_t)m * LD0 + C_GR + lane * 8);
        float s[8], g[8]; float ss = 0.f;
#pragma unroll
        for (int j = 0; j < 4; ++j) { s[2 * j] = __uint_as_float(rf[j] << 16) + __uint_as_float(rb[j] << 16); s[2 * j + 1] = __uint_as_float(rf[j] & 0xffff0000u) + __uint_as_float(rb[j] & 0xffff0000u);
            g[2 * j] = __uint_as_float(rg[j] << 16); g[2 * j + 1] = __uint_as_float(rg[j] & 0xffff0000u); }
#pragma unroll
        for (int j = 0; j < 8; ++j) ss += s[j] * s[j];
        ss += __shfl_xor(ss, 1); ss += __shfl_xor(ss, 2); ss += __shfl_xor(ss, 4); ss += __shfl_xor(ss, 8);
        const float rms = 1.0f / sqrtf(ss * (1.f / 128.f) + LN_EPS);
        float o[8];
#pragma unroll
        for (int j = 0; j < 8; ++j) o[j] = s[j] * rms * ng[(lane & 15) * 8 + j] * silu_f(g[j]);
        u32x4 ov; ov.x = pk2(o[0], o[1]); ov.y = pk2(o[2], o[3]); ov.z = pk2(o[4], o[5]); ov.w = pk2(o[6], o[7]);
        *(u32x4*)(A + (size_t)m * DM + 512 + lane * 8) = ov;
    }
}
DI void phase_rope_naive(const P& p) {
    bf16_t* QKV = (bf16_t*)(p.ws + WS_H); const float* T = (const float*)(p.ws + WS_ROPE);
    for (size_t idx = (size_t)blockIdx.x * NTHR + otid(); idx < (size_t)MX * 1024; idx += (size_t)gridDim.x * NTHR) {
        const int m = (int)(idx >> 10), pi = (int)(idx & 1023), blk = pi >> 5, j = pi & 31, t = m & 2047;
        const int d0 = j < 16 ? j : 32 + (j - 16);
        const float c = T[(t * 32 + j) * 2], s = T[(t * 32 + j) * 2 + 1];
        bf16_t* u = QKV + (size_t)m * LD1 + blk * 64 + d0;
        const float u0 = bf2f(u[0]), u1 = bf2f(u[16]);
        u[0] = f2bf(u0 * c - u1 * s); u[16] = f2bf(u1 * c + u0 * s);
    }
}
DI void phase_diff_naive(const P& p) {
    const bf16_t* QKV = (const bf16_t*)(p.ws + WS_H); bf16_t* A = (bf16_t*)(p.ws + WS_A);
    float d1 = 0.f, d2 = 0.f;
    for (int i = 0; i < 64; ++i) { d1 += p.in[24][i] * p.in[25][i]; d2 += p.in[26][i] * p.in[27][i]; }
    const float lam = expf(d1) - expf(d2) + LAMBDA_INIT;
    const float* sg = p.in[28];
    for (int idx = blockIdx.x * NTHR + otid(); idx < MX * 32; idx += gridDim.x * NTHR) {
        const int quarter = idx & 3, head = (idx >> 2) & 7, m = idx >> 5, b = m >> 11;
        float res[32];
#pragma unroll 1
        for (int br = 0; br < 2; ++br) {
            float q[64], o[32]; float mx = -1e30f, l = 0.f;
            load_q64(q, QKV + (size_t)m * LD1 + head * 128 + br * 64);
#pragma unroll
            for (int e = 0; e < 32; ++e) o[e] = 0.f;
#pragma unroll 1
            for (int key = 0; key < 2304; ++key) { const size_t mk = key < 2048 ? (size_t)b * 2048 + key : (size_t)MX + b * 256 + (key - 2048);
                att_step<32>(q, QKV + mk * LD1 + 1024 + head * 128 + br * 64, QKV + mk * LD1 + 2048 + head * 128 + quarter * 32, 0.f, mx, l, o); }
            const float il = 1.f / l;
            if (br == 0) {
#pragma unroll
                for (int e = 0; e < 32; ++e) res[e] = o[e] * il;
            } else {
#pragma unroll
                for (int e = 0; e < 32; ++e) res[e] -= lam * o[e] * il;
            }
        }
        float ss = 0.f;
#pragma unroll
        for (int e = 0; e < 32; ++e) ss += res[e] * res[e];
        ss += __shfl_xor(ss, 1); ss += __shfl_xor(ss, 2);
        const float rms = 1.0f / sqrtf(ss * (1.f / 128.f) + LN_EPS);
        bf16_t* op = A + (size_t)m * DM + head * 128 + quarter * 32;
#pragma unroll
        for (int e = 0; e < 32; e += 2) *(unsigned*)(op + e) = pk2(res[e] * rms * sg[quarter * 32 + e] * (1.f - LAMBDA_INIT), res[e + 1] * rms * sg[quarter * 32 + e + 1] * (1.f - LAMBDA_INIT));
    }
}


namespace att {
#define ALDS __attribute__((address_space(3)))
typedef short bf16x8 __attribute__((ext_vector_type(8)));
typedef short s16x4 __attribute__((ext_vector_type(4)));
typedef float f32x16 __attribute__((ext_vector_type(16)));
typedef float f32x2_t __attribute__((ext_vector_type(2)));
typedef __bf16 bf16x2_t __attribute__((ext_vector_type(2)));
constexpr int KV_STAGE = 32768;
constexpr int OFF_BIAS = 65536;
constexpr int BIAS_STRIDE = 640;
constexpr int OFF_SG = 65536 + 8192;
constexpr float LOG2E = 1.4426950408889634f;
DI unsigned cvtpk(float lo, float hi) { f32x2_t v = {lo, hi}; bf16x2_t b = __builtin_convertvector(v, bf16x2_t); return __builtin_bit_cast(unsigned, b); }
DI unsigned fxor(unsigned row) { return ((row & 3u) << 2) | ((row >> 2) & 3u); }
DI unsigned off_b(unsigned row, unsigned ch) { return 256u * row + 16u * (ch ^ fxor(row)); }
DI s16x4 vtr(const ALDS unsigned char* p) { typedef short v4i16_t __attribute__((ext_vector_type(4))); return __builtin_bit_cast(s16x4, __builtin_amdgcn_ds_read_tr16_b64_v4i16((ALDS v4i16_t*)p)); }
DI float half_swap(float v) { return __shfl_xor(v, 32); }

template <class RowPtr>
DI void dma_image(ALDS unsigned char* img, int wid, int lane, const RowPtr& rowptr) {
#pragma unroll
    for (int i = 0; i < 2; ++i) { const int ci = 2 * wid + i; const unsigned row = 4u * ci + (lane >> 4), pos = lane & 15, ch = pos ^ fxor(row);
        const unsigned char* src = rowptr((int)row) + 16u * ch;
        __builtin_amdgcn_global_load_lds((const unsigned*)src, (ALDS unsigned*)(img + 1024 * ci), 16, 0, 0); }
}

struct WaveState { float m, l; };

template <int NC, class TFn>
DI void step(f32x16 (&OT)[NC], WaveState& st, const bf16x8 (&qf)[4], const ALDS unsigned char* Kimg, const ALDS unsigned char* Vimg, const unsigned (&kaddr)[4], const unsigned (&vaddr)[NC][2], float cscale, const TFn& tfn) {
    f32x16 S[2];
#pragma unroll
    for (int j = 0; j < 2; ++j) {
#pragma unroll
        for (int r = 0; r < 16; ++r) S[j][r] = 0.f;
#pragma unroll
        for (int d0 = 0; d0 < 4; ++d0) { const bf16x8 kf = *(const ALDS bf16x8*)(Kimg + kaddr[d0] + 8192 * j); S[j] = __builtin_amdgcn_mfma_f32_32x32x16_bf16(kf, qf[d0], S[j], 0, 0, 0); }
    }
    float mx = -1e30f;
#pragma unroll
    for (int j = 0; j < 2; ++j)
#pragma unroll
        for (int r = 0; r < 16; ++r) { S[j][r] = tfn(j, r, S[j][r] * cscale); mx = fmaxf(mx, S[j][r]); }
    mx = fmaxf(mx, half_swap(mx));
    const float mn = fmaxf(st.m, mx), alpha = __builtin_amdgcn_exp2f(st.m - mn);
    st.m = mn;
    float rs = 0.f;
#pragma unroll
    for (int j = 0; j < 2; ++j)
#pragma unroll
        for (int r = 0; r < 16; ++r) { S[j][r] = __builtin_amdgcn_exp2f(S[j][r] - mn); rs += S[j][r]; }
    st.l = st.l * alpha + rs;
    if (__any(alpha != 1.0f)) {
#pragma unroll
        for (int c = 0; c < NC; ++c)
#pragma unroll
            for (int r = 0; r < 16; ++r) OT[c][r] *= alpha;
    }
#pragma unroll
    for (int j = 0; j < 2; ++j)
#pragma unroll
        for (int ks = 0; ks < 2; ++ks) {
            u32x4 pw; pw.x = cvtpk(S[j][8 * ks], S[j][8 * ks + 1]); pw.y = cvtpk(S[j][8 * ks + 2], S[j][8 * ks + 3]); pw.z = cvtpk(S[j][8 * ks + 4], S[j][8 * ks + 5]); pw.w = cvtpk(S[j][8 * ks + 6], S[j][8 * ks + 7]);
            const bf16x8 pf = __builtin_bit_cast(bf16x8, pw);
#pragma unroll
            for (int c = 0; c < NC; ++c) { const s16x4 lo = vtr(Vimg + vaddr[c][0] + 8192 * j + 4096 * ks), hi = vtr(Vimg + vaddr[c][1] + 8192 * j + 4096 * ks);
                const bf16x8 vf = {lo[0], lo[1], lo[2], lo[3], hi[0], hi[1], hi[2], hi[3]};
                OT[c] = __builtin_amdgcn_mfma_f32_32x32x16_bf16(vf, pf, OT[c], 0, 0, 0); }
        }
}
DI void make_kaddr(unsigned (&kaddr)[4], int lane, int ks_base) {
    const unsigned i = lane & 31, h = lane >> 5, rowp = (i & ~12u) | ((i & 4u) << 1) | ((i & 8u) >> 1);
#pragma unroll
    for (int d0 = 0; d0 < 4; ++d0) kaddr[d0] = off_b(rowp, 2u * (ks_base + d0) + h);
}
template <int NC>
DI void make_vaddr(unsigned (&vaddr)[NC][2], int lane, int c_base) {
    const unsigned h = lane >> 5, blk = (lane >> 4) & 1, q = (lane & 15) >> 2, p = lane & 3;
#pragma unroll
    for (int c = 0; c < NC; ++c)
#pragma unroll
        for (int t = 0; t < 2; ++t) vaddr[c][t] = off_b(8u * h + 4u * t + q, 4u * (c_base + c) + 2u * blk + (p >> 1)) + 8u * (p & 1);
}
DI void load_q(bf16x8 (&qf)[4], const bf16_t* qrow, int lane) {
    const int h = lane >> 5;
#pragma unroll
    for (int d0 = 0; d0 < 4; ++d0) qf[d0] = *(const bf16x8*)(qrow + 16 * d0 + 8 * h);
}
#define ATT_WAIT_BAR() do { asm volatile("s_waitcnt vmcnt(0) lgkmcnt(0)" ::: "memory"); __builtin_amdgcn_s_barrier(); asm volatile("" ::: "memory"); } while (0)

DI void phase_diff(const P& p, unsigned char* lds_generic) {
    ALDS unsigned char* lds = (ALDS unsigned char*)lds_generic;
    const int tid = otid(), lane = tid & 63, wid = __builtin_amdgcn_readfirstlane(tid >> 6), g = wid >> 2, qb = wid & 3, h = lane >> 5;
    const bf16_t* QKV = (const bf16_t*)(p.ws + WS_H); bf16_t* A = (bf16_t*)(p.ws + WS_A);
    float d1 = 0.f, d2 = 0.f;
    for (int i = 0; i < 64; ++i) { d1 += p.in[24][i] * p.in[25][i]; d2 += p.in[26][i] * p.in[27][i]; }
    const float lam = expf(d1) - expf(d2) + LAMBDA_INIT;
    ALDS float* sgl = (ALDS float*)(lds + OFF_SG);
    if (tid < 128) sgl[tid] = p.in[28][tid] * (1.f - LAMBDA_INIT);
    unsigned kaddr[4], vaddr[4][2];
    make_kaddr(kaddr, lane, 4 * g); make_vaddr<4>(vaddr, lane, 0);
    const float cscale = 0.125f * LOG2E;
    for (int unit = blockIdx.x; unit < 1024; unit += gridDim.x) {
        const int b = unit >> 7, head = (unit >> 4) & 7, qblk = unit & 15;
        const int mq = b * 2048 + qblk * 128 + qb * 32 + (lane & 31);
        bf16x8 qf[4]; load_q(qf, QKV + (size_t)mq * LD1 + head * 128 + g * 64, lane);
        f32x16 OT[4];
#pragma unroll
        for (int c = 0; c < 4; ++c)
#pragma unroll
            for (int r = 0; r < 16; ++r) OT[c][r] = 0.f;
        WaveState st{-1e30f, 0.f};
        auto issue = [&](int s) {
            ALDS unsigned char* base = lds + (s & 1) * KV_STAGE;
            auto krow = [&](int row) { const int key = s * 64 + row; const size_t m = key < 2048 ? (size_t)b * 2048 + key : (size_t)MX + b * 256 + (key - 2048); return (const unsigned char*)(QKV + m * LD1 + 1024 + head * 128); };
            auto vrow = [&](int row) { const int key = s * 64 + row; const size_t m = key < 2048 ? (size_t)b * 2048 + key : (size_t)MX + b * 256 + (key - 2048); return (const unsigned char*)(QKV + m * LD1 + 2048 + head * 128); };
            dma_image(base, wid, lane, krow); dma_image(base + 16384, wid, lane, vrow);
        };
        issue(0);
#pragma unroll 1
        for (int s = 0; s < 36; ++s) {
            ATT_WAIT_BAR();
            if (s + 1 < 36) issue(s + 1);
            const ALDS unsigned char* base = lds + (s & 1) * KV_STAGE;
            step<4>(OT, st, qf, base, base + 16384, kaddr, vaddr, cscale, [](int, int, float v) { return v; });
        }
        const float inv = 1.0f / (st.l + half_swap(st.l));
        ATT_WAIT_BAR();
        ALDS float* exch = (ALDS float*)lds + qb * 4096;
        if (g == 1) {
#pragma unroll
            for (int c = 0; c < 4; ++c)
#pragma unroll
                for (int r = 0; r < 16; ++r) exch[(c * 16 + r) * 64 + lane] = OT[c][r] * inv;
        }
        ATT_WAIT_BAR();
        if (g == 0) {
            float ss = 0.f;
#pragma unroll
            for (int c = 0; c < 4; ++c)
#pragma unroll
                for (int r = 0; r < 16; ++r) { const float o = OT[c][r] * inv - lam * exch[(c * 16 + r) * 64 + lane]; OT[c][r] = o; ss += o * o; }
            ss += half_swap(ss);
            const float rms = 1.0f / sqrtf(ss * (1.f / 128.f) + LN_EPS);
            bf16_t* orow = A + (size_t)mq * DM + head * 128;
#pragma unroll
            for (int c = 0; c < 4; ++c)
#pragma unroll
                for (int r4 = 0; r4 < 4; ++r4) { const int e0 = 32 * c + 8 * r4 + 4 * h; const f32x4 sg = *(const ALDS f32x4*)(sgl + e0);
                    u32x2 w; w.x = cvtpk(OT[c][4 * r4] * rms * sg[0], OT[c][4 * r4 + 1] * rms * sg[1]); w.y = cvtpk(OT[c][4 * r4 + 2] * rms * sg[2], OT[c][4 * r4 + 3] * rms * sg[3]);
                    *(u32x2*)(orow + e0) = w; }
        }
        ATT_WAIT_BAR();
    }
}

DI void phase_na(const P& p, unsigned char* lds_generic) {
    ALDS unsigned char* lds = (ALDS unsigned char*)lds_generic;
    const int tid = otid(), lane = tid & 63, wid = __builtin_amdgcn_readfirstlane(tid >> 6), g = wid >> 2, qb = wid & 3, h = lane >> 5;
    const bf16_t* QKV = (const bf16_t*)(p.ws + WS_H); bf16_t* A = (bf16_t*)(p.ws + WS_A);
    ALDS float* biasl = (ALDS float*)(lds + OFF_BIAS);
    unsigned kaddr[4], vaddr[2][2];
    make_kaddr(kaddr, lane, 4 * g); make_vaddr<2>(vaddr, lane, 2 * g);
    const float cscale = 0.125f * LOG2E;
    int cur_hp = -1;
    for (int unit = blockIdx.x; unit < 576; unit += gridDim.x) {
        int b, hp, mq, r_q = 0, cq = 0, rs0 = 0, nloc = 0; bool lat = unit < 512;
        if (lat) { b = unit >> 6; hp = (unit >> 4) & 3; const int rp = unit & 15; r_q = 2 * rp + (qb >> 1); cq = 32 * (qb & 1) + (lane & 31);
            mq = b * 2048 + r_q * 64 + cq; rs0 = min(max(2 * rp - 4, 0), 24); const int rs1 = min(max(2 * rp + 1 - 4, 0), 24); nloc = rs1 + 8 - rs0; }
        else { const int u = unit - 512; b = u >> 3; hp = (u >> 1) & 3; mq = MX + b * 256 + (u & 1) * 128 + qb * 32 + (lane & 31); }
        const int head = 2 * hp + g;
        if (hp != cur_hp) {
            ATT_WAIT_BAR();
            for (int i = tid; i < 2 * BIAS_STRIDE; i += NTHR) { const int hh = i / BIAS_STRIDE, k = i % BIAS_STRIDE - 64; biasl[i] = (k >= 0 && k < 465) ? p.in[10][(2 * hp + hh) * 465 + k] * LOG2E : 0.f; }
            cur_hp = hp;
        }
        bf16x8 qf[4]; load_q(qf, QKV + (size_t)mq * LD0 + C_NQ + head * 64, lane);
        f32x16 OT[2];
#pragma unroll
        for (int c = 0; c < 2; ++c)
#pragma unroll
            for (int r = 0; r < 16; ++r) OT[c][r] = 0.f;
        WaveState st{-1e30f, 0.f};
        const int nsteps = nloc + 4;
        auto issue = [&](int s) {
            ALDS unsigned char* base = lds + (s & 1) * KV_STAGE;
            const size_t m0 = s < nloc ? (size_t)b * 2048 + (rs0 + s) * 64 : (size_t)MX + b * 256 + (s - nloc) * 64;
            auto krow = [&](int row) { return (const unsigned char*)(QKV + (m0 + row) * LD0 + C_NK + hp * 128); };
            auto vrow = [&](int row) { return (const unsigned char*)(QKV + (m0 + row) * LD0 + C_NV + hp * 128); };
            dma_image(base, wid, lane, krow); dma_image(base + 16384, wid, lane, vrow);
        };
        issue(0);
        const int rsq = min(max(r_q - 4, 0), 24), cs = min(max(cq - 8, 0), 48);
#pragma unroll 1
        for (int s = 0; s < nsteps; ++s) {
            ATT_WAIT_BAR();
            if (s + 1 < nsteps) issue(s + 1);
            const ALDS unsigned char* base = lds + (s & 1) * KV_STAGE;
            if (s < nloc) {
                const int rr = rs0 + s;
                if (rr >= rsq && rr < rsq + 8) {
                    const ALDS float* bl = biasl + g * BIAS_STRIDE + 64 + (rr - r_q + 7) * 31 + 15 - cq + 8 * h;
                    step<2>(OT, st, qf, base, base + 16384, kaddr, vaddr, cscale, [&](int j, int r, float v) {
                        const int w = 32 * j + 16 * (r >> 3) + 8 * h + (r & 7);
                        const float bv = bl[32 * j + 16 * (r >> 3) + (r & 7)];
                        return ((unsigned)(w - cs) < 16u) ? v + bv : -1e30f; });
                }
            } else step<2>(OT, st, qf, base, base + 16384, kaddr, vaddr, cscale, [](int, int, float v) { return v; });
        }
        const float inv = 1.0f / (st.l + half_swap(st.l));
        bf16_t* orow = A + (size_t)mq * DM + head * 64;
#pragma unroll
        for (int c = 0; c < 2; ++c)
#pragma unroll
            for (int r4 = 0; r4 < 4; ++r4) { const int e0 = 32 * c + 8 * r4 + 4 * h;
                u32x2 w; w.x = cvtpk(OT[c][4 * r4] * inv, OT[c][4 * r4 + 1] * inv); w.y = cvtpk(OT[c][4 * r4 + 2] * inv, OT[c][4 * r4 + 3] * inv);
                *(u32x2*)(orow + e0) = w; }
        ATT_WAIT_BAR();
    }
    ATT_WAIT_BAR();
}
#undef ALDS
}


namespace gla {
#define ALDS __attribute__((address_space(3)))
using att::bf16x8; using att::s16x4; using att::f32x16; using att::off_b; using att::fxor; using att::vtr; using att::cvtpk; using att::half_swap;
constexpr size_t WS_U = WS_OF;
constexpr size_t WS_GD = 283 * MiB;
DI int chain_id(int b, int h, int dir) { return (b * 4 + h) * 2 + dir; }
DI float logsig16(float z) { return (fminf(z, 0.f) - log1pf(expf(-fabsf(z)))) * (1.f / 16.f); }

DI void gates(const P& p, const bf16_t* QKV, size_t m0, int hh, int d, int seg, ALDS float* tot, float (&Bf)[8], float (&Bb)[8], float& totf, float& totb) {
    float wf[16], wb[16];
#pragma unroll
    for (int r = 0; r < 16; ++r) { wf[r] = p.in[11][r * 256 + hh * 64 + d]; wb[r] = p.in[13][r * 256 + hh * 64 + d]; }
    const float bf = p.in[12][hh * 64 + d], bb = p.in[14][hh * 64 + d];
    float lf[8], lb[8];
#pragma unroll
    for (int k = 0; k < 8; ++k) {
        const u32x4* zr = (const u32x4*)(QKV + (m0 + 8 * seg + k) * LD0 + C_ZF);
        float zf = bf, zb = bb;
#pragma unroll
        for (int c4 = 0; c4 < 2; ++c4) { const u32x4 a = zr[c4], b2 = zr[2 + c4];
#pragma unroll
            for (int j = 0; j < 4; ++j) { zf += __uint_as_float(a[j] << 16) * wf[c4 * 8 + 2 * j] + __uint_as_float(a[j] & 0xffff0000u) * wf[c4 * 8 + 2 * j + 1];
                zb += __uint_as_float(b2[j] << 16) * wb[c4 * 8 + 2 * j] + __uint_as_float(b2[j] & 0xffff0000u) * wb[c4 * 8 + 2 * j + 1]; } }
        lf[k] = logsig16(zf); lb[k] = logsig16(zb);
    }
    Bf[0] = lf[0];
#pragma unroll
    for (int k = 1; k < 8; ++k) Bf[k] = Bf[k - 1] + lf[k];
    Bb[7] = lb[7];
#pragma unroll
    for (int k = 6; k >= 0; --k) Bb[k] = Bb[k + 1] + lb[k];
    tot[seg * 64 + d] = Bf[7]; tot[(8 + seg) * 64 + d] = Bb[0];
    asm volatile("s_waitcnt lgkmcnt(0)" ::: "memory"); __builtin_amdgcn_s_barrier(); asm volatile("" ::: "memory");
    float offf = 0.f, offb = 0.f; totf = 0.f; totb = 0.f;
#pragma unroll
    for (int s2 = 0; s2 < 8; ++s2) { const float tf = tot[s2 * 64 + d], tb = tot[(8 + s2) * 64 + d]; totf += tf; totb += tb; if (s2 < seg) offf += tf; if (s2 > seg) offb += tb; }
#pragma unroll
    for (int k = 0; k < 8; ++k) { Bf[k] += offf; Bb[k] += offb; }
}
DI void token_chunk(int tc, int b, size_t& m0, int& cf, int& cb) {
    if (tc < 4) { m0 = (size_t)MX + b * 256 + tc * 64; cf = tc; cb = 3 - tc; } else { m0 = (size_t)b * 2048 + (tc - 4) * 64; cf = tc; cb = 39 - tc; }
}
DI void img_store(ALDS unsigned char* img, int row, int col, float v) { *(ALDS bf16_t*)(img + off_b(row, col >> 3) + 2 * (col & 7)) = f2bf(v); }
template <int NCC>
DI void make_tr(unsigned (&a)[NCC][2], int lane, int c_base) { att::make_vaddr<NCC>(a, lane, c_base); }
DI bf16x8 tr_frag(const ALDS unsigned char* img, const unsigned (&a)[2], int ks) { const s16x4 lo = vtr(img + a[0] + 4096 * ks), hi = vtr(img + a[1] + 4096 * ks); return (bf16x8){lo[0], lo[1], lo[2], lo[3], hi[0], hi[1], hi[2], hi[3]}; }

DI void phase_g1(const P& p, unsigned char* lds_generic) {
    ALDS unsigned char* lds = (ALDS unsigned char*)lds_generic;
    ALDS unsigned char* Vimg = lds; ALDS unsigned char* KDimg = lds + 16384; ALDS float* tot = (ALDS float*)(lds + 32768);
    const int tid = otid(), lane = tid & 63, wid = __builtin_amdgcn_readfirstlane(tid >> 6), d = lane, seg = wid, h = lane >> 5;
    const bf16_t* QKV = (const bf16_t*)(p.ws + WS_H); bf16_t* U = (bf16_t*)(p.ws + WS_U); float* GD = (float*)(p.ws + WS_GD);
    const int db = wid & 1, eb = wid >> 1;
    unsigned akd[2][2], av[1][2];
    for (int unit = blockIdx.x; unit < 1152; unit += gridDim.x) {
        const int tc = unit % 36, bh = unit / 36, b = bh >> 2, hh = bh & 3;
        size_t m0; int cf, cb; token_chunk(tc, b, m0, cf, cb);
        att::dma_image(Vimg, wid, lane, [&](int row) { return (const unsigned char*)(QKV + (m0 + row) * LD0 + C_GV + hh * 128); });
        float Bf[8], Bb[8], totf, totb;
        gates(p, QKV, m0, hh, d, seg, tot, Bf, Bb, totf, totb);
#pragma unroll
        for (int k = 0; k < 8; ++k) { const int i = 8 * seg + k; const float kv = bf2f(QKV[(m0 + i) * LD0 + C_GK + hh * 64 + d]);
            img_store(KDimg, i, d, kv * expf(totf - Bf[k])); img_store(KDimg, i, 64 + d, kv * expf(totb - Bb[k])); }
        if (seg == 0) GD[(size_t)(chain_id(b, hh, 0) * 36 + cf) * 64 + d] = expf(totf);
        if (seg == 1) GD[(size_t)(chain_id(b, hh, 1) * 36 + cb) * 64 + d] = expf(totb);
        ATT_WAIT_BAR();
        make_tr<2>(akd, lane, db); make_tr<1>(av, lane, eb);
        unsigned akb[1][2]; make_tr<1>(akb, lane, 2 + db);
        f32x16 accf, accb;
#pragma unroll
        for (int r = 0; r < 16; ++r) { accf[r] = 0.f; accb[r] = 0.f; }
#pragma unroll
        for (int ks = 0; ks < 4; ++ks) { const bf16x8 vf = tr_frag(Vimg, av[0], ks);
            accf = __builtin_amdgcn_mfma_f32_32x32x16_bf16(tr_frag(KDimg, akd[0], ks), vf, accf, 0, 0, 0);
            accb = __builtin_amdgcn_mfma_f32_32x32x16_bf16(tr_frag(KDimg, akb[0], ks), vf, accb, 0, 0, 0); }
        bf16_t* Uf = U + ((size_t)(chain_id(b, hh, 0) * 36 + cf) * 64) * 128; bf16_t* Ub = U + ((size_t)(chain_id(b, hh, 1) * 36 + cb) * 64) * 128;
#pragma unroll
        for (int r = 0; r < 16; ++r) { const int dd = 32 * db + 8 * (r >> 2) + 4 * h + (r & 3), e = 32 * eb + (lane & 31);
            Uf[dd * 128 + e] = f2bf(accf[r]); Ub[dd * 128 + e] = f2bf(accb[r]); }
        ATT_WAIT_BAR();
    }
}
DI void phase_g2(const P& p) {
    bf16_t* U = (bf16_t*)(p.ws + WS_U); const float* GD = (const float*)(p.ws + WS_GD);
    for (int item = blockIdx.x * NTHR + otid(); item < 65536; item += gridDim.x * NTHR) {
        const int chain = item >> 10, rem = item & 1023, d = rem >> 4, e8 = (rem & 15) * 8;
        float st[8];
#pragma unroll
        for (int j = 0; j < 8; ++j) st[j] = 0.f;
#pragma unroll 4
        for (int c = 0; c < 36; ++c) {
            u32x4* ptr = (u32x4*)(U + ((size_t)(chain * 36 + c) * 64 + d) * 128 + e8); const u32x4 raw = *ptr; const float dec = GD[(size_t)(chain * 36 + c) * 64 + d];
            u32x4 o; o.x = pk2(st[0], st[1]); o.y = pk2(st[2], st[3]); o.z = pk2(st[4], st[5]); o.w = pk2(st[6], st[7]); *ptr = o;
#pragma unroll
            for (int j = 0; j < 4; ++j) { st[2 * j] = dec * st[2 * j] + __uint_as_float(raw[j] << 16); st[2 * j + 1] = dec * st[2 * j + 1] + __uint_as_float(raw[j] & 0xffff0000u); }
        }
    }
}
DI void phase_g3(const P& p, unsigned char* lds_generic) {
    ALDS unsigned char* lds = (ALDS unsigned char*)lds_generic;
    ALDS unsigned char* Vimg = lds; ALDS unsigned char* Simg = lds + 16384  ; ALDS unsigned char* QKimg = lds + 49152  ;
    ALDS float* tot = (ALDS float*)(lds + 81920); ALDS float* ssb = (ALDS float*)(lds + 86016);
    const int tid = otid(), lane = tid & 63, wid = __builtin_amdgcn_readfirstlane(tid >> 6), d = lane, seg = wid, h = lane >> 5;
    const bf16_t* QKV = (const bf16_t*)(p.ws + WS_H); const bf16_t* U = (const bf16_t*)(p.ws + WS_U); bf16_t* A = (bf16_t*)(p.ws + WS_A);
    const int eb = wid & 3, tb = wid >> 2;
    unsigned kaddr[4], qaddr[4], atr[1][2];
    att::make_kaddr(kaddr, lane, 4);
#pragma unroll
    for (int d0 = 0; d0 < 4; ++d0) qaddr[d0] = off_b(lane & 31, 2 * d0 + h);
    make_tr<1>(atr, lane, eb);
    for (int unit = blockIdx.x; unit < 1152; unit += gridDim.x) {
        const int tc = unit % 36, bh = unit / 36, b = bh >> 2, hh = bh & 3;
        size_t m0; int cf, cb; token_chunk(tc, b, m0, cf, cb);
        att::dma_image(Vimg, wid, lane, [&](int row) { return (const unsigned char*)(QKV + (m0 + row) * LD0 + C_GV + hh * 128); });
        att::dma_image(Simg, wid, lane, [&](int row) { return (const unsigned char*)(U + ((size_t)(chain_id(b, hh, 0) * 36 + cf) * 64 + row) * 128); });
        att::dma_image(Simg + 16384, wid, lane, [&](int row) { return (const unsigned char*)(U + ((size_t)(chain_id(b, hh, 1) * 36 + cb) * 64 + row) * 128); });
        float Bf[8], Bb[8], totf, totb;
        gates(p, QKV, m0, hh, d, seg, tot, Bf, Bb, totf, totb);
#pragma unroll
        for (int k = 0; k < 8; ++k) { const int i = 8 * seg + k; const float qv = bf2f(QKV[(m0 + i) * LD0 + C_GQ + hh * 64 + d]) * 0.125f, kv = bf2f(QKV[(m0 + i) * LD0 + C_GK + hh * 64 + d]);
            img_store(QKimg, i, d, qv * expf(Bf[k])); img_store(QKimg, i, 64 + d, kv * expf(-Bf[k]));
            img_store(QKimg + 16384, i, d, qv * expf(Bb[k])); img_store(QKimg + 16384, i, 64 + d, kv * expf(-Bb[k])); }
        ATT_WAIT_BAR();
        f32x16 acc;
#pragma unroll
        for (int r = 0; r < 16; ++r) acc[r] = 0.f;
        const int tq = 32 * tb + (lane & 31);
#pragma unroll
        for (int dir = 0; dir < 2; ++dir) {
            const ALDS unsigned char* QK = QKimg + 16384 * dir; const ALDS unsigned char* SI = Simg + 16384 * dir;
            bf16x8 qf[4];
#pragma unroll
            for (int d0 = 0; d0 < 4; ++d0) qf[d0] = *(const ALDS bf16x8*)(QK + qaddr[d0] + 8192 * tb);
#pragma unroll
            for (int sb = 0; sb < 2; ++sb) {
                if ((dir == 0 && sb > tb) || (dir == 1 && sb < tb)) continue;
                f32x16 S;
#pragma unroll
                for (int r = 0; r < 16; ++r) S[r] = 0.f;
#pragma unroll
                for (int d0 = 0; d0 < 4; ++d0) { const bf16x8 kf = *(const ALDS bf16x8*)(QK + kaddr[d0] + 8192 * sb); S = __builtin_amdgcn_mfma_f32_32x32x16_bf16(kf, qf[d0], S, 0, 0, 0); }
#pragma unroll
                for (int r = 0; r < 16; ++r) { const int sk = 32 * sb + 16 * (r >> 3) + 8 * h + (r & 7); const bool keep = dir == 0 ? (sk <= tq) : (sk > tq); S[r] = keep ? S[r] : 0.f; }
#pragma unroll
                for (int ks2 = 0; ks2 < 2; ++ks2) {
                    u32x4 pw; pw.x = cvtpk(S[8 * ks2], S[8 * ks2 + 1]); pw.y = cvtpk(S[8 * ks2 + 2], S[8 * ks2 + 3]); pw.z = cvtpk(S[8 * ks2 + 4], S[8 * ks2 + 5]); pw.w = cvtpk(S[8 * ks2 + 6], S[8 * ks2 + 7]);
                    acc = __builtin_amdgcn_mfma_f32_32x32x16_bf16(tr_frag(Vimg, atr[0], 2 * sb + ks2), __builtin_bit_cast(bf16x8, pw), acc, 0, 0, 0); }
            }
#pragma unroll
            for (int ks = 0; ks < 4; ++ks) acc = __builtin_amdgcn_mfma_f32_32x32x16_bf16(tr_frag(SI, atr[0], ks), qf[ks], acc, 0, 0, 0);
        }
        float ss = 0.f;
#pragma unroll
        for (int r = 0; r < 16; ++r) ss += acc[r] * acc[r];
        ss += half_swap(ss);
        if (h == 0) ssb[eb * 64 + tq] = ss;
        ATT_WAIT_BAR();
        const float tots = ssb[tq] + ssb[64 + tq] + ssb[128 + tq] + ssb[192 + tq];
        const float rms = 1.0f / sqrtf(tots * (1.f / 128.f) + LN_EPS);
        const size_t m = m0 + tq;
#pragma unroll
        for (int r4 = 0; r4 < 4; ++r4) { const int e0 = 32 * eb + 8 * r4 + 4 * h;
            const f32x4 ng = *(const f32x4*)(p.in[15] + e0); const u32x2 gr = *(const u32x2*)(QKV + m * LD0 + C_GR + hh * 128 + e0);
            const float g0 = __uint_as_float(gr.x << 16), g1 = __uint_as_float(gr.x & 0xffff0000u), g2 = __uint_as_float(gr.y << 16), g3 = __uint_as_float(gr.y & 0xffff0000u);
            u32x2 w; w.x = cvtpk(acc[4 * r4] * rms * ng[0] * silu_f(g0), acc[4 * r4 + 1] * rms * ng[1] * silu_f(g1)); w.y = cvtpk(acc[4 * r4 + 2] * rms * ng[2] * silu_f(g2), acc[4 * r4 + 3] * rms * ng[3] * silu_f(g3));
            *(u32x2*)(A + m * DM + 512 + hh * 128 + e0) = w; }
        ATT_WAIT_BAR();
    }
}
#undef ALDS
}

__global__ void __launch_bounds__(NTHR) mk_fwd(P p) {
    extern __shared__ __attribute__((aligned(16))) unsigned char lds_raw[];
    float* lds = (float*)lds_raw;
    cg::grid_group grid = cg::this_grid();
    int ph = 0;
#define RUN(...) do { if (ph >= p.ph_lo && ph < p.ph_hi) { __VA_ARGS__; if (ph + 1 < p.ph_hi) grid.sync(); } ++ph; } while (0)
    bf16_t* A = (bf16_t*)(p.ws + WS_A); bf16_t* H = (bf16_t*)(p.ws + WS_H);

    RUN({ phase_adaln(p, lds); phase_rope_table(p); phase_convert(p, lds); });
    RUN(phase_rowpass(p, false, 0, false, true, 0, 0, 1, MT));
    __attribute__((address_space(3))) unsigned char* glds = (__attribute__((address_space(3))) unsigned char*)lds_raw;
    float* XH = (float*)(p.ws + WS_XH); const float* ROPE = (const float*)(p.ws + WS_ROPE);
    const int G = (int)gridDim.x, cid = (int)blockIdx.x;
#define GEMM_SWIGLU(Aop, Wt, Mrows) do { pg8::Gemm g{Aop, Wt, Mrows, 2 * DFF, DM}; pg8::StaticOrder S; S.init(Mrows, 2 * DFF, G, cid); pg8::EpiSwigluF E{H, DFF}; \
        pg8::gemm_phase<pg8::EpiSwigluF, pg8::StaticOrder, true, true>(glds, g, S, E); } while (0)
#define GEMM_STORE(Aop, Wt, Mrows, N, ropet) do { pg8::Gemm g{Aop, Wt, Mrows, N, DM}; pg8::StaticOrder S; S.init(Mrows, N, G, cid); pg8::EpiStoreF E{H, N, ROPE, ropet, MX}; \
        pg8::gemm_phase<pg8::EpiStoreF, pg8::StaticOrder, true, true>(glds, g, S, E); } while (0)
#define GEMM_RESID(Aop, Wt, Mrows, K, xi, hi, chunk, sc) do { pg8::Gemm g{Aop, Wt, Mrows, DM, K}; pg8::StaticOrder S; S.init(Mrows, DM, G, cid); \
        pg8::EpiResidF E{xi, hi, p.out, XH, mod_ptr(p, l, 0, chunk), mod_ptr(p, l, 8, chunk), sc, ALPHA}; \
        pg8::gemm_phase<pg8::EpiResidF, pg8::StaticOrder, true, true>(glds, g, S, E); } while (0)
#pragma unroll 1
    for (int l = 0; l < 2; ++l) {
        RUN(GEMM_SWIGLU(A, wt_ptr(p, l, WT_F1I), MT));
        RUN(GEMM_RESID(H, wt_ptr(p, l, WT_F1O), MT, DFF, (l == 0 ? p.in[0] : (const float*)p.out), (l == 0 ? p.in[2] : (const float*)XH), 2, 0.5f));
        RUN(phase_rowpass(p, true, 1, true, true, l, 3, 4, MT));
        if (l == 0) {
            RUN(GEMM_STORE(A, wt_ptr(p, l, WT_MI), MT, LD0, 0));
            RUN({ gla::phase_g1(p, lds_raw); att::phase_na(p, lds_raw); });
            RUN(gla::phase_g2(p));
            RUN(gla::phase_g3(p, lds_raw));
        } else {
            RUN(GEMM_STORE(A, wt_ptr(p, l, WT_MI), MT, LD1, 8));
            RUN(att::phase_diff(p, lds_raw));
        }
        const int Mrows = l == 0 ? MT : MX;
        RUN(GEMM_RESID(A, wt_ptr(p, l, WT_MO), Mrows, DM, (const float*)p.out, (const float*)XH, 5, 1.0f));
        RUN(phase_rowpass(p, true, 1, true, true, l, 6, 7, Mrows));
        RUN(GEMM_SWIGLU(A, wt_ptr(p, l, WT_F2I), Mrows));
        RUN(GEMM_RESID(H, wt_ptr(p, l, WT_F2O), Mrows, DFF, (const float*)p.out, (const float*)XH, 8, 0.5f));
        RUN(phase_rowpass(p, true, 1, true, l == 0, 1, 0, 1, Mrows));
    }
#undef RUN
}

extern "C" void kernel_launch(void* const* d_in, const int* in_sizes, int n_in, void* d_out, int out_size, void* d_ws, size_t ws_size, hipStream_t stream) {
    static int grid = 0;
    if (grid == 0) {
        if (n_in != 31 || out_size != MX * DM || ws_size < WS_END) { fprintf(stderr, "kernel_launch: unexpected shapes (n_in %d out %d ws %zu)\n", n_in, out_size, ws_size); grid = -1; return; }
        int dev = 0, cus = 0, per_cu = 0;
        hipGetDevice(&dev); hipDeviceGetAttribute(&cus, hipDeviceAttributeMultiprocessorCount, dev);
        hipFuncSetAttribute((const void*)mk_fwd, hipFuncAttributeMaxDynamicSharedMemorySize, LDS_BYTES);
        hipOccupancyMaxActiveBlocksPerMultiprocessor(&per_cu, (const void*)mk_fwd, NTHR, LDS_BYTES);
        if (per_cu < 1) { fprintf(stderr, "kernel_launch: occupancy query says %d blocks per CU\n", per_cu); grid = -1; return; }
        grid = cus;
    }
    if (grid < 0) return;
    P p{};
    for (int i = 0; i < 31; ++i) p.in[i] = (const float*)d_in[i];
    p.out = (float*)d_out; p.ws = (unsigned char*)d_ws; p.ph_lo = 0; p.ph_hi = 1000;
    void* args[] = {&p};
    hipError_t e = hipLaunchCooperativeKernel((const void*)mk_fwd, dim3(grid), dim3(NTHR), args, LDS_BYTES, stream);
    if (e != hipSuccess) fprintf(stderr, "cooperative launch failed: %s (grid %d)\n", hipGetErrorString(e), grid);
}
```

```cpp
#include <hip/hip_runtime.h>
#include <hip/hip_cooperative_groups.h>
#include <cstdio>
#include <cstdint>
namespace cg = cooperative_groups;

typedef unsigned short bf16_t;
typedef float f32x4 __attribute__((ext_vector_type(4)));
typedef unsigned u32x4 __attribute__((ext_vector_type(4)));
typedef unsigned u32x2 __attribute__((ext_vector_type(2)));
#define DI __device__ __forceinline__

constexpr int NB = 8, SEQ = 2048, CTXL = 256, DM = 1024, DFF = 2816;
constexpr int MX = NB * SEQ, MH = NB * CTXL, MT = MX + MH;
constexpr float ALPHA = 1.41421356237309515f;
constexpr float LN_EPS = 1e-6f;
constexpr float LAMBDA_INIT = 0.35550906759f;
constexpr int NTHR = 512;

constexpr int LD0 = 3328, C_NQ = 0, C_NK = 512, C_NV = 1024, C_GQ = 1536, C_GK = 1792, C_GV = 2048, C_GR = 2560, C_ZF = 3072, C_ZB = 3088;
constexpr int LD1 = 3072;

constexpr size_t MiB = 1u << 20;
constexpr size_t WS_MOD = 0;
constexpr size_t WS_ROPE = 1 * MiB;
constexpr size_t WS_XH = 2 * MiB;
constexpr size_t WS_WT = 10 * MiB;
constexpr size_t WT_LAYER = 42 * MiB;
constexpr size_t WT_F1I = 0, WT_F1O = 11 * MiB, WT_MI = 16 * MiB + MiB / 2, WT_MO = 23 * MiB, WT_F2I = 25 * MiB, WT_F2O = 36 * MiB;
constexpr size_t WS_A = 94 * MiB;
constexpr size_t WS_H = 130 * MiB;
constexpr size_t WS_OF = 247 * MiB;
constexpr size_t WS_OB = 265 * MiB;
constexpr size_t WS_CTL = 284 * MiB;
constexpr size_t CTL_BYTES = 16384;
constexpr size_t WS_END = 285 * MiB;

constexpr int REP_ROW = 1, REP_SWI = 1, REP_STORE = 1, REP_DIFF = 1, REP_NA = 1, REP_G1 = 1, REP_G3 = 1, REP_PRO = 1, REP_SYNC = 1;
constexpr int LDS_BYTES = 147456;

struct P { const float* in[31]; float* out; unsigned char* ws; int ph_lo, ph_hi; };

DI float bf2f(bf16_t h) { return __uint_as_float(((unsigned)h) << 16); }
DI bf16_t f2bf(float f) { unsigned u = __float_as_uint(f); return (bf16_t)((u + 0x7fffu + ((u >> 16) & 1u)) >> 16); }
DI unsigned pk2(float lo, float hi) { return (unsigned)f2bf(lo) | ((unsigned)f2bf(hi) << 16); }
DI float silu_f(float v) { return v / (1.f + expf(-v)); }
DI float wave_sum(float v) {
#pragma unroll
    for (int o = 1; o < 64; o <<= 1) v += __shfl_xor(v, o);
    return v;
}
DI int otid() { int t = threadIdx.x; asm volatile("" : "+v"(t)); return t; }
DI float* xres_ptr(const P& p, int m) { return m < MX ? p.out + (size_t)m * DM : (float*)(p.ws + WS_XH) + (size_t)(m - MX) * DM; }
DI const float* xin_ptr(const P& p, int m) { return m < MX ? p.in[0] + (size_t)m * DM : p.in[2] + (size_t)(m - MX) * DM; }
DI int modrow(int m) { return m < MX ? (m >> 11) : 8; }
DI const float* mod_ptr(const P& p, int l, int r, int chunk) { return (const float*)(p.ws + WS_MOD) + ((size_t)(l * 9 + r) * 9 + chunk) * DM; }
DI bf16_t* wt_ptr(const P& p, int l, size_t off) { return (bf16_t*)(p.ws + WS_WT + (size_t)l * WT_LAYER + off); }

DI void phase_adaln(const P& p, float* lds) {
    float* sc = lds; float* red = lds + 9 * 1024;
    const int tid = otid(), lane = tid & 63, w = tid >> 6;
    for (int i = tid; i < 9 * 1024; i += NTHR) { const int r = i >> 10, k = i & 1023; const float v = r < 8 ? p.in[1][r * 1024 + k] : p.in[3][k]; sc[i] = silu_f(v); }
    __syncthreads();
    for (int item = blockIdx.x; item < 288; item += gridDim.x) {
        const int l = item / 144, cb = item % 144, n = cb * 64 + lane;
        const float* W = p.in[l ? 18 : 4]; const float* bb = p.in[l ? 19 : 5];
        float acc[9];
#pragma unroll
        for (int r = 0; r < 9; ++r) acc[r] = 0.f;
#pragma unroll 4
        for (int k = w * 128; k < w * 128 + 128; ++k) { const float wv = W[(size_t)k * 9216 + n];
#pragma unroll
            for (int r = 0; r < 9; ++r) acc[r] += sc[r * 1024 + k] * wv; }
#pragma unroll
        for (int r = 0; r < 9; ++r) red[(w * 9 + r) * 64 + lane] = acc[r];
        __syncthreads();
        float* MOD = (float*)(p.ws + WS_MOD);
        for (int o = tid; o < 576; o += NTHR) { const int r = o >> 6, c = o & 63; float s = bb[cb * 64 + c];
#pragma unroll
            for (int w2 = 0; w2 < 8; ++w2) s += red[(w2 * 9 + r) * 64 + c];
            MOD[(size_t)(l * 9 + r) * 9216 + cb * 64 + c] = s; }
        __syncthreads();
    }
}
DI void phase_rope_table(const P& p) {
    float* T = (float*)(p.ws + WS_ROPE);
    for (int idx = blockIdx.x * NTHR + otid(); idx < 2048 * 32; idx += gridDim.x * NTHR) {
        const int t = idx >> 5, j = idx & 31, fi = j & 15; const float pos = (float)(j < 16 ? (t >> 6) : (t & 63));
        const float inv = powf(10000.f, -(float)(2 * fi) / 32.f); const float ang = pos * inv;
        T[idx * 2] = cosf(ang); T[idx * 2 + 1] = sinf(ang);
    }
}
DI void conv_item(const float* W, int K, int Nsrc, int src0, bf16_t* WT, int n0dst, int k0, float* scr, int lane) {
    if (src0 >= 0) {
#pragma unroll 8
        for (int i = 0; i < 32; ++i) { const int kk = 2 * i + (lane >> 5); scr[kk * 33 + (lane & 31)] = W[(size_t)(k0 + kk) * Nsrc + src0 + (lane & 31)]; }
    } else {
#pragma unroll 8
        for (int i = 0; i < 32; ++i) { const int kk = 2 * i + (lane >> 5); scr[kk * 33 + (lane & 31)] = 0.f; }
    }
    asm volatile("s_waitcnt lgkmcnt(0)" ::: "memory");
    const int c = lane & 7;
#pragma unroll
    for (int j = 0; j < 4; ++j) { const int n = (lane >> 3) + 8 * j; const float* s = scr + (8 * c) * 33 + n;
        u32x4 o; o.x = pk2(s[0 * 33], s[1 * 33]); o.y = pk2(s[2 * 33], s[3 * 33]); o.z = pk2(s[4 * 33], s[5 * 33]); o.w = pk2(s[6 * 33], s[7 * 33]);
        *(u32x4*)(WT + (size_t)(n0dst + n) * K + k0 + 8 * c) = o; }
    asm volatile("s_waitcnt lgkmcnt(0)" ::: "memory");
}
DI void conv_matrix_item(const float* W, int K, int Nsrc, int Ndst, int kind, bf16_t* WT, int item, float* scr, int lane) {
    const int nblk = Ndst / 32, kb = item / nblk, nb = item % nblk, n0 = nb * 32;
    int src0;
    if (kind == 1) { const int t = n0 >> 8, j = n0 & 255; src0 = j < 128 ? 128 * t + j : DFF + 128 * t + (j - 128); }
    else src0 = n0 < Nsrc ? n0 : -1;
    conv_item(W, K, Nsrc, src0, WT, n0, kb * 64, scr, lane);
}
DI void phase_convert(const P& p, float* lds) {
    const int tid = otid(), lane = tid & 63, w = tid >> 6;
    float* scr = lds + w * (64 * 33 + 16);
    const int gw = blockIdx.x * 8 + w, NGW = gridDim.x * 8;
    for (int l = 0; l < 2; ++l) {
        const int b = l ? 18 : 4;
        const int nmi = l ? 3072 : 3104, nmid = l ? 3072 : 3328;
        const int i0 = 16 * 176, i1 = 44 * 32, i2 = 16 * (nmid / 32), i3 = 16 * 32;
        const int total = i0 + i1 + i2 + i3 + i0 + i1;
        for (int it = gw; it < total; it += NGW) {
            int r = it;
            if (r < i0) { conv_matrix_item(p.in[b + 2], 1024, 5632, 5632, 1, wt_ptr(p, l, WT_F1I), r, scr, lane); continue; } r -= i0;
            if (r < i1) { conv_matrix_item(p.in[b + 3], 2816, 1024, 1024, 0, wt_ptr(p, l, WT_F1O), r, scr, lane); continue; } r -= i1;
            if (r < i2) { conv_matrix_item(p.in[b + 4], 1024, nmi, nmid, 0, wt_ptr(p, l, WT_MI), r, scr, lane); continue; } r -= i2;
            if (r < i3) { conv_matrix_item(p.in[b + 5], 1024, 1024, 1024, 0, wt_ptr(p, l, WT_MO), r, scr, lane); continue; } r -= i3;
            const int f2 = l ? 29 : 16;
            if (r < i0) { conv_matrix_item(p.in[f2], 1024, 5632, 5632, 1, wt_ptr(p, l, WT_F2I), r, scr, lane); continue; } r -= i0;
            conv_matrix_item(p.in[f2 + 1], 2816, 1024, 1024, 0, wt_ptr(p, l, WT_F2O), r, scr, lane);
        }
    }
}

DI void phase_rowpass(const P& p, bool do_ln, int src_mode, bool write_x, bool write_a, int l_mod, int ch_shift, int ch_scale, int M) {
    const int tid = otid(), lane = tid & 63, w = tid >> 6;
    const int gw = blockIdx.x * 8 + w, NGW = gridDim.x * 8;
    bf16_t* A = (bf16_t*)(p.ws + WS_A);
    for (int m = gw; m < M; m += NGW) {
        const f32x4* src = (const f32x4*)(src_mode == 0 ? xin_ptr(p, m) : (const float*)xres_ptr(p, m)) + lane;
        f32x4 v[4]; float s = 0.f;
#pragma unroll
        for (int j = 0; j < 4; ++j) { v[j] = src[64 * j]; s += (v[j].x + v[j].y) + (v[j].z + v[j].w); }
        if (do_ln) {
            const float mean = wave_sum(s) * (1.f / DM); float s2 = 0.f;
#pragma unroll
            for (int j = 0; j < 4; ++j) { v[j] = v[j] - mean; s2 += (v[j].x * v[j].x + v[j].y * v[j].y) + (v[j].z * v[j].z + v[j].w * v[j].w); }
            const float rstd = 1.0f / sqrtf(wave_sum(s2) * (1.f / DM) + LN_EPS);
#pragma unroll
            for (int j = 0; j < 4; ++j) v[j] = v[j] * rstd;
        }
        if (write_x) { f32x4* dst = (f32x4*)xres_ptr(p, m) + lane;
#pragma unroll
            for (int j = 0; j < 4; ++j) dst[64 * j] = v[j]; }
        if (write_a) {
            const f32x4* sh = (const f32x4*)mod_ptr(p, l_mod, modrow(m), ch_shift) + lane; const f32x4* scp = (const f32x4*)mod_ptr(p, l_mod, modrow(m), ch_scale) + lane;
            u32x2* o8 = (u32x2*)(A + (size_t)m * DM) + lane;
#pragma unroll
            for (int j = 0; j < 4; ++j) { const f32x4 a = v[j] * (scp[64 * j] + 1.0f) + sh[64 * j]; u32x2 o; o.x = pk2(a.x, a.y); o.y = pk2(a.z, a.w); o8[64 * j] = o; }
        }
    }
}

template <class Epi>
DI void naive_gemm(const bf16_t* A, const bf16_t* Wt, int M, int N, int K, const Epi& epi, float* lds) {
    float* sA = lds; float* sB = lds + 32 * 132;
    const int tid = otid(), tx = tid & 31, ty = tid >> 5;
    const int ntn = N / 256, ntm = M / 128, ntiles = ntm * ntn;
    for (int tile = blockIdx.x; tile < ntiles; tile += gridDim.x) {
        const int tn = tile % ntn, tm = tile / ntn, m0 = tm * 128, n0 = tn * 256;
        float acc[8][8];
#pragma unroll
        for (int i = 0; i < 8; ++i)
#pragma unroll
            for (int j = 0; j < 8; ++j) acc[i][j] = 0.f;
        for (int k0 = 0; k0 < K; k0 += 32) {
            const int row = tid >> 2, kc = (tid & 3) * 8;
            { const u32x4 raw = *(const u32x4*)(A + (size_t)(m0 + row) * K + k0 + kc);
#pragma unroll
              for (int j = 0; j < 4; ++j) { sA[(kc + 2 * j) * 132 + row] = __uint_as_float(raw[j] << 16); sA[(kc + 2 * j + 1) * 132 + row] = __uint_as_float(raw[j] & 0xffff0000u); } }
#pragma unroll
            for (int h = 0; h < 2; ++h) { const int rb = row + 128 * h; const u32x4 raw = *(const u32x4*)(Wt + (size_t)(n0 + rb) * K + k0 + kc);
#pragma unroll
              for (int j = 0; j < 4; ++j) { sB[(kc + 2 * j) * 264 + rb] = __uint_as_float(raw[j] << 16); sB[(kc + 2 * j + 1) * 264 + rb] = __uint_as_float(raw[j] & 0xffff0000u); } }
            __syncthreads();
#pragma unroll 4
            for (int kk = 0; kk < 32; ++kk) {
                const f32x4 a0 = *(const f32x4*)&sA[kk * 132 + ty * 8], a1 = *(const f32x4*)&sA[kk * 132 + ty * 8 + 4];
                const f32x4 b0 = *(const f32x4*)&sB[kk * 264 + tx * 4], b1 = *(const f32x4*)&sB[kk * 264 + 128 + tx * 4];
                const float a[8] = {a0.x, a0.y, a0.z, a0.w, a1.x, a1.y, a1.z, a1.w}; const float b[8] = {b0.x, b0.y, b0.z, b0.w, b1.x, b1.y, b1.z, b1.w};
#pragma unroll
                for (int i = 0; i < 8; ++i)
#pragma unroll
                    for (int j = 0; j < 8; ++j) acc[i][j] += a[i] * b[j];
            }
            __syncthreads();
        }
#pragma unroll
        for (int i = 0; i < 8; ++i)
#pragma unroll
            for (int j = 0; j < 4; ++j) epi.pair(m0 + ty * 8 + i, tn, tx * 4 + j, acc[i][j], acc[i][4 + j]);
    }
}
struct EpiSwiglu { bf16_t* H; DI void pair(int m, int t, int c, float va, float vg) const { H[(size_t)m * DFF + t * 128 + c] = f2bf(silu_f(va) * vg); } };
struct EpiStore { bf16_t* O; int ld; DI void pair(int m, int t, int c, float va, float vg) const { O[(size_t)m * ld + t * 256 + c] = f2bf(va); O[(size_t)m * ld + t * 256 + 128 + c] = f2bf(vg); } };
struct EpiResid { const P* p; int src_mode, l, chunk; float scale;
    DI void one(int m, int n, float v) const { const float* res = src_mode ? (const float*)xres_ptr(*p, m) : xin_ptr(*p, m); const float g = mod_ptr(*p, l, modrow(m), chunk)[n]; xres_ptr(*p, m)[n] = ALPHA * res[n] + g * scale * v; }
    DI void pair(int m, int t, int c, float va, float vg) const { one(m, t * 256 + c, va); one(m, t * 256 + 128 + c, vg); } };

namespace pg8 {
#define PG8_LAS __attribute__((address_space(3)))
typedef unsigned short bf16_t;
typedef short bf16x8 __attribute__((ext_vector_type(8)));
typedef float f32x4 __attribute__((ext_vector_type(4)));
typedef unsigned u32x4 __attribute__((ext_vector_type(4)));
constexpr int BM = 256, BK = 64, HALF = 128, HTB = HALF * BK * 2  , STAGE_BYTES = 8 * HTB, NXCD = 8, WGM = 8;

__host__ __device__ __forceinline__ int lds_byte(int r, int c) { const int st = (r >> 4) * 2 + (c >> 5), rr = r & 15, cc = c & 31, ob = rr * 64 + cc * 2; return st * 1024 + (ob ^ (((ob >> 9) & 1) << 5)); }
__host__ __device__ __forceinline__ void stage_rc(int b, int& R, int& C) { const int st = b / 1024, sb = b % 1024, swz = sb ^ (((sb >> 9) & 1) << 5); R = (st >> 1) * 16 + swz / 64; C = (st & 1) * 32 + (swz % 64) / 2; }
__host__ __device__ __forceinline__ int perm32(int rho) { const int n = rho >> 4, i = rho & 15; return 8 * (i >> 2) + 4 * n + (i & 3); }

struct Unit { int pm, pn; };
struct Gemm { const bf16_t* A; const bf16_t* Bt; int M, N, K; };

struct StaticOrder {
    int nM, nN, nwg, G, c;
    __host__ __device__ void init(int M, int N, int G_, int c_) { nM = M / BM; nN = N / BM; nwg = nM * nN; G = G_; c = c_; }
    __host__ __device__ bool next(int i, Unit& u) const {
        const long L = (long)i * G + c; if (L >= nwg) return false;
        int wgid = (int)L; { const int q = nwg / NXCD, r = nwg % NXCD, xcd = wgid % NXCD, off = wgid / NXCD; wgid = (xcd < r ? xcd * (q + 1) : r * (q + 1) + (xcd - r) * q) + off; }
        const int nig = WGM * nN, gid = wgid / nig, fm = gid * WGM, gsz = (nM - fm) < WGM ? (nM - fm) : WGM;
        u.pm = fm + ((wgid % nig) % gsz); u.pn = (wgid % nig) / gsz; return true;
    }
    __device__ __forceinline__ void a_ready(const Unit&) const {}
    __device__ __forceinline__ void done(const Unit&) const {}
};

__device__ __forceinline__ unsigned cvt_pk_bf16(float lo, float hi) { unsigned r; asm volatile("v_cvt_pk_bf16_f32 %0, %1, %2" : "=v"(r) : "v"(lo), "v"(hi)); return r; }
__device__ __forceinline__ float fast_silu(float a) { return a * __builtin_amdgcn_rcpf(1.0f + __builtin_amdgcn_exp2f(-1.4426950408889634f * a)); }
struct EpiSwigluF {
    static constexpr bool PERM = true, AFTER_DRAIN = false;
    bf16_t* H; int ldh;
    __device__ __forceinline__ void operator()(const f32x4 (&acc)[2][2][4][2], const Unit& u, int wr, int wc, int fr, int fq) const {
        const int row0 = u.pm * BM + wr * 64 + fr, col0 = u.pn * HALF + wc * 32 + 8 * fq;
#pragma unroll
        for (int ai = 0; ai < 2; ++ai)
#pragma unroll
            for (int m = 0; m < 4; ++m) { bf16_t* rowp = H + (size_t)(row0 + ai * HALF + m * 16) * ldh + col0;
                const f32x4 a0 = acc[ai][0][m][0], a1 = acc[ai][0][m][1], g0 = acc[ai][1][m][0], g1 = acc[ai][1][m][1];
                u32x4 w; w.x = cvt_pk_bf16(fast_silu(a0[0]) * g0[0], fast_silu(a0[1]) * g0[1]); w.y = cvt_pk_bf16(fast_silu(a0[2]) * g0[2], fast_silu(a0[3]) * g0[3]);
                w.z = cvt_pk_bf16(fast_silu(a1[0]) * g1[0], fast_silu(a1[1]) * g1[1]); w.w = cvt_pk_bf16(fast_silu(a1[2]) * g1[2], fast_silu(a1[3]) * g1[3]);
                *(u32x4*)rowp = w; }
    }
};
struct EpiStoreF {
    static constexpr bool PERM = true, AFTER_DRAIN = false;
    bf16_t* O; int ld; const float* T; int rope_tiles, rope_rows;
    __device__ __forceinline__ void operator()(const f32x4 (&acc)[2][2][4][2], const Unit& u, int wr, int wc, int fr, int fq) const {
        const int row0 = u.pm * BM + wr * 64 + fr, col0 = u.pn * BM + wc * 32 + 8 * fq;
        const bool rope = (u.pn < rope_tiles) && (u.pm * BM < rope_rows);
        const int jt = (wc & 1) * 16 + ((8 * fq) & 15);
        const float sgn = fq < 2 ? -1.f : 1.f;
#pragma unroll
        for (int ai = 0; ai < 2; ++ai)
#pragma unroll
            for (int m = 0; m < 4; ++m) { const int row = row0 + ai * HALF + m * 16; bf16_t* rowp = O + (size_t)row * ld + col0;
#pragma unroll
                for (int bj = 0; bj < 2; ++bj) { f32x4 v0 = acc[ai][bj][m][0], v1 = acc[ai][bj][m][1];
                    if (rope) {
                        const f32x4* tp = (const f32x4*)(T + ((size_t)(row & 2047) * 32 + jt) * 2);
                        const f32x4 t0 = tp[0], t1 = tp[1], t2 = tp[2], t3 = tp[3];
                        f32x4 p0, p1;
#pragma unroll
                        for (int j = 0; j < 4; ++j) { p0[j] = __shfl_xor(v0[j], 32); p1[j] = __shfl_xor(v1[j], 32); }
                        v0 = (f32x4){v0[0] * t0[0] + sgn * p0[0] * t0[1], v0[1] * t0[2] + sgn * p0[1] * t0[3], v0[2] * t1[0] + sgn * p0[2] * t1[1], v0[3] * t1[2] + sgn * p0[3] * t1[3]};
                        v1 = (f32x4){v1[0] * t2[0] + sgn * p1[0] * t2[1], v1[1] * t2[2] + sgn * p1[1] * t2[3], v1[2] * t3[0] + sgn * p1[2] * t3[1], v1[3] * t3[2] + sgn * p1[3] * t3[3]};
                    }
                    u32x4 w; w.x = cvt_pk_bf16(v0[0], v0[1]); w.y = cvt_pk_bf16(v0[2], v0[3]); w.z = cvt_pk_bf16(v1[0], v1[1]); w.w = cvt_pk_bf16(v1[2], v1[3]);
                    *(u32x4*)(rowp + bj * HALF) = w; } }
    }
};
struct EpiResidF {
    static constexpr bool PERM = false, AFTER_DRAIN = false;
    const float* xi; const float* hi; float* xo; float* ho; const float* gx; const float* gh; float scale, alpha;
    __device__ __forceinline__ void operator()(const f32x4 (&acc)[2][2][4][2], const Unit& u, int wr, int wc, int fr, int fq) const {
        const bool lat = u.pm < 64;
        const int rowt = (lat ? u.pm : u.pm - 64) * BM + wr * 64 + fr, col0 = u.pn * BM + wc * 32 + 4 * fq;
        const float* ri = lat ? xi : hi; float* ro = lat ? xo : ho; const float* g = lat ? gx + (size_t)9216 * (u.pm >> 3) : gh;
        f32x4 gv[2][2];
#pragma unroll
        for (int bj = 0; bj < 2; ++bj)
#pragma unroll
            for (int n = 0; n < 2; ++n) gv[bj][n] = *(const f32x4*)(g + col0 + bj * HALF + n * 16) * scale;
#pragma unroll
        for (int ai = 0; ai < 2; ++ai)
#pragma unroll
            for (int m = 0; m < 4; ++m) { const size_t off = (size_t)(rowt + ai * HALF + m * 16) * 1024 + col0;
#pragma unroll
                for (int bj = 0; bj < 2; ++bj)
#pragma unroll
                    for (int n = 0; n < 2; ++n) { const f32x4 r = *(const f32x4*)(ri + off + bj * HALF + n * 16);
                        *(f32x4*)(ro + off + bj * HALF + n * 16) = r * alpha + gv[bj][n] * acc[ai][bj][m][n]; } }
    }
};

template <class Epi, class Sched, bool ALIGN_EPI = false, bool SP2 = false>
__device__ __forceinline__ void gemm_phase(PG8_LAS unsigned char* lds, const Gemm g, const Sched& S, const Epi& E) {
    const int tid = otid(), wid = __builtin_amdgcn_readfirstlane(tid >> 6), lane = tid & 63, wr = wid >> 2, wc = wid & 3, fr = lane & 15, fq = lane >> 4;
    const int K = g.K, nt = K / BK;
    unsigned voffA[2], voffB[2];
#pragma unroll
    for (int i = 0; i < 2; ++i) { int R, C; stage_rc(tid * 16 + i * 8192, R, C); const int Rb = Epi::PERM ? ((R & ~31) + perm32(R & 31)) : R;
        voffA[i] = (unsigned)(R * K + C) * 2u; voffB[i] = (unsigned)(Rb * K + C) * 2u; }
    const size_t kstep = (size_t)(BK * 2);
    const size_t hstep = (size_t)HALF * K * 2;
    const size_t tstep = 2 * hstep;
    const unsigned ldsw = (unsigned)wid * 1024u;
    const int aoff = lds_byte(wr * 64 + fr, fq * 8), boff = lds_byte(wc * 32 + fr, fq * 8);
#define PG8_SA(b, h) (((b) * 2 + (h)) * HTB)
#define PG8_SB(b, h) ((4 + (b) * 2 + (h)) * HTB)
#define PG8_STAGE(bufoff, gbase, voff) do { _Pragma("unroll") for (int _i = 0; _i < 2; ++_i) \
        __builtin_amdgcn_global_load_lds((const unsigned*)((const char*)(gbase) + (voff)[_i]), (PG8_LAS unsigned*)(lds + (bufoff) + ldsw + _i * 8192), 16, 0, 0); } while (0)
#define PG8_LDA(dst, b, h) do { _Pragma("unroll") for (int m = 0; m < 4; ++m) _Pragma("unroll") for (int k = 0; k < 2; ++k) dst[m][k] = *(const PG8_LAS bf16x8*)(lds + PG8_SA(b, h) + aoff + m * 2048 + k * 1024); } while (0)
#define PG8_LDB(dst, b, h) do { _Pragma("unroll") for (int n = 0; n < 2; ++n) _Pragma("unroll") for (int k = 0; k < 2; ++k) dst[n][k] = *(const PG8_LAS bf16x8*)(lds + PG8_SB(b, h) + boff + n * 2048 + k * 1024); } while (0)
#define PG8_MMA(ai, bj, At, Bt) do { __builtin_amdgcn_s_setprio(1); _Pragma("unroll") for (int m = 0; m < 4; ++m) _Pragma("unroll") for (int n = 0; n < 2; ++n) _Pragma("unroll") for (int k = 0; k < 2; ++k) \
        acc[ai][bj][m][n] = __builtin_amdgcn_mfma_f32_16x16x32_bf16(Bt[n][k], At[m][k], acc[ai][bj][m][n], 0, 0, 0); __builtin_amdgcn_s_setprio(0); } while (0)
#define PG8_WAIT_V(n) asm volatile("s_waitcnt vmcnt(" #n ")" ::: "memory")
#define PG8_WAIT_L(n) asm volatile("s_waitcnt lgkmcnt(" #n ")" ::: "memory")
#define PG8_BAR __builtin_amdgcn_s_barrier()
#define PG8_SCHED __builtin_amdgcn_sched_barrier(0)
    Unit cur, nxt; int ui = 0;
    if (!S.next(0, cur)) return;
    f32x4 acc[2][2][4][2];
#pragma unroll
    for (int a = 0; a < 2; ++a)
#pragma unroll
        for (int b = 0; b < 2; ++b)
#pragma unroll
            for (int m = 0; m < 4; ++m)
#pragma unroll
                for (int n = 0; n < 2; ++n) acc[a][b][m][n] = (f32x4){0.f, 0.f, 0.f, 0.f};
    bf16x8 At[4][2], B0[2][2], B1[2][2];
    const char* cA = (const char*)g.A + (size_t)cur.pm * tstep; const char* cB = (const char*)g.Bt + (size_t)cur.pn * tstep;
    S.a_ready(cur);
    if constexpr (SP2) {
        PG8_STAGE(PG8_SB(0, 0), cB, voffB); PG8_STAGE(PG8_SB(0, 1), cB + hstep, voffB); PG8_STAGE(PG8_SA(0, 0), cA, voffA); PG8_STAGE(PG8_SA(0, 1), cA + hstep, voffA);
        if (wr == 1) PG8_BAR;
        PG8_WAIT_V(2); PG8_BAR;
        PG8_STAGE(PG8_SB(1, 0), cB + kstep, voffB); PG8_STAGE(PG8_SA(1, 0), cA + kstep, voffA); PG8_STAGE(PG8_SB(1, 1), cB + hstep + kstep, voffB);
        PG8_WAIT_V(6); PG8_BAR;
    } else {
        PG8_STAGE(PG8_SB(0, 0), cB, voffB); PG8_STAGE(PG8_SA(0, 0), cA, voffA); PG8_STAGE(PG8_SB(0, 1), cB + hstep, voffB); PG8_STAGE(PG8_SA(0, 1), cA + hstep, voffA);
        if (wr == 1) PG8_BAR;
        PG8_WAIT_V(4); PG8_BAR;
        PG8_STAGE(PG8_SB(1, 0), cB + kstep, voffB); PG8_STAGE(PG8_SA(1, 0), cA + kstep, voffA); PG8_STAGE(PG8_SB(1, 1), cB + hstep + kstep, voffB);
        PG8_WAIT_V(6); PG8_BAR;
    }
    for (;;) {
        const bool has_next = S.next(ui + 1, nxt);
        const char* nA = has_next ? (const char*)g.A + (size_t)nxt.pm * tstep : cA; const char* nB = has_next ? (const char*)g.Bt + (size_t)nxt.pn * tstep : cB;
        for (int t = 0; t < nt; t += 2) {
            const bool last = (t == nt - 2);
            const char* a1 = cA + (size_t)(t + 1) * kstep;
            const char* a2 = last ? nA : cA + (size_t)(t + 2) * kstep; const char* b2 = last ? nB : cB + (size_t)(t + 2) * kstep;
            const char* a3 = a2 + kstep; const char* b3 = b2 + kstep;
            if (last && has_next) S.a_ready(nxt);
            if constexpr (SP2) {
            PG8_LDB(B0, 0, 0); PG8_LDB(B1, 0, 1); PG8_SCHED; PG8_LDA(At, 0, 0); PG8_STAGE(PG8_SA(1, 1), a1 + hstep, voffA);
            PG8_WAIT_V(8); PG8_WAIT_L(0); PG8_BAR; PG8_MMA(0, 0, At, B0); PG8_MMA(0, 1, At, B1); PG8_BAR; PG8_SCHED;
            PG8_LDA(At, 0, 1); PG8_STAGE(PG8_SB(0, 0), b2, voffB); PG8_STAGE(PG8_SB(0, 1), b2 + hstep, voffB); PG8_STAGE(PG8_SA(0, 0), a2, voffA);
            PG8_WAIT_V(8); PG8_WAIT_L(0); PG8_BAR; PG8_MMA(1, 0, At, B0); PG8_MMA(1, 1, At, B1); PG8_BAR; PG8_SCHED;
            PG8_LDB(B0, 1, 0); PG8_LDB(B1, 1, 1); PG8_SCHED; PG8_LDA(At, 1, 0); PG8_STAGE(PG8_SA(0, 1), a2 + hstep, voffA);
            PG8_WAIT_V(8); PG8_WAIT_L(0); PG8_BAR; PG8_MMA(0, 0, At, B0); PG8_MMA(0, 1, At, B1); PG8_BAR; PG8_SCHED;
            PG8_LDA(At, 1, 1); PG8_STAGE(PG8_SB(1, 0), b3, voffB); PG8_STAGE(PG8_SB(1, 1), b3 + hstep, voffB); PG8_STAGE(PG8_SA(1, 0), a3, voffA);
            PG8_WAIT_V(8); PG8_WAIT_L(0); PG8_BAR; PG8_MMA(1, 0, At, B0); PG8_MMA(1, 1, At, B1); PG8_BAR; PG8_SCHED;
            } else {
            PG8_LDB(B0, 0, 0); PG8_SCHED; PG8_LDA(At, 0, 0); PG8_STAGE(PG8_SA(1, 1), a1 + hstep, voffA);
            PG8_WAIT_L(8); PG8_BAR; PG8_WAIT_L(0); PG8_MMA(0, 0, At, B0); PG8_BAR; PG8_SCHED;
            PG8_LDB(B1, 0, 1); PG8_STAGE(PG8_SB(0, 0), b2, voffB);
            PG8_BAR; PG8_WAIT_L(0); PG8_MMA(0, 1, At, B1); PG8_BAR;
            PG8_LDA(At, 0, 1); PG8_STAGE(PG8_SA(0, 0), a2, voffA);
            PG8_BAR; PG8_WAIT_L(0); PG8_MMA(1, 0, At, B0); PG8_BAR; PG8_SCHED;
            PG8_STAGE(PG8_SB(0, 1), b2 + hstep, voffB);
            PG8_WAIT_V(6); PG8_BAR; PG8_MMA(1, 1, At, B1); PG8_BAR;
            PG8_LDB(B0, 1, 0); PG8_SCHED; PG8_LDA(At, 1, 0); PG8_STAGE(PG8_SA(0, 1), a2 + hstep, voffA);
            PG8_WAIT_L(8); PG8_BAR; PG8_WAIT_L(0); PG8_MMA(0, 0, At, B0); PG8_BAR; PG8_SCHED;
            PG8_LDB(B1, 1, 1); PG8_STAGE(PG8_SB(1, 0), b3, voffB);
            PG8_BAR; PG8_WAIT_L(0); PG8_MMA(0, 1, At, B1); PG8_BAR;
            PG8_LDA(At, 1, 1); PG8_STAGE(PG8_SA(1, 0), a3, voffA);
            PG8_BAR; PG8_WAIT_L(0); PG8_MMA(1, 0, At, B0); PG8_BAR; PG8_SCHED;
            PG8_STAGE(PG8_SB(1, 1), b3 + hstep, voffB);
            PG8_WAIT_V(6); PG8_BAR; PG8_MMA(1, 1, At, B1); PG8_BAR;
            }
        }
        if constexpr (ALIGN_EPI) { if (wr == 0) PG8_BAR; }
        if constexpr (!Epi::AFTER_DRAIN) { E(acc, cur, wr, wc, fr, fq); S.done(cur); }
        if (!has_next) break;
#pragma unroll
        for (int a = 0; a < 2; ++a)
#pragma unroll
            for (int b = 0; b < 2; ++b)
#pragma unroll
                for (int m = 0; m < 4; ++m)
#pragma unroll
                    for (int n = 0; n < 2; ++n) acc[a][b][m][n] = (f32x4){0.f, 0.f, 0.f, 0.f};
        cur = nxt; cA = nA; cB = nB; ++ui;
        if constexpr (ALIGN_EPI) { if (wr == 1) PG8_BAR; }
    }
    PG8_WAIT_V(0);
    if constexpr (!ALIGN_EPI) { if (wr == 0) PG8_BAR; }
    PG8_BAR;
    if constexpr (Epi::AFTER_DRAIN) { E.fused(acc, cur, wr, wc, fr, fq, lds, wid, lane); S.done(cur); }
#undef PG8_SA
#undef PG8_SB
#undef PG8_STAGE
#undef PG8_LDA
#undef PG8_LDB
#undef PG8_MMA
#undef PG8_WAIT_V
#undef PG8_WAIT_L
#undef PG8_BAR
#undef PG8_SCHED
}
}
template <int NV>
DI void att_step(const float (&q)[64], const bf16_t* kp, const bf16_t* vp, float bias, float& mx, float& l, float (&o)[NV]) {
    float dot = 0.f;
#pragma unroll
    for (int c = 0; c < 8; ++c) { const u32x4 raw = *(const u32x4*)(kp + c * 8);
#pragma unroll
        for (int j = 0; j < 4; ++j) { dot += q[c * 8 + 2 * j] * __uint_as_float(raw[j] << 16); dot += q[c * 8 + 2 * j + 1] * __uint_as_float(raw[j] & 0xffff0000u); } }
    const float s = dot * 0.125f + bias;
    const float mn = fmaxf(mx, s), corr = expf(mx - mn), pr = expf(s - mn);
    mx = mn; l = l * corr + pr;
#pragma unroll
    for (int c = 0; c < NV / 8; ++c) { const u32x4 raw = *(const u32x4*)(vp + c * 8);
#pragma unroll
        for (int j = 0; j < 4; ++j) { o[c * 8 + 2 * j] = o[c * 8 + 2 * j] * corr + pr * __uint_as_float(raw[j] << 16); o[c * 8 + 2 * j + 1] = o[c * 8 + 2 * j + 1] * corr + pr * __uint_as_float(raw[j] & 0xffff0000u); } }
}
DI void load_q64(float (&q)[64], const bf16_t* qp) {
#pragma unroll
    for (int c = 0; c < 8; ++c) { const u32x4 raw = *(const u32x4*)(qp + c * 8);
#pragma unroll
        for (int j = 0; j < 4; ++j) { q[c * 8 + 2 * j] = __uint_as_float(raw[j] << 16); q[c * 8 + 2 * j + 1] = __uint_as_float(raw[j] & 0xffff0000u); } }
}
DI void phase_na_naive(const P& p) {
    const bf16_t* QKV = (const bf16_t*)(p.ws + WS_H); bf16_t* A = (bf16_t*)(p.ws + WS_A); const float* rpb = p.in[10];
    for (int idx = blockIdx.x * NTHR + otid(); idx < MT * 8; idx += gridDim.x * NTHR) {
        const int head = idx & 7, m = idx >> 3;
        float q[64], o[64]; float mx = -1e30f, l = 0.f;
        load_q64(q, QKV + (size_t)m * LD0 + C_NQ + head * 64);
#pragma unroll
        for (int d = 0; d < 64; ++d) o[d] = 0.f;
        int b;
        if (m < MX) {
            b = m >> 11; const int t = m & 2047, r = t >> 6, c = t & 63;
            const int rs = min(max(r - 4, 0), 24), cs = min(max(c - 8, 0), 48);
#pragma unroll 1
            for (int i = 0; i < 8; ++i)
#pragma unroll 1
                for (int w = 0; w < 16; ++w) { const int rr = rs + i, ww = cs + w; const size_t mk = (size_t)b * 2048 + rr * 64 + ww;
                    const float bias = rpb[(head * 15 + (rr - r + 7)) * 31 + (ww - c + 15)];
                    att_step<64>(q, QKV + mk * LD0 + C_NK + head * 64, QKV + mk * LD0 + C_NV + head * 64, bias, mx, l, o); }
        } else b = (m - MX) >> 8;
#pragma unroll 1
        for (int lk = 0; lk < 256; ++lk) { const size_t mk = (size_t)MX + b * 256 + lk;
            att_step<64>(q, QKV + mk * LD0 + C_NK + head * 64, QKV + mk * LD0 + C_NV + head * 64, 0.f, mx, l, o); }
        const float il = 1.f / l; bf16_t* op = A + (size_t)m * DM + head * 64;
#pragma unroll
        for (int d = 0; d < 64; d += 2) *(unsigned*)(op + d) = pk2(o[d] * il, o[d + 1] * il);
    }
}
DI void phase_gla_naive(const P& p, float* lds) {
    float* sq = lds; float* sk = lds + 4096; float* sa = lds + 8192; float* sv = lds + 12288;
    const bf16_t* QKV = (const bf16_t*)(p.ws + WS_H);
    const int tid = otid();
    for (int chain = blockIdx.x; chain < 64; chain += gridDim.x) {
        const int dir = chain & 1, h = (chain >> 1) & 3, b = chain >> 3;
        const float* wg = p.in[dir ? 13 : 11]; const float* bg = p.in[dir ? 14 : 12];
        bf16_t* O = (bf16_t*)(p.ws + (dir ? WS_OB : WS_OF));
        const int zoff = dir ? C_ZB : C_ZF;
        float S[64];
#pragma unroll
        for (int d = 0; d < 64; ++d) S[d] = 0.f;
        for (int seg = 0; seg < 2; ++seg) {
            const int base = seg == 0 ? MX + b * 256 : b * 2048, n = seg == 0 ? 256 : 2048;
            for (int c = 0; c < n / 64; ++c) {
                for (int idx = tid; idx < 4096; idx += NTHR) { const int i = idx >> 6, d = idx & 63, tp = c * 64 + i, t = dir ? n - 1 - tp : tp;
                    const bf16_t* rowp = QKV + (size_t)(base + t) * LD0;
                    sq[idx] = bf2f(rowp[C_GQ + h * 64 + d]) * 0.125f; sk[idx] = bf2f(rowp[C_GK + h * 64 + d]);
                    float z = bg[h * 64 + d];
#pragma unroll
                    for (int r = 0; r < 16; ++r) z += bf2f(rowp[zoff + r]) * wg[r * 256 + h * 64 + d];
                    const float ls = fminf(z, 0.f) - log1pf(expf(-fabsf(z)));
                    sa[idx] = expf(ls * (1.f / 16.f)); }
                for (int idx = tid; idx < 8192; idx += NTHR) { const int i = idx >> 7, e = idx & 127, tp = c * 64 + i, t = dir ? n - 1 - tp : tp;
                    sv[idx] = bf2f(QKV[(size_t)(base + t) * LD0 + C_GV + h * 128 + e]); }
                __syncthreads();
                if (tid < 128) {
                    const int e = tid;
#pragma unroll 1
                    for (int i = 0; i < 64; ++i) { const float ve = sv[i * 128 + e]; float o = 0.f;
#pragma unroll
                        for (int d = 0; d < 64; ++d) { float sd = sa[i * 64 + d] * S[d];
                            if (dir == 0) { sd += sk[i * 64 + d] * ve; o += sq[i * 64 + d] * sd; } else { o += sq[i * 64 + d] * sd; sd += sk[i * 64 + d] * ve; }
                            S[d] = sd; }
                        const int tp = c * 64 + i, t = dir ? n - 1 - tp : tp;
                        O[(size_t)(base + t) * 512 + h * 128 + e] = f2bf(o); }
                }
                __syncthreads();
            }
        }
    }
}
DI void phase_gla_finalize(const P& p) {
    const int tid = otid(), lane = tid & 63, w = tid >> 6;
    const int gw = blockIdx.x * 8 + w, NGW = gridDim.x * 8;
    const bf16_t* QKV = (const bf16_t*)(p.ws + WS_H); bf16_t* A = (bf16_t*)(p.ws + WS_A);
    const bf16_t* OF = (const bf16_t*)(p.ws + WS_OF); const bf16_t* OB = (const bf16_t*)(p.ws + WS_OB); const float* ng = p.in[15];
    for (int m = gw; m < MT; m += NGW) {
        const u32x4 rf = *(const u32x4*)(OF + (size_t)m * 512 + lane * 8), rb = *(const u32x4*)(OB + (size_t)m * 512 + lane * 8), rg = *(const u32x4*)(QKV + (size_t)m * LD0 + C_GR + lane * 8);
        float s[8], g[8]; float ss = 0.f;
#pragma unroll
        for (int j = 0; j < 4; ++j) { s[2 * j] = __uint_as_float(rf[j] << 16) + __uint_as_float(rb[j] << 16); s[2 * j + 1] = __uint_as_float(rf[j] & 0xffff0000u) + __uint_as_float(rb[j] & 0xffff0000u);
            g[2 * j] = __uint_as_float(rg[j] << 16); g[2 * j + 1] = __uint_as_float(rg[j] & 0xffff0000u); }
#pragma unroll
        for (int j = 0; j < 8; ++j) ss += s[j] * s[j];
        ss += __shfl_xor(ss, 1); ss += __shfl_xor(ss, 2); ss += __shfl_xor(ss, 4); ss += __shfl_xor(ss, 8);
        const float rms = 1.0f / sqrtf(ss * (1.f / 128.f) + LN_EPS);
        float o[8];
#pragma unroll
        for (int j = 0; j < 8; ++j) o[j] = s[j] * rms * ng[(lane & 15) * 8 + j] * silu_f(g[j]);
        u32x4 ov; ov.x = pk2(o[0], o[1]); ov.y = pk2(o[2], o[3]); ov.z = pk2(o[4], o[5]); ov.w = pk2(o[6], o[7]);
        *(u32x4*)(A + (size_t)m * DM + 512 + lane * 8) = ov;
    }
}
DI void phase_rope_naive(const P& p) {
    bf16_t* QKV = (bf16_t*)(p.ws + WS_H); const float* T = (const float*)(p.ws + WS_ROPE);
    for (size_t idx = (size_t)blockIdx.x * NTHR + otid(); idx < (size_t)MX * 1024; idx += (size_t)gridDim.x * NTHR) {
        const int m = (int)(idx >> 10), pi = (int)(idx & 1023), blk = pi >> 5, j = pi & 31, t = m & 2047;
        const int d0 = j < 16 ? j : 32 + (j - 16);
        const float c = T[(t * 32 + j) * 2], s = T[(t * 32 + j) * 2 + 1];
        bf16_t* u = QKV + (size_t)m * LD1 + blk * 64 + d0;
        const float u0 = bf2f(u[0]), u1 = bf2f(u[16]);
        u[0] = f2bf(u0 * c - u1 * s); u[16] = f2bf(u1 * c + u0 * s);
    }
}
DI void phase_diff_naive(const P& p) {
    const bf16_t* QKV = (const bf16_t*)(p.ws + WS_H); bf16_t* A = (bf16_t*)(p.ws + WS_A);
    float d1 = 0.f, d2 = 0.f;
    for (int i = 0; i < 64; ++i) { d1 += p.in[24][i] * p.in[25][i]; d2 += p.in[26][i] * p.in[27][i]; }
    const float lam = expf(d1) - expf(d2) + LAMBDA_INIT;
    const float* sg = p.in[28];
    for (int idx = blockIdx.x * NTHR + otid(); idx < MX * 32; idx += gridDim.x * NTHR) {
        const int quarter = idx & 3, head = (idx >> 2) & 7, m = idx >> 5, b = m >> 11;
        float res[32];
#pragma unroll 1
        for (int br = 0; br < 2; ++br) {
            float q[64], o[32]; float mx = -1e30f, l = 0.f;
            load_q64(q, QKV + (size_t)m * LD1 + head * 128 + br * 64);
#pragma unroll
            for (int e = 0; e < 32; ++e) o[e] = 0.f;
#pragma unroll 1
            for (int key = 0; key < 2304; ++key) { const size_t mk = key < 2048 ? (size_t)b * 2048 + key : (size_t)MX + b * 256 + (key - 2048);
                att_step<32>(q, QKV + mk * LD1 + 1024 + head * 128 + br * 64, QKV + mk * LD1 + 2048 + head * 128 + quarter * 32, 0.f, mx, l, o); }
            const float il = 1.f / l;
            if (br == 0) {
#pragma unroll
                for (int e = 0; e < 32; ++e) res[e] = o[e] * il;
            } else {
#pragma unroll
                for (int e = 0; e < 32; ++e) res[e] -= lam * o[e] * il;
            }
        }
        float ss = 0.f;
#pragma unroll
        for (int e = 0; e < 32; ++e) ss += res[e] * res[e];
        ss += __shfl_xor(ss, 1); ss += __shfl_xor(ss, 2);
        const float rms = 1.0f / sqrtf(ss * (1.f / 128.f) + LN_EPS);
        bf16_t* op = A + (size_t)m * DM + head * 128 + quarter * 32;
#pragma unroll
        for (int e = 0; e < 32; e += 2) *(unsigned*)(op + e) = pk2(res[e] * rms * sg[quarter * 32 + e] * (1.f - LAMBDA_INIT), res[e + 1] * rms * sg[quarter * 32 + e + 1] * (1.f - LAMBDA_INIT));
    }
}


namespace att {
#define ALDS __attribute__((address_space(3)))
typedef short bf16x8 __attribute__((ext_vector_type(8)));
typedef short s16x4 __attribute__((ext_vector_type(4)));
typedef float f32x16 __attribute__((ext_vector_type(16)));
typedef float f32x2_t __attribute__((ext_vector_type(2)));
typedef __bf16 bf16x2_t __attribute__((ext_vector_type(2)));
constexpr int KV_STAGE = 32768;
constexpr int OFF_BIAS = 65536;
constexpr int BIAS_STRIDE = 640;
constexpr int OFF_SG = 65536 + 8192;
constexpr float LOG2E = 1.4426950408889634f;
DI unsigned cvtpk(float lo, float hi) { f32x2_t v = {lo, hi}; bf16x2_t b = __builtin_convertvector(v, bf16x2_t); return __builtin_bit_cast(unsigned, b); }
DI unsigned fxor(unsigned row) { return ((row & 3u) << 2) | ((row >> 2) & 3u); }
DI unsigned off_b(unsigned row, unsigned ch) { return 256u * row + 16u * (ch ^ fxor(row)); }
DI s16x4 vtr(const ALDS unsigned char* p) { typedef short v4i16_t __attribute__((ext_vector_type(4))); return __builtin_bit_cast(s16x4, __builtin_amdgcn_ds_read_tr16_b64_v4i16((ALDS v4i16_t*)p)); }
DI float half_swap(float v) { return __shfl_xor(v, 32); }

template <class RowPtr>
DI void dma_image(ALDS unsigned char* img, int wid, int lane, const RowPtr& rowptr) {
#pragma unroll
    for (int i = 0; i < 2; ++i) { const int ci = 2 * wid + i; const unsigned row = 4u * ci + (lane >> 4), pos = lane & 15, ch = pos ^ fxor(row);
        const unsigned char* src = rowptr((int)row) + 16u * ch;
        __builtin_amdgcn_global_load_lds((const unsigned*)src, (ALDS unsigned*)(img + 1024 * ci), 16, 0, 0); }
}

struct WaveState { float m, l; };

template <int NC, class TFn>
DI void step(f32x16 (&OT)[NC], WaveState& st, const bf16x8 (&qf)[4], const ALDS unsigned char* Kimg, const ALDS unsigned char* Vimg, const unsigned (&kaddr)[4], const unsigned (&vaddr)[NC][2], float cscale, const TFn& tfn) {
    f32x16 S[2];
#pragma unroll
    for (int j = 0; j < 2; ++j) {
#pragma unroll
        for (int r = 0; r < 16; ++r) S[j][r] = 0.f;
#pragma unroll
        for (int d0 = 0; d0 < 4; ++d0) { const bf16x8 kf = *(const ALDS bf16x8*)(Kimg + kaddr[d0] + 8192 * j); S[j] = __builtin_amdgcn_mfma_f32_32x32x16_bf16(kf, qf[d0], S[j], 0, 0, 0); }
    }
    float mx = -1e30f;
#pragma unroll
    for (int j = 0; j < 2; ++j)
#pragma unroll
        for (int r = 0; r < 16; ++r) { S[j][r] = tfn(j, r, S[j][r] * cscale); mx = fmaxf(mx, S[j][r]); }
    mx = fmaxf(mx, half_swap(mx));
    const float mn = fmaxf(st.m, mx), alpha = __builtin_amdgcn_exp2f(st.m - mn);
    st.m = mn;
    float rs = 0.f;
#pragma unroll
    for (int j = 0; j < 2; ++j)
#pragma unroll
        for (int r = 0; r < 16; ++r) { S[j][r] = __builtin_amdgcn_exp2f(S[j][r] - mn); rs += S[j][r]; }
    st.l = st.l * alpha + rs;
    if (__any(alpha != 1.0f)) {
#pragma unroll
        for (int c = 0; c < NC; ++c)
#pragma unroll
            for (int r = 0; r < 16; ++r) OT[c][r] *= alpha;
    }
#pragma unroll
    for (int j = 0; j < 2; ++j)
#pragma unroll
        for (int ks = 0; ks < 2; ++ks) {
            u32x4 pw; pw.x = cvtpk(S[j][8 * ks], S[j][8 * ks + 1]); pw.y = cvtpk(S[j][8 * ks + 2], S[j][8 * ks + 3]); pw.z = cvtpk(S[j][8 * ks + 4], S[j][8 * ks + 5]); pw.w = cvtpk(S[j][8 * ks + 6], S[j][8 * ks + 7]);
            const bf16x8 pf = __builtin_bit_cast(bf16x8, pw);
#pragma unroll
            for (int c = 0; c < NC; ++c) { const s16x4 lo = vtr(Vimg + vaddr[c][0] + 8192 * j + 4096 * ks), hi = vtr(Vimg + vaddr[c][1] + 8192 * j + 4096 * ks);
                const bf16x8 vf = {lo[0], lo[1], lo[2], lo[3], hi[0], hi[1], hi[2], hi[3]};
                OT[c] = __builtin_amdgcn_mfma_f32_32x32x16_bf16(vf, pf, OT[c], 0, 0, 0); }
        }
}
DI void make_kaddr(unsigned (&kaddr)[4], int lane, int ks_base) {
    const unsigned i = lane & 31, h = lane >> 5, rowp = (i & ~12u) | ((i & 4u) << 1) | ((i & 8u) >> 1);
#pragma unroll
    for (int d0 = 0; d0 < 4; ++d0) kaddr[d0] = off_b(rowp, 2u * (ks_base + d0) + h);
}
template <int NC>
DI void make_vaddr(unsigned (&vaddr)[NC][2], int lane, int c_base) {
    const unsigned h = lane >> 5, blk = (lane >> 4) & 1, q = (lane & 15) >> 2, p = lane & 3;
#pragma unroll
    for (int c = 0; c < NC; ++c)
#pragma unroll
        for (int t = 0; t < 2; ++t) vaddr[c][t] = off_b(8u * h + 4u * t + q, 4u * (c_base + c) + 2u * blk + (p >> 1)) + 8u * (p & 1);
}
DI void load_q(bf16x8 (&qf)[4], const bf16_t* qrow, int lane) {
    const int h = lane >> 5;
#pragma unroll
    for (int d0 = 0; d0 < 4; ++d0) qf[d0] = *(const bf16x8*)(qrow + 16 * d0 + 8 * h);
}
#define ATT_WAIT_BAR() do { asm volatile("s_waitcnt vmcnt(0) lgkmcnt(0)" ::: "memory"); __builtin_amdgcn_s_barrier(); asm volatile("" ::: "memory"); } while (0)

DI void phase_diff(const P& p, unsigned char* lds_generic) {
    ALDS unsigned char* lds = (ALDS unsigned char*)lds_generic;
    const int tid = otid(), lane = tid & 63, wid = __builtin_amdgcn_readfirstlane(tid >> 6), g = wid >> 2, qb = wid & 3, h = lane >> 5;
    const bf16_t* QKV = (const bf16_t*)(p.ws + WS_H); bf16_t* A = (bf16_t*)(p.ws + WS_A);
    float d1 = 0.f, d2 = 0.f;
    for (int i = 0; i < 64; ++i) { d1 += p.in[24][i] * p.in[25][i]; d2 += p.in[26][i] * p.in[27][i]; }
    const float lam = expf(d1) - expf(d2) + LAMBDA_INIT;
    ALDS float* sgl = (ALDS float*)(lds + OFF_SG);
    if (tid < 128) sgl[tid] = p.in[28][tid] * (1.f - LAMBDA_INIT);
    unsigned kaddr[4], vaddr[4][2];
    make_kaddr(kaddr, lane, 4 * g); make_vaddr<4>(vaddr, lane, 0);
    const float cscale = 0.125f * LOG2E;
    for (int unit = blockIdx.x; unit < 1024; unit += gridDim.x) {
        const int b = unit >> 7, head = (unit >> 4) & 7, qblk = unit & 15;
        const int mq = b * 2048 + qblk * 128 + qb * 32 + (lane & 31);
        bf16x8 qf[4]; load_q(qf, QKV + (size_t)mq * LD1 + head * 128 + g * 64, lane);
        f32x16 OT[4];
#pragma unroll
        for (int c = 0; c < 4; ++c)
#pragma unroll
            for (int r = 0; r < 16; ++r) OT[c][r] = 0.f;
        WaveState st{-1e30f, 0.f};
        auto issue = [&](int s) {
            ALDS unsigned char* base = lds + (s & 1) * KV_STAGE;
            auto krow = [&](int row) { const int key = s * 64 + row; const size_t m = key < 2048 ? (size_t)b * 2048 + key : (size_t)MX + b * 256 + (key - 2048); return (const unsigned char*)(QKV + m * LD1 + 1024 + head * 128); };
            auto vrow = [&](int row) { const int key = s * 64 + row; const size_t m = key < 2048 ? (size_t)b * 2048 + key : (size_t)MX + b * 256 + (key - 2048); return (const unsigned char*)(QKV + m * LD1 + 2048 + head * 128); };
            dma_image(base, wid, lane, krow); dma_image(base + 16384, wid, lane, vrow);
        };
        issue(0);
#pragma unroll 1
        for (int s = 0; s < 36; ++s) {
            ATT_WAIT_BAR();
            if (s + 1 < 36) issue(s + 1);
            const ALDS unsigned char* base = lds + (s & 1) * KV_STAGE;
            step<4>(OT, st, qf, base, base + 16384, kaddr, vaddr, cscale, [](int, int, float v) { return v; });
        }
        const float inv = 1.0f / (st.l + half_swap(st.l));
        ATT_WAIT_BAR();
        ALDS float* exch = (ALDS float*)lds + qb * 4096;
        if (g == 1) {
#pragma unroll
            for (int c = 0; c < 4; ++c)
#pragma unroll
                for (int r = 0; r < 16; ++r) exch[(c * 16 + r) * 64 + lane] = OT[c][r] * inv;
        }
        ATT_WAIT_BAR();
        if (g == 0) {
            float ss = 0.f;
#pragma unroll
            for (int c = 0; c < 4; ++c)
#pragma unroll
                for (int r = 0; r < 16; ++r) { const float o = OT[c][r] * inv - lam * exch[(c * 16 + r) * 64 + lane]; OT[c][r] = o; ss += o * o; }
            ss += half_swap(ss);
            const float rms = 1.0f / sqrtf(ss * (1.f / 128.f) + LN_EPS);
            bf16_t* orow = A + (size_t)mq * DM + head * 128;
#pragma unroll
            for (int c = 0; c < 4; ++c)
#pragma unroll
                for (int r4 = 0; r4 < 4; ++r4) { const int e0 = 32 * c + 8 * r4 + 4 * h; const f32x4 sg = *(const ALDS f32x4*)(sgl + e0);
                    u32x2 w; w.x = cvtpk(OT[c][4 * r4] * rms * sg[0], OT[c][4 * r4 + 1] * rms * sg[1]); w.y = cvtpk(OT[c][4 * r4 + 2] * rms * sg[2], OT[c][4 * r4 + 3] * rms * sg[3]);
                    *(u32x2*)(orow + e0) = w; }
        }
        ATT_WAIT_BAR();
    }
}

DI void phase_na(const P& p, unsigned char* lds_generic) {
    ALDS unsigned char* lds = (ALDS unsigned char*)lds_generic;
    const int tid = otid(), lane = tid & 63, wid = __builtin_amdgcn_readfirstlane(tid >> 6), g = wid >> 2, qb = wid & 3, h = lane >> 5;
    const bf16_t* QKV = (const bf16_t*)(p.ws + WS_H); bf16_t* A = (bf16_t*)(p.ws + WS_A);
    ALDS float* biasl = (ALDS float*)(lds + OFF_BIAS);
    unsigned kaddr[4], vaddr[2][2];
    make_kaddr(kaddr, lane, 4 * g); make_vaddr<2>(vaddr, lane, 2 * g);
    const float cscale = 0.125f * LOG2E;
    int cur_hp = -1;
    for (int unit = blockIdx.x; unit < 576; unit += gridDim.x) {
        int b, hp, mq, r_q = 0, cq = 0, rs0 = 0, nloc = 0; bool lat = unit < 512;
        if (lat) { b = unit >> 6; hp = (unit >> 4) & 3; const int rp = unit & 15; r_q = 2 * rp + (qb >> 1); cq = 32 * (qb & 1) + (lane & 31);
            mq = b * 2048 + r_q * 64 + cq; rs0 = min(max(2 * rp - 4, 0), 24); const int rs1 = min(max(2 * rp + 1 - 4, 0), 24); nloc = rs1 + 8 - rs0; }
        else { const int u = unit - 512; b = u >> 3; hp = (u >> 1) & 3; mq = MX + b * 256 + (u & 1) * 128 + qb * 32 + (lane & 31); }
        const int head = 2 * hp + g;
        if (hp != cur_hp) {
            ATT_WAIT_BAR();
            for (int i = tid; i < 2 * BIAS_STRIDE; i += NTHR) { const int hh = i / BIAS_STRIDE, k = i % BIAS_STRIDE - 64; biasl[i] = (k >= 0 && k < 465) ? p.in[10][(2 * hp + hh) * 465 + k] * LOG2E : 0.f; }
            cur_hp = hp;
        }
        bf16x8 qf[4]; load_q(qf, QKV + (size_t)mq * LD0 + C_NQ + head * 64, lane);
        f32x16 OT[2];
#pragma unroll
        for (int c = 0; c < 2; ++c)
#pragma unroll
            for (int r = 0; r < 16; ++r) OT[c][r] = 0.f;
        WaveState st{-1e30f, 0.f};
        const int nsteps = nloc + 4;
        auto issue = [&](int s) {
            ALDS unsigned char* base = lds + (s & 1) * KV_STAGE;
            const size_t m0 = s < nloc ? (size_t)b * 2048 + (rs0 + s) * 64 : (size_t)MX + b * 256 + (s - nloc) * 64;
            auto krow = [&](int row) { return (const unsigned char*)(QKV + (m0 + row) * LD0 + C_NK + hp * 128); };
            auto vrow = [&](int row) { return (const unsigned char*)(QKV + (m0 + row) * LD0 + C_NV + hp * 128); };
            dma_image(base, wid, lane, krow); dma_image(base + 16384, wid, lane, vrow);
        };
        issue(0);
        const int rsq = min(max(r_q - 4, 0), 24), cs = min(max(cq - 8, 0), 48);
#pragma unroll 1
        for (int s = 0; s < nsteps; ++s) {
            ATT_WAIT_BAR();
            if (s + 1 < nsteps) issue(s + 1);
            const ALDS unsigned char* base = lds + (s & 1) * KV_STAGE;
            if (s < nloc) {
                const int rr = rs0 + s;
                if (rr >= rsq && rr < rsq + 8) {
                    const ALDS float* bl = biasl + g * BIAS_STRIDE + 64 + (rr - r_q + 7) * 31 + 15 - cq + 8 * h;
                    step<2>(OT, st, qf, base, base + 16384, kaddr, vaddr, cscale, [&](int j, int r, float v) {
                        const int w = 32 * j + 16 * (r >> 3) + 8 * h + (r & 7);
                        const float bv = bl[32 * j + 16 * (r >> 3) + (r & 7)];
                        return ((unsigned)(w - cs) < 16u) ? v + bv : -1e30f; });
                }
            } else step<2>(OT, st, qf, base, base + 16384, kaddr, vaddr, cscale, [](int, int, float v) { return v; });
        }
        const float inv = 1.0f / (st.l + half_swap(st.l));
        bf16_t* orow = A + (size_t)mq * DM + head * 64;
#pragma unroll
        for (int c = 0; c < 2; ++c)
#pragma unroll
            for (int r4 = 0; r4 < 4; ++r4) { const int e0 = 32 * c + 8 * r4 + 4 * h;
                u32x2 w; w.x = cvtpk(OT[c][4 * r4] * inv, OT[c][4 * r4 + 1] * inv); w.y = cvtpk(OT[c][4 * r4 + 2] * inv, OT[c][4 * r4 + 3] * inv);
                *(u32x2*)(orow + e0) = w; }
        ATT_WAIT_BAR();
    }
    ATT_WAIT_BAR();
}
#undef ALDS
}


namespace gla {
#define ALDS __attribute__((address_space(3)))
using att::bf16x8; using att::s16x4; using att::f32x16; using att::off_b; using att::fxor; using att::vtr; using att::cvtpk; using att::half_swap;
constexpr size_t WS_U = WS_OF;
constexpr size_t WS_GD = 283 * MiB;
DI int chain_id(int b, int h, int dir) { return (b * 4 + h) * 2 + dir; }
DI float logsig16(float z) { return (fminf(z, 0.f) - log1pf(expf(-fabsf(z)))) * (1.f / 16.f); }

DI void gates(const P& p, const bf16_t* QKV, size_t m0, int hh, int d, int seg, ALDS float* tot, float (&Bf)[8], float (&Bb)[8], float& totf, float& totb) {
    float wf[16], wb[16];
#pragma unroll
    for (int r = 0; r < 16; ++r) { wf[r] = p.in[11][r * 256 + hh * 64 + d]; wb[r] = p.in[13][r * 256 + hh * 64 + d]; }
    const float bf = p.in[12][hh * 64 + d], bb = p.in[14][hh * 64 + d];
    float lf[8], lb[8];
#pragma unroll
    for (int k = 0; k < 8; ++k) {
        const u32x4* zr = (const u32x4*)(QKV + (m0 + 8 * seg + k) * LD0 + C_ZF);
        float zf = bf, zb = bb;
#pragma unroll
        for (int c4 = 0; c4 < 2; ++c4) { const u32x4 a = zr[c4], b2 = zr[2 + c4];
#pragma unroll
            for (int j = 0; j < 4; ++j) { zf += __uint_as_float(a[j] << 16) * wf[c4 * 8 + 2 * j] + __uint_as_float(a[j] & 0xffff0000u) * wf[c4 * 8 + 2 * j + 1];
                zb += __uint_as_float(b2[j] << 16) * wb[c4 * 8 + 2 * j] + __uint_as_float(b2[j] & 0xffff0000u) * wb[c4 * 8 + 2 * j + 1]; } }
        lf[k] = logsig16(zf); lb[k] = logsig16(zb);
    }
    Bf[0] = lf[0];
#pragma unroll
    for (int k = 1; k < 8; ++k) Bf[k] = Bf[k - 1] + lf[k];
    Bb[7] = lb[7];
#pragma unroll
    for (int k = 6; k >= 0; --k) Bb[k] = Bb[k + 1] + lb[k];
    tot[seg * 64 + d] = Bf[7]; tot[(8 + seg) * 64 + d] = Bb[0];
    asm volatile("s_waitcnt lgkmcnt(0)" ::: "memory"); __builtin_amdgcn_s_barrier(); asm volatile("" ::: "memory");
    float offf = 0.f, offb = 0.f; totf = 0.f; totb = 0.f;
#pragma unroll
    for (int s2 = 0; s2 < 8; ++s2) { const float tf = tot[s2 * 64 + d], tb = tot[(8 + s2) * 64 + d]; totf += tf; totb += tb; if (s2 < seg) offf += tf; if (s2 > seg) offb += tb; }
#pragma unroll
    for (int k = 0; k < 8; ++k) { Bf[k] += offf; Bb[k] += offb; }
}
DI void token_chunk(int tc, int b, size_t& m0, int& cf, int& cb) {
    if (tc < 4) { m0 = (size_t)MX + b * 256 + tc * 64; cf = tc; cb = 3 - tc; } else { m0 = (size_t)b * 2048 + (tc - 4) * 64; cf = tc; cb = 39 - tc; }
}
DI void img_store(ALDS unsigned char* img, int row, int col, float v) { *(ALDS bf16_t*)(img + off_b(row, col >> 3) + 2 * (col & 7)) = f2bf(v); }
template <int NCC>
DI void make_tr(unsigned (&a)[NCC][2], int lane, int c_base) { att::make_vaddr<NCC>(a, lane, c_base); }
DI bf16x8 tr_frag(const ALDS unsigned char* img, const unsigned (&a)[2], int ks) { const s16x4 lo = vtr(img + a[0] + 4096 * ks), hi = vtr(img + a[1] + 4096 * ks); return (bf16x8){lo[0], lo[1], lo[2], lo[3], hi[0], hi[1], hi[2], hi[3]}; }

DI void phase_g1(const P& p, unsigned char* lds_generic) {
    ALDS unsigned char* lds = (ALDS unsigned char*)lds_generic;
    ALDS unsigned char* Vimg = lds; ALDS unsigned char* KDimg = lds + 16384; ALDS float* tot = (ALDS float*)(lds + 32768);
    const int tid = otid(), lane = tid & 63, wid = __builtin_amdgcn_readfirstlane(tid >> 6), d = lane, seg = wid, h = lane >> 5;
    const bf16_t* QKV = (const bf16_t*)(p.ws + WS_H); bf16_t* U = (bf16_t*)(p.ws + WS_U); float* GD = (float*)(p.ws + WS_GD);
    const int db = wid & 1, eb = wid >> 1;
    unsigned akd[2][2], av[1][2];
    for (int unit = blockIdx.x; unit < 1152; unit += gridDim.x) {
        const int tc = unit % 36, bh = unit / 36, b = bh >> 2, hh = bh & 3;
        size_t m0; int cf, cb; token_chunk(tc, b, m0, cf, cb);
        att::dma_image(Vimg, wid, lane, [&](int row) { return (const unsigned char*)(QKV + (m0 + row) * LD0 + C_GV + hh * 128); });
        float Bf[8], Bb[8], totf, totb;
        gates(p, QKV, m0, hh, d, seg, tot, Bf, Bb, totf, totb);
#pragma unroll
        for (int k = 0; k < 8; ++k) { const int i = 8 * seg + k; const float kv = bf2f(QKV[(m0 + i) * LD0 + C_GK + hh * 64 + d]);
            img_store(KDimg, i, d, kv * expf(totf - Bf[k])); img_store(KDimg, i, 64 + d, kv * expf(totb - Bb[k])); }
        if (seg == 0) GD[(size_t)(chain_id(b, hh, 0) * 36 + cf) * 64 + d] = expf(totf);
        if (seg == 1) GD[(size_t)(chain_id(b, hh, 1) * 36 + cb) * 64 + d] = expf(totb);
        ATT_WAIT_BAR();
        make_tr<2>(akd, lane, db); make_tr<1>(av, lane, eb);
        unsigned akb[1][2]; make_tr<1>(akb, lane, 2 + db);
        f32x16 accf, accb;
#pragma unroll
        for (int r = 0; r < 16; ++r) { accf[r] = 0.f; accb[r] = 0.f; }
#pragma unroll
        for (int ks = 0; ks < 4; ++ks) { const bf16x8 vf = tr_frag(Vimg, av[0], ks);
            accf = __builtin_amdgcn_mfma_f32_32x32x16_bf16(tr_frag(KDimg, akd[0], ks), vf, accf, 0, 0, 0);
            accb = __builtin_amdgcn_mfma_f32_32x32x16_bf16(tr_frag(KDimg, akb[0], ks), vf, accb, 0, 0, 0); }
        bf16_t* Uf = U + ((size_t)(chain_id(b, hh, 0) * 36 + cf) * 64) * 128; bf16_t* Ub = U + ((size_t)(chain_id(b, hh, 1) * 36 + cb) * 64) * 128;
#pragma unroll
        for (int r = 0; r < 16; ++r) { const int dd = 32 * db + 8 * (r >> 2) + 4 * h + (r & 3), e = 32 * eb + (lane & 31);
            Uf[dd * 128 + e] = f2bf(accf[r]); Ub[dd * 128 + e] = f2bf(accb[r]); }
        ATT_WAIT_BAR();
    }
}
DI void phase_g2(const P& p) {
    bf16_t* U = (bf16_t*)(p.ws + WS_U); const float* GD = (const float*)(p.ws + WS_GD);
    for (int item = blockIdx.x * NTHR + otid(); item < 65536; item += gridDim.x * NTHR) {
        const int chain = item >> 10, rem = item & 1023, d = rem >> 4, e8 = (rem & 15) * 8;
        float st[8];
#pragma unroll
        for (int j = 0; j < 8; ++j) st[j] = 0.f;
#pragma unroll 4
        for (int c = 0; c < 36; ++c) {
            u32x4* ptr = (u32x4*)(U + ((size_t)(chain * 36 + c) * 64 + d) * 128 + e8); const u32x4 raw = *ptr; const float dec = GD[(size_t)(chain * 36 + c) * 64 + d];
            u32x4 o; o.x = pk2(st[0], st[1]); o.y = pk2(st[2], st[3]); o.z = pk2(st[4], st[5]); o.w = pk2(st[6], st[7]); *ptr = o;
#pragma unroll
            for (int j = 0; j < 4; ++j) { st[2 * j] = dec * st[2 * j] + __uint_as_float(raw[j] << 16); st[2 * j + 1] = dec * st[2 * j + 1] + __uint_as_float(raw[j] & 0xffff0000u); }
        }
    }
}
DI void phase_g3(const P& p, unsigned char* lds_generic) {
    ALDS unsigned char* lds = (ALDS unsigned char*)lds_generic;
    ALDS unsigned char* Vimg = lds; ALDS unsigned char* Simg = lds + 16384  ; ALDS unsigned char* QKimg = lds + 49152  ;
    ALDS float* tot = (ALDS float*)(lds + 81920); ALDS float* ssb = (ALDS float*)(lds + 86016);
    const int tid = otid(), lane = tid & 63, wid = __builtin_amdgcn_readfirstlane(tid >> 6), d = lane, seg = wid, h = lane >> 5;
    const bf16_t* QKV = (const bf16_t*)(p.ws + WS_H); const bf16_t* U = (const bf16_t*)(p.ws + WS_U); bf16_t* A = (bf16_t*)(p.ws + WS_A);
    const int eb = wid & 3, tb = wid >> 2;
    unsigned kaddr[4], qaddr[4], atr[1][2];
    att::make_kaddr(kaddr, lane, 4);
#pragma unroll
    for (int d0 = 0; d0 < 4; ++d0) qaddr[d0] = off_b(lane & 31, 2 * d0 + h);
    make_tr<1>(atr, lane, eb);
    for (int unit = blockIdx.x; unit < 1152; unit += gridDim.x) {
        const int tc = unit % 36, bh = unit / 36, b = bh >> 2, hh = bh & 3;
        size_t m0; int cf, cb; token_chunk(tc, b, m0, cf, cb);
        att::dma_image(Vimg, wid, lane, [&](int row) { return (const unsigned char*)(QKV + (m0 + row) * LD0 + C_GV + hh * 128); });
        att::dma_image(Simg, wid, lane, [&](int row) { return (const unsigned char*)(U + ((size_t)(chain_id(b, hh, 0) * 36 + cf) * 64 + row) * 128); });
        att::dma_image(Simg + 16384, wid, lane, [&](int row) { return (const unsigned char*)(U + ((size_t)(chain_id(b, hh, 1) * 36 + cb) * 64 + row) * 128); });
        float Bf[8], Bb[8], totf, totb;
        gates(p, QKV, m0, hh, d, seg, tot, Bf, Bb, totf, totb);
#pragma unroll
        for (int k = 0; k < 8; ++k) { const int i = 8 * seg + k; const float qv = bf2f(QKV[(m0 + i) * LD0 + C_GQ + hh * 64 + d]) * 0.125f, kv = bf2f(QKV[(m0 + i) * LD0 + C_GK + hh * 64 + d]);
            img_store(QKimg, i, d, qv * expf(Bf[k])); img_store(QKimg, i, 64 + d, kv * expf(-Bf[k]));
            img_store(QKimg + 16384, i, d, qv * expf(Bb[k])); img_store(QKimg + 16384, i, 64 + d, kv * expf(-Bb[k])); }
        ATT_WAIT_BAR();
        f32x16 acc;
#pragma unroll
        for (int r = 0; r < 16; ++r) acc[r] = 0.f;
        const int tq = 32 * tb + (lane & 31);
#pragma unroll
        for (int dir = 0; dir < 2; ++dir) {
            const ALDS unsigned char* QK = QKimg + 16384 * dir; const ALDS unsigned char* SI = Simg + 16384 * dir;
            bf16x8 qf[4];
#pragma unroll
            for (int d0 = 0; d0 < 4; ++d0) qf[d0] = *(const ALDS bf16x8*)(QK + qaddr[d0] + 8192 * tb);
#pragma unroll
            for (int sb = 0; sb < 2; ++sb) {
                if ((dir == 0 && sb > tb) || (dir == 1 && sb < tb)) continue;
                f32x16 S;
#pragma unroll
                for (int r = 0; r < 16; ++r) S[r] = 0.f;
#pragma unroll
                for (int d0 = 0; d0 < 4; ++d0) { const bf16x8 kf = *(const ALDS bf16x8*)(QK + kaddr[d0] + 8192 * sb); S = __builtin_amdgcn_mfma_f32_32x32x16_bf16(kf, qf[d0], S, 0, 0, 0); }
#pragma unroll
                for (int r = 0; r < 16; ++r) { const int sk = 32 * sb + 16 * (r >> 3) + 8 * h + (r & 7); const bool keep = dir == 0 ? (sk <= tq) : (sk > tq); S[r] = keep ? S[r] : 0.f; }
#pragma unroll
                for (int ks2 = 0; ks2 < 2; ++ks2) {
                    u32x4 pw; pw.x = cvtpk(S[8 * ks2], S[8 * ks2 + 1]); pw.y = cvtpk(S[8 * ks2 + 2], S[8 * ks2 + 3]); pw.z = cvtpk(S[8 * ks2 + 4], S[8 * ks2 + 5]); pw.w = cvtpk(S[8 * ks2 + 6], S[8 * ks2 + 7]);
                    acc = __builtin_amdgcn_mfma_f32_32x32x16_bf16(tr_frag(Vimg, atr[0], 2 * sb + ks2), __builtin_bit_cast(bf16x8, pw), acc, 0, 0, 0); }
            }
#pragma unroll
            for (int ks = 0; ks < 4; ++ks) acc = __builtin_amdgcn_mfma_f32_32x32x16_bf16(tr_frag(SI, atr[0], ks), qf[ks], acc, 0, 0, 0);
        }
        float ss = 0.f;
#pragma unroll
        for (int r = 0; r < 16; ++r) ss += acc[r] * acc[r];
        ss += half_swap(ss);
        if (h == 0) ssb[eb * 64 + tq] = ss;
        ATT_WAIT_BAR();
        const float tots = ssb[tq] + ssb[64 + tq] + ssb[128 + tq] + ssb[192 + tq];
        const float rms = 1.0f / sqrtf(tots * (1.f / 128.f) + LN_EPS);
        const size_t m = m0 + tq;
#pragma unroll
        for (int r4 = 0; r4 < 4; ++r4) { const int e0 = 32 * eb + 8 * r4 + 4 * h;
            const f32x4 ng = *(const f32x4*)(p.in[15] + e0); const u32x2 gr = *(const u32x2*)(QKV + m * LD0 + C_GR + hh * 128 + e0);
            const float g0 = __uint_as_float(gr.x << 16), g1 = __uint_as_float(gr.x & 0xffff0000u), g2 = __uint_as_float(gr.y << 16), g3 = __uint_as_float(gr.y & 0xffff0000u);
            u32x2 w; w.x = cvtpk(acc[4 * r4] * rms * ng[0] * silu_f(g0), acc[4 * r4 + 1] * rms * ng[1] * silu_f(g1)); w.y = cvtpk(acc[4 * r4 + 2] * rms * ng[2] * silu_f(g2), acc[4 * r4 + 3] * rms * ng[3] * silu_f(g3));
            *(u32x2*)(A + m * DM + 512 + hh * 128 + e0) = w; }
        ATT_WAIT_BAR();
    }
}
#undef ALDS
}


#define LAS __attribute__((address_space(3)))
#define XB_TMO      128
#define XB_XCNT(j)  (256  + 64 * (j))
#define XB_XSUB(j)  (1280 + 64 * (j))
#define XB_XGEN(j)  (2304 + 64 * (j))
#define XB_TOP      3328
#define XB_TOPGEN   3392
#define XCD_BAR_WORDS 3456
#define XB_SPIN_CAP (1u << 18)

__device__ __forceinline__ unsigned xb_ld(unsigned* p)              { return __hip_atomic_load(p, __ATOMIC_RELAXED, __HIP_MEMORY_SCOPE_AGENT); }
__device__ __forceinline__ unsigned xb_add(unsigned* p, unsigned v) { return __hip_atomic_fetch_add(p, v, __ATOMIC_RELAXED, __HIP_MEMORY_SCOPE_AGENT); }
__device__ __forceinline__ unsigned xb_xcc_id() { return (unsigned)__builtin_amdgcn_s_getreg((3 << 11) | 20) & 0xFu; }
#define XB_SPIN(cond, bar) do { unsigned _sp = 0; while (cond) { __builtin_amdgcn_s_sleep(1); \
    if ((++_sp & 255u) == 0u) { if (xb_ld(&(bar)[XB_TMO])) break; if (_sp > XB_SPIN_CAP) { atomicAdd(&(bar)[XB_TMO], 1u); break; } } } } while (0)

struct XcdBarrier {
    unsigned* bar; unsigned x;
    volatile LAS unsigned* st;
};

__device__ __forceinline__ XcdBarrier xcd_barrier_post(unsigned* bar, volatile LAS unsigned* st) {
    XcdBarrier b; b.bar = bar; b.x = xb_xcc_id(); b.st = st;
    if (threadIdx.x == 0) (void)xb_add(&bar[XB_XCNT(b.x)], 1u);
    return b;
}
__device__ __forceinline__ void xcd_barrier_complete(unsigned* bar, unsigned x, unsigned& nloc, unsigned& nx) {
    const unsigned G = gridDim.x * gridDim.y * gridDim.z;
    unsigned sum, cnt, mine, sp = 0u;
    for (;;) {
        sum = 0u; cnt = 0u; mine = 0u;
#pragma unroll
        for (unsigned j = 0; j < 16; ++j) { const unsigned c = xb_ld(&bar[XB_XCNT(j)]); sum += c; cnt += (c > 0u) ? 1u : 0u; mine = (j == x) ? c : mine; }
        if (sum == G) break;
        __builtin_amdgcn_s_sleep(1);
        if ((++sp & 255u) == 0u) { if (xb_ld(&bar[XB_TMO])) break; if (sp > XB_SPIN_CAP) { atomicAdd(&bar[XB_TMO], 1u); break; } }
    }
    nloc = mine > 0u ? mine : 1u; nx = cnt > 0u ? cnt : 1u;
}

__device__ __forceinline__ void xcd_barrier(const XcdBarrier& b) {
    asm volatile("s_waitcnt vmcnt(0)" ::: "memory");
    __syncthreads();
    if (threadIdx.x == 0) {
        unsigned* bar = b.bar;
        __builtin_amdgcn_s_waitcnt(0);
        unsigned nloc = b.st[0], nx = b.st[1];
        if (nloc == 0u) { xcd_barrier_complete(bar, b.x, nloc, nx); b.st[0] = nloc; b.st[1] = nx; }
        const unsigned old = xb_add(&bar[XB_XSUB(b.x)], 1u);
        const unsigned gen = old / nloc;
        if (old + 1u == (gen + 1u) * nloc) {
            __builtin_amdgcn_fence(__ATOMIC_RELEASE, "agent");
            asm volatile("s_waitcnt vmcnt(0)" ::: "memory");
            const unsigned og = xb_add(&bar[XB_TOP], 1u);
            const unsigned tg = og / nx;
            if (og + 1u == (tg + 1u) * nx) xb_add(&bar[XB_TOPGEN], 1u);
            else XB_SPIN(xb_ld(&bar[XB_TOPGEN]) == tg, bar);
            __builtin_amdgcn_fence(__ATOMIC_ACQUIRE, "agent");
            xb_add(&bar[XB_XGEN(b.x)], 1u);
            asm volatile("s_waitcnt vmcnt(0)" ::: "memory");
        } else {
            XB_SPIN(xb_ld(&bar[XB_XGEN(b.x)]) == gen, bar);
            __builtin_amdgcn_fence(__ATOMIC_ACQUIRE, "agent");
            asm volatile("s_waitcnt vmcnt(0)" ::: "memory");
        }
    }
    __syncthreads();
}

__global__ void __launch_bounds__(NTHR) mk_fwd(P p) {
    extern __shared__ __attribute__((aligned(16))) unsigned char lds_raw[];
    float* lds = (float*)lds_raw;
    cg::grid_group grid = cg::this_grid();
    volatile LAS unsigned* bst = (volatile LAS unsigned*)((LAS unsigned char*)lds_raw + 139264);
    if (threadIdx.x < 4) bst[threadIdx.x] = 0u;
    __syncthreads();
    const XcdBarrier xbar = xcd_barrier_post((unsigned*)(p.ws + WS_CTL), bst);
    int ph = 0;
#define RUN(...) do { if (ph >= p.ph_lo && ph < p.ph_hi) { __VA_ARGS__; if (ph + 1 < p.ph_hi) { for (int rs_ = 0; rs_ < REP_SYNC; ++rs_) { if (ph == 0) grid.sync(); else xcd_barrier(xbar); } } } ++ph; } while (0)
#define REPEAT(n, ...) do { for (int rp_ = 0; rp_ < (n); ++rp_) { __VA_ARGS__; } } while (0)
    bf16_t* A = (bf16_t*)(p.ws + WS_A); bf16_t* H = (bf16_t*)(p.ws + WS_H);

    RUN(REPEAT(REP_PRO, phase_adaln(p, lds); phase_rope_table(p); phase_convert(p, lds); __syncthreads()));
    RUN(REPEAT(REP_ROW, phase_rowpass(p, false, 0, false, true, 0, 0, 1, MT)));
    __attribute__((address_space(3))) unsigned char* glds = (__attribute__((address_space(3))) unsigned char*)lds_raw;
    float* XH = (float*)(p.ws + WS_XH); const float* ROPE = (const float*)(p.ws + WS_ROPE);
    const int G = (int)gridDim.x, cid = (int)blockIdx.x;
#define GEMM_SWIGLU(Aop, Wt, Mrows) do { pg8::Gemm g{Aop, Wt, Mrows, 2 * DFF, DM}; pg8::StaticOrder S; S.init(Mrows, 2 * DFF, G, cid); pg8::EpiSwigluF E{H, DFF}; \
        pg8::gemm_phase<pg8::EpiSwigluF, pg8::StaticOrder, true, true>(glds, g, S, E); } while (0)
#define GEMM_STORE(Aop, Wt, Mrows, N, ropet) do { pg8::Gemm g{Aop, Wt, Mrows, N, DM}; pg8::StaticOrder S; S.init(Mrows, N, G, cid); pg8::EpiStoreF E{H, N, ROPE, ropet, MX}; \
        pg8::gemm_phase<pg8::EpiStoreF, pg8::StaticOrder, true, true>(glds, g, S, E); } while (0)
#define GEMM_RESID(Aop, Wt, Mrows, K, xi, hi, chunk, sc) do { pg8::Gemm g{Aop, Wt, Mrows, DM, K}; pg8::StaticOrder S; S.init(Mrows, DM, G, cid); \
        pg8::EpiResidF E{xi, hi, p.out, XH, mod_ptr(p, l, 0, chunk), mod_ptr(p, l, 8, chunk), sc, ALPHA}; \
        pg8::gemm_phase<pg8::EpiResidF, pg8::StaticOrder, true, true>(glds, g, S, E); } while (0)
#pragma unroll 1
    for (int l = 0; l < 2; ++l) {
        RUN(REPEAT(REP_SWI, GEMM_SWIGLU(A, wt_ptr(p, l, WT_F1I), MT)));
        RUN(GEMM_RESID(H, wt_ptr(p, l, WT_F1O), MT, DFF, (l == 0 ? p.in[0] : (const float*)p.out), (l == 0 ? p.in[2] : (const float*)XH), 2, 0.5f));
        RUN(REPEAT(REP_ROW, phase_rowpass(p, true, 1, true, true, l, 3, 4, MT)));
        if (l == 0) {
            RUN(REPEAT(REP_STORE, GEMM_STORE(A, wt_ptr(p, l, WT_MI), MT, LD0, 0)));
            RUN({ REPEAT(REP_G1, gla::phase_g1(p, lds_raw)); REPEAT(REP_NA, att::phase_na(p, lds_raw)); });
            RUN(gla::phase_g2(p));
            RUN(REPEAT(REP_G3, gla::phase_g3(p, lds_raw)));
        } else {
            RUN(REPEAT(REP_STORE, GEMM_STORE(A, wt_ptr(p, l, WT_MI), MT, LD1, 8)));
            RUN(REPEAT(REP_DIFF, att::phase_diff(p, lds_raw)));
        }
        const int Mrows = l == 0 ? MT : MX;
        RUN(GEMM_RESID(A, wt_ptr(p, l, WT_MO), Mrows, DM, (const float*)p.out, (const float*)XH, 5, 1.0f));
        RUN(REPEAT(REP_ROW, phase_rowpass(p, true, 1, true, true, l, 6, 7, Mrows)));
        RUN(REPEAT(REP_SWI, GEMM_SWIGLU(A, wt_ptr(p, l, WT_F2I), Mrows)));
        RUN(GEMM_RESID(H, wt_ptr(p, l, WT_F2O), Mrows, DFF, (const float*)p.out, (const float*)XH, 8, 0.5f));
        RUN(REPEAT(REP_ROW, phase_rowpass(p, true, 1, true, l == 0, 1, 0, 1, Mrows)));
    }
#undef RUN
}

extern "C" void kernel_launch(void* const* d_in, const int* in_sizes, int n_in, void* d_out, int out_size, void* d_ws, size_t ws_size, hipStream_t stream) {
    static int grid = 0;
    if (grid == 0) {
        if (n_in != 31 || out_size != MX * DM || ws_size < WS_END) { fprintf(stderr, "kernel_launch: unexpected shapes (n_in %d out %d ws %zu)\n", n_in, out_size, ws_size); grid = -1; return; }
        int dev = 0, cus = 0, per_cu = 0;
        hipGetDevice(&dev); hipDeviceGetAttribute(&cus, hipDeviceAttributeMultiprocessorCount, dev);
        hipFuncSetAttribute((const void*)mk_fwd, hipFuncAttributeMaxDynamicSharedMemorySize, LDS_BYTES);
        hipOccupancyMaxActiveBlocksPerMultiprocessor(&per_cu, (const void*)mk_fwd, NTHR, LDS_BYTES);
        if (per_cu < 1) { fprintf(stderr, "kernel_launch: occupancy query says %d blocks per CU\n", per_cu); grid = -1; return; }
        grid = cus;
    }
    if (grid < 0) return;
    if (hipMemsetAsync((char*)d_ws + WS_CTL, 0, CTL_BYTES, stream) != hipSuccess) { fprintf(stderr, "memset failed\n"); return; }
    P p{};
    for (int i = 0; i < 31; ++i) p.in[i] = (const float*)d_in[i];
    p.out = (float*)d_out; p.ws = (unsigned char*)d_ws; p.ph_lo = 0; p.ph_hi = 1000;
    void* args[] = {&p};
    hipError_t e = hipLaunchCooperativeKernel((const void*)mk_fwd, dim3(grid), dim3(NTHR), args, LDS_BYTES, stream);
    if (e != hipSuccess) fprintf(stderr, "cooperative launch failed: %s (grid %d)\n", hipGetErrorString(e), grid);
}
```

```cpp
#include <hip/hip_runtime.h>
#include <hip/hip_cooperative_groups.h>
#include <cstdio>
#include <cstdint>
namespace cg = cooperative_groups;

typedef unsigned short bf16_t;
typedef float f32x4 __attribute__((ext_vector_type(4)));
typedef unsigned u32x4 __attribute__((ext_vector_type(4)));
typedef unsigned u32x2 __attribute__((ext_vector_type(2)));
#define DI __device__ __forceinline__

constexpr int NB = 8, SEQ = 2048, CTXL = 256, DM = 1024, DFF = 2816;
constexpr int MX = NB * SEQ, MH = NB * CTXL, MT = MX + MH;
constexpr float ALPHA = 1.41421356237309515f;
constexpr float LN_EPS = 1e-6f;
constexpr float LAMBDA_INIT = 0.35550906759f;
constexpr int NTHR = 512;

constexpr int LD0 = 3328, C_NQ = 0, C_NK = 512, C_NV = 1024, C_GQ = 1536, C_GK = 1792, C_GV = 2048, C_GR = 2560, C_ZF = 3072, C_ZB = 3088;
constexpr int LD1 = 3072;

constexpr size_t MiB = 1u << 20;
constexpr size_t WS_MOD = 0;
constexpr size_t WS_ROPE = 1 * MiB;
constexpr size_t WS_XH = 2 * MiB;
constexpr size_t WS_WT = 10 * MiB;
constexpr size_t WT_LAYER = 42 * MiB;
constexpr size_t WT_F1I = 0, WT_F1O = 11 * MiB, WT_MI = 16 * MiB + MiB / 2, WT_MO = 23 * MiB, WT_F2I = 25 * MiB, WT_F2O = 36 * MiB;
constexpr size_t WS_A = 94 * MiB;
constexpr size_t WS_H = 130 * MiB;
constexpr size_t WS_OF = 247 * MiB;
constexpr size_t WS_OB = 265 * MiB;
constexpr size_t WS_CTL = 284 * MiB;
constexpr size_t CTL_BYTES = 16384;
constexpr size_t WS_END = 285 * MiB;

constexpr int REP_ROW = 1, REP_SWI = 1, REP_STORE = 1, REP_DIFF = 1, REP_NA = 1, REP_G1 = 1, REP_G3 = 1, REP_PRO = 1, REP_SYNC = 1, REP_RES = 1, REP_G2 = 1;
constexpr int LDS_BYTES = 147456;

struct P { const float* in[31]; float* out; unsigned char* ws; int ph_lo, ph_hi; };

DI float bf2f(bf16_t h) { return __uint_as_float(((unsigned)h) << 16); }
DI bf16_t f2bf(float f) { unsigned u = __float_as_uint(f); return (bf16_t)((u + 0x7fffu + ((u >> 16) & 1u)) >> 16); }
DI unsigned pk2(float lo, float hi) { return (unsigned)f2bf(lo) | ((unsigned)f2bf(hi) << 16); }
DI float silu_f(float v) { return v / (1.f + expf(-v)); }
DI float wave_sum(float v) {
#pragma unroll
    for (int o = 1; o < 64; o <<= 1) v += __shfl_xor(v, o);
    return v;
}
DI int otid() { int t = threadIdx.x; asm volatile("" : "+v"(t)); return t; }
DI float* xres_ptr(const P& p, int m) { return m < MX ? p.out + (size_t)m * DM : (float*)(p.ws + WS_XH) + (size_t)(m - MX) * DM; }
DI const float* xin_ptr(const P& p, int m) { return m < MX ? p.in[0] + (size_t)m * DM : p.in[2] + (size_t)(m - MX) * DM; }
DI int modrow(int m) { return m < MX ? (m >> 11) : 8; }
DI const float* mod_ptr(const P& p, int l, int r, int chunk) { return (const float*)(p.ws + WS_MOD) + ((size_t)(l * 9 + r) * 9 + chunk) * DM; }
DI bf16_t* wt_ptr(const P& p, int l, size_t off) { return (bf16_t*)(p.ws + WS_WT + (size_t)l * WT_LAYER + off); }

DI void phase_adaln(const P& p, float* lds) {
    float* sc = lds; float* red = lds + 9 * 1024;
    const int tid = otid(), lane = tid & 63, w = tid >> 6;
    for (int i = tid; i < 9 * 1024; i += NTHR) { const int r = i >> 10, k = i & 1023; const float v = r < 8 ? p.in[1][r * 1024 + k] : p.in[3][k]; sc[i] = silu_f(v); }
    __syncthreads();
    for (int item = blockIdx.x; item < 288; item += gridDim.x) {
        const int l = item / 144, cb = item % 144, n = cb * 64 + lane;
        const float* W = p.in[l ? 18 : 4]; const float* bb = p.in[l ? 19 : 5];
        float acc[9];
#pragma unroll
        for (int r = 0; r < 9; ++r) acc[r] = 0.f;
#pragma unroll 4
        for (int k = w * 128; k < w * 128 + 128; ++k) { const float wv = W[(size_t)k * 9216 + n];
#pragma unroll
            for (int r = 0; r < 9; ++r) acc[r] += sc[r * 1024 + k] * wv; }
#pragma unroll
        for (int r = 0; r < 9; ++r) red[(w * 9 + r) * 64 + lane] = acc[r];
        __syncthreads();
        float* MOD = (float*)(p.ws + WS_MOD);
        for (int o = tid; o < 576; o += NTHR) { const int r = o >> 6, c = o & 63; float s = bb[cb * 64 + c];
#pragma unroll
            for (int w2 = 0; w2 < 8; ++w2) s += red[(w2 * 9 + r) * 64 + c];
            MOD[(size_t)(l * 9 + r) * 9216 + cb * 64 + c] = s; }
        __syncthreads();
    }
}
DI void phase_rope_table(const P& p) {
    float* T = (float*)(p.ws + WS_ROPE);
    for (int idx = blockIdx.x * NTHR + otid(); idx < 2048 * 32; idx += gridDim.x * NTHR) {
        const int t = idx >> 5, j = idx & 31, fi = j & 15; const float pos = (float)(j < 16 ? (t >> 6) : (t & 63));
        const float inv = powf(10000.f, -(float)(2 * fi) / 32.f); const float ang = pos * inv;
        T[idx * 2] = cosf(ang); T[idx * 2 + 1] = sinf(ang);
    }
}
DI void conv_item(const float* W, int K, int Nsrc, int src0, bf16_t* WT, int n0dst, int k0, float* scr, int lane) {
    if (src0 >= 0) {
#pragma unroll 8
        for (int i = 0; i < 32; ++i) { const int kk = 2 * i + (lane >> 5); scr[kk * 33 + (lane & 31)] = W[(size_t)(k0 + kk) * Nsrc + src0 + (lane & 31)]; }
    } else {
#pragma unroll 8
        for (int i = 0; i < 32; ++i) { const int kk = 2 * i + (lane >> 5); scr[kk * 33 + (lane & 31)] = 0.f; }
    }
    asm volatile("s_waitcnt lgkmcnt(0)" ::: "memory");
    const int c = lane & 7;
#pragma unroll
    for (int j = 0; j < 4; ++j) { const int n = (lane >> 3) + 8 * j; const float* s = scr + (8 * c) * 33 + n;
        u32x4 o; o.x = pk2(s[0 * 33], s[1 * 33]); o.y = pk2(s[2 * 33], s[3 * 33]); o.z = pk2(s[4 * 33], s[5 * 33]); o.w = pk2(s[6 * 33], s[7 * 33]);
        *(u32x4*)(WT + (size_t)(n0dst + n) * K + k0 + 8 * c) = o; }
    asm volatile("s_waitcnt lgkmcnt(0)" ::: "memory");
}
DI void conv_matrix_item(const float* W, int K, int Nsrc, int Ndst, int kind, bf16_t* WT, int item, float* scr, int lane) {
    const int nblk = Ndst / 32, kb = item / nblk, nb = item % nblk, n0 = nb * 32;
    int src0;
    if (kind == 1) { const int t = n0 >> 8, j = n0 & 255; src0 = j < 128 ? 128 * t + j : DFF + 128 * t + (j - 128); }
    else src0 = n0 < Nsrc ? n0 : -1;
    conv_item(W, K, Nsrc, src0, WT, n0, kb * 64, scr, lane);
}
DI void phase_convert(const P& p, float* lds) {
    const int tid = otid(), lane = tid & 63, w = tid >> 6;
    float* scr = lds + w * (64 * 33 + 16);
    const int gw = blockIdx.x * 8 + w, NGW = gridDim.x * 8;
    for (int l = 0; l < 2; ++l) {
        const int b = l ? 18 : 4;
        const int nmi = l ? 3072 : 3104, nmid = l ? 3072 : 3328;
        const int i0 = 16 * 176, i1 = 44 * 32, i2 = 16 * (nmid / 32), i3 = 16 * 32;
        const int total = i0 + i1 + i2 + i3 + i0 + i1;
        for (int it = gw; it < total; it += NGW) {
            int r = it;
            if (r < i0) { conv_matrix_item(p.in[b + 2], 1024, 5632, 5632, 1, wt_ptr(p, l, WT_F1I), r, scr, lane); continue; } r -= i0;
            if (r < i1) { conv_matrix_item(p.in[b + 3], 2816, 1024, 1024, 0, wt_ptr(p, l, WT_F1O), r, scr, lane); continue; } r -= i1;
            if (r < i2) { conv_matrix_item(p.in[b + 4], 1024, nmi, nmid, 0, wt_ptr(p, l, WT_MI), r, scr, lane); continue; } r -= i2;
            if (r < i3) { conv_matrix_item(p.in[b + 5], 1024, 1024, 1024, 0, wt_ptr(p, l, WT_MO), r, scr, lane); continue; } r -= i3;
            const int f2 = l ? 29 : 16;
            if (r < i0) { conv_matrix_item(p.in[f2], 1024, 5632, 5632, 1, wt_ptr(p, l, WT_F2I), r, scr, lane); continue; } r -= i0;
            conv_matrix_item(p.in[f2 + 1], 2816, 1024, 1024, 0, wt_ptr(p, l, WT_F2O), r, scr, lane);
        }
    }
}

DI void phase_rowpass(const P& p, bool do_ln, int src_mode, bool write_x, bool write_a, int l_mod, int ch_shift, int ch_scale, int M, int hp_chunk = -1, float hp_scale = 0.f, int hp_l = 0, bool hp_src0 = false) {
    const int tid = otid(), lane = tid & 63, w = tid >> 6;
    const int gw = blockIdx.x * 8 + w, NGW = gridDim.x * 8;
    bf16_t* A = (bf16_t*)(p.ws + WS_A);
    for (int m = gw; m < M; m += NGW) {
        const f32x4* src = (const f32x4*)(src_mode == 0 ? xin_ptr(p, m) : (const float*)xres_ptr(p, m)) + lane;
        f32x4 v[4]; float s = 0.f;
        if (m >= MX && hp_chunk >= 0) {
            const f32x4* r = (const f32x4*)(hp_src0 ? p.in[2] + (size_t)(m - MX) * DM : (const float*)(p.ws + WS_XH) + (size_t)(m - MX) * DM) + lane;
            const f32x4* gp = (const f32x4*)mod_ptr(p, hp_l, 8, hp_chunk) + lane; const f32x4* pp = (const f32x4*)((const float*)(p.ws + WS_OF) + (size_t)(m - MX) * DM) + lane;
#pragma unroll
            for (int j = 0; j < 4; ++j) { const f32x4 ps = (pp[64 * j] + pp[64 * j + 524288]) + (pp[64 * j + 2 * 524288] + pp[64 * j + 3 * 524288]);
                v[j] = r[64 * j] * ALPHA + gp[64 * j] * hp_scale * ps; s += (v[j].x + v[j].y) + (v[j].z + v[j].w); }
        } else {
#pragma unroll
        for (int j = 0; j < 4; ++j) { v[j] = src[64 * j]; s += (v[j].x + v[j].y) + (v[j].z + v[j].w); }
        }
        if (do_ln) {
            const float mean = wave_sum(s) * (1.f / DM); float s2 = 0.f;
#pragma unroll
            for (int j = 0; j < 4; ++j) { v[j] = v[j] - mean; s2 += (v[j].x * v[j].x + v[j].y * v[j].y) + (v[j].z * v[j].z + v[j].w * v[j].w); }
            const float rstd = 1.0f / sqrtf(wave_sum(s2) * (1.f / DM) + LN_EPS);
#pragma unroll
            for (int j = 0; j < 4; ++j) v[j] = v[j] * rstd;
        }
        if (write_x) { f32x4* dst = (f32x4*)xres_ptr(p, m) + lane;
#pragma unroll
            for (int j = 0; j < 4; ++j) dst[64 * j] = v[j]; }
        if (write_a) {
            const f32x4* sh = (const f32x4*)mod_ptr(p, l_mod, modrow(m), ch_shift) + lane; const f32x4* scp = (const f32x4*)mod_ptr(p, l_mod, modrow(m), ch_scale) + lane;
            u32x2* o8 = (u32x2*)(A + (size_t)m * DM) + lane;
#pragma unroll
            for (int j = 0; j < 4; ++j) { const f32x4 a = v[j] * (scp[64 * j] + 1.0f) + sh[64 * j]; u32x2 o; o.x = pk2(a.x, a.y); o.y = pk2(a.z, a.w); o8[64 * j] = o; }
        }
    }
}

template <class Epi>
DI void naive_gemm(const bf16_t* A, const bf16_t* Wt, int M, int N, int K, const Epi& epi, float* lds) {
    float* sA = lds; float* sB = lds + 32 * 132;
    const int tid = otid(), tx = tid & 31, ty = tid >> 5;
    const int ntn = N / 256, ntm = M / 128, ntiles = ntm * ntn;
    for (int tile = blockIdx.x; tile < ntiles; tile += gridDim.x) {
        const int tn = tile % ntn, tm = tile / ntn, m0 = tm * 128, n0 = tn * 256;
        float acc[8][8];
#pragma unroll
        for (int i = 0; i < 8; ++i)
#pragma unroll
            for (int j = 0; j < 8; ++j) acc[i][j] = 0.f;
        for (int k0 = 0; k0 < K; k0 += 32) {
            const int row = tid >> 2, kc = (tid & 3) * 8;
            { const u32x4 raw = *(const u32x4*)(A + (size_t)(m0 + row) * K + k0 + kc);
#pragma unroll
              for (int j = 0; j < 4; ++j) { sA[(kc + 2 * j) * 132 + row] = __uint_as_float(raw[j] << 16); sA[(kc + 2 * j + 1) * 132 + row] = __uint_as_float(raw[j] & 0xffff0000u); } }
#pragma unroll
            for (int h = 0; h < 2; ++h) { const int rb = row + 128 * h; const u32x4 raw = *(const u32x4*)(Wt + (size_t)(n0 + rb) * K + k0 + kc);
#pragma unroll
              for (int j = 0; j < 4; ++j) { sB[(kc + 2 * j) * 264 + rb] = __uint_as_float(raw[j] << 16); sB[(kc + 2 * j + 1) * 264 + rb] = __uint_as_float(raw[j] & 0xffff0000u); } }
            __syncthreads();
#pragma unroll 4
            for (int kk = 0; kk < 32; ++kk) {
                const f32x4 a0 = *(const f32x4*)&sA[kk * 132 + ty * 8], a1 = *(const f32x4*)&sA[kk * 132 + ty * 8 + 4];
                const f32x4 b0 = *(const f32x4*)&sB[kk * 264 + tx * 4], b1 = *(const f32x4*)&sB[kk * 264 + 128 + tx * 4];
                const float a[8] = {a0.x, a0.y, a0.z, a0.w, a1.x, a1.y, a1.z, a1.w}; const float b[8] = {b0.x, b0.y, b0.z, b0.w, b1.x, b1.y, b1.z, b1.w};
#pragma unroll
                for (int i = 0; i < 8; ++i)
#pragma unroll
                    for (int j = 0; j < 8; ++j) acc[i][j] += a[i] * b[j];
            }
            __syncthreads();
        }
#pragma unroll
        for (int i = 0; i < 8; ++i)
#pragma unroll
            for (int j = 0; j < 4; ++j) epi.pair(m0 + ty * 8 + i, tn, tx * 4 + j, acc[i][j], acc[i][4 + j]);
    }
}
struct EpiSwiglu { bf16_t* H; DI void pair(int m, int t, int c, float va, float vg) const { H[(size_t)m * DFF + t * 128 + c] = f2bf(silu_f(va) * vg); } };
struct EpiStore { bf16_t* O; int ld; DI void pair(int m, int t, int c, float va, float vg) const { O[(size_t)m * ld + t * 256 + c] = f2bf(va); O[(size_t)m * ld + t * 256 + 128 + c] = f2bf(vg); } };
struct EpiResid { const P* p; int src_mode, l, chunk; float scale;
    DI void one(int m, int n, float v) const { const float* res = src_mode ? (const float*)xres_ptr(*p, m) : xin_ptr(*p, m); const float g = mod_ptr(*p, l, modrow(m), chunk)[n]; xres_ptr(*p, m)[n] = ALPHA * res[n] + g * scale * v; }
    DI void pair(int m, int t, int c, float va, float vg) const { one(m, t * 256 + c, va); one(m, t * 256 + 128 + c, vg); } };

namespace pg8 {
#define PG8_LAS __attribute__((address_space(3)))
typedef unsigned short bf16_t;
typedef short bf16x8 __attribute__((ext_vector_type(8)));
typedef float f32x4 __attribute__((ext_vector_type(4)));
typedef unsigned u32x4 __attribute__((ext_vector_type(4)));
constexpr int BM = 256, BK = 64, HALF = 128, HTB = HALF * BK * 2  , STAGE_BYTES = 8 * HTB, NXCD = 8, WGM = 8;

__host__ __device__ __forceinline__ int lds_byte(int r, int c) { const int st = (r >> 4) * 2 + (c >> 5), rr = r & 15, cc = c & 31, ob = rr * 64 + cc * 2; return st * 1024 + (ob ^ (((ob >> 9) & 1) << 5)); }
__host__ __device__ __forceinline__ void stage_rc(int b, int& R, int& C) { const int st = b / 1024, sb = b % 1024, swz = sb ^ (((sb >> 9) & 1) << 5); R = (st >> 1) * 16 + swz / 64; C = (st & 1) * 32 + (swz % 64) / 2; }
__host__ __device__ __forceinline__ int perm32(int rho) { const int n = rho >> 4, i = rho & 15; return 8 * (i >> 2) + 4 * n + (i & 3); }

struct Unit { int pm, pn, kofs, nt, aux; };
struct Gemm { const bf16_t* A; const bf16_t* Bt; int M, N, K; };

struct StaticOrder {
    int nM, nN, nwg, G, c, ntk;
    __host__ __device__ void init(int M, int N, int G_, int c_, int K) { nM = M / BM; nN = N / BM; nwg = nM * nN; G = G_; c = c_; ntk = K / BK; }
    __host__ __device__ bool next(int i, Unit& u) const {
        const long L = (long)i * G + c; if (L >= nwg) return false;
        int wgid = (int)L; { const int q = nwg / NXCD, r = nwg % NXCD, xcd = wgid % NXCD, off = wgid / NXCD; wgid = (xcd < r ? xcd * (q + 1) : r * (q + 1) + (xcd - r) * q) + off; }
        const int nig = WGM * nN, gid = wgid / nig, fm = gid * WGM, gsz = (nM - fm) < WGM ? (nM - fm) : WGM;
        u.pm = fm + ((wgid % nig) % gsz); u.pn = (wgid % nig) / gsz; u.kofs = 0; u.nt = ntk; u.aux = 0; return true;
    }
    __device__ __forceinline__ void a_ready(const Unit&) const {}
    __device__ __forceinline__ void done(const Unit&) const {}
};

__device__ __forceinline__ unsigned cvt_pk_bf16(float lo, float hi) { unsigned r; asm volatile("v_cvt_pk_bf16_f32 %0, %1, %2" : "=v"(r) : "v"(lo), "v"(hi)); return r; }
__device__ __forceinline__ float fast_silu(float a) { return a * __builtin_amdgcn_rcpf(1.0f + __builtin_amdgcn_exp2f(-1.4426950408889634f * a)); }
struct EpiSwigluF {
    static constexpr bool PERM = true, AFTER_DRAIN = false;
    bf16_t* H; int ldh;
    __device__ __forceinline__ void operator()(const f32x4 (&acc)[2][2][4][2], const Unit& u, int wr, int wc, int fr, int fq) const {
        const int row0 = u.pm * BM + wr * 64 + fr, col0 = u.pn * HALF + wc * 32 + 8 * fq;
#pragma unroll
        for (int ai = 0; ai < 2; ++ai)
#pragma unroll
            for (int m = 0; m < 4; ++m) { bf16_t* rowp = H + (size_t)(row0 + ai * HALF + m * 16) * ldh + col0;
                const f32x4 a0 = acc[ai][0][m][0], a1 = acc[ai][0][m][1], g0 = acc[ai][1][m][0], g1 = acc[ai][1][m][1];
                u32x4 w; w.x = cvt_pk_bf16(fast_silu(a0[0]) * g0[0], fast_silu(a0[1]) * g0[1]); w.y = cvt_pk_bf16(fast_silu(a0[2]) * g0[2], fast_silu(a0[3]) * g0[3]);
                w.z = cvt_pk_bf16(fast_silu(a1[0]) * g1[0], fast_silu(a1[1]) * g1[1]); w.w = cvt_pk_bf16(fast_silu(a1[2]) * g1[2], fast_silu(a1[3]) * g1[3]);
                *(u32x4*)rowp = w; }
    }
};
struct EpiStoreF {
    static constexpr bool PERM = true, AFTER_DRAIN = false;
    bf16_t* O; int ld; const float* T; int rope_tiles, rope_rows;
    __device__ __forceinline__ void operator()(const f32x4 (&acc)[2][2][4][2], const Unit& u, int wr, int wc, int fr, int fq) const {
        const int row0 = u.pm * BM + wr * 64 + fr, col0 = u.pn * BM + wc * 32 + 8 * fq;
        const bool rope = (u.pn < rope_tiles) && (u.pm * BM < rope_rows);
        const int jt = (wc & 1) * 16 + ((8 * fq) & 15);
        const float sgn = fq < 2 ? -1.f : 1.f;
#pragma unroll
        for (int ai = 0; ai < 2; ++ai)
#pragma unroll
            for (int m = 0; m < 4; ++m) { const int row = row0 + ai * HALF + m * 16; bf16_t* rowp = O + (size_t)row * ld + col0;
#pragma unroll
                for (int bj = 0; bj < 2; ++bj) { f32x4 v0 = acc[ai][bj][m][0], v1 = acc[ai][bj][m][1];
                    if (rope) {
                        const f32x4* tp = (const f32x4*)(T + ((size_t)(row & 2047) * 32 + jt) * 2);
                        const f32x4 t0 = tp[0], t1 = tp[1], t2 = tp[2], t3 = tp[3];
                        f32x4 p0, p1;
#pragma unroll
                        for (int j = 0; j < 4; ++j) { p0[j] = __shfl_xor(v0[j], 32); p1[j] = __shfl_xor(v1[j], 32); }
                        v0 = (f32x4){v0[0] * t0[0] + sgn * p0[0] * t0[1], v0[1] * t0[2] + sgn * p0[1] * t0[3], v0[2] * t1[0] + sgn * p0[2] * t1[1], v0[3] * t1[2] + sgn * p0[3] * t1[3]};
                        v1 = (f32x4){v1[0] * t2[0] + sgn * p1[0] * t2[1], v1[1] * t2[2] + sgn * p1[1] * t2[3], v1[2] * t3[0] + sgn * p1[2] * t3[1], v1[3] * t3[2] + sgn * p1[3] * t3[3]};
                    }
                    u32x4 w; w.x = cvt_pk_bf16(v0[0], v0[1]); w.y = cvt_pk_bf16(v0[2], v0[3]); w.z = cvt_pk_bf16(v1[0], v1[1]); w.w = cvt_pk_bf16(v1[2], v1[3]);
                    *(u32x4*)(rowp + bj * HALF) = w; } }
    }
};
struct EpiResidF {
    static constexpr bool PERM = false, AFTER_DRAIN = false;
    const float* xi; const float* hi; float* xo; float* ho; const float* gx; const float* gh; float scale, alpha; int dry;
    __device__ __forceinline__ void operator()(const f32x4 (&acc)[2][2][4][2], const Unit& u, int wr, int wc, int fr, int fq) const {
        const bool lat = u.pm < 64;
        const int rowt = (lat ? u.pm : u.pm - 64) * BM + wr * 64 + fr, col0 = u.pn * BM + wc * 32 + 4 * fq;
        const float* ri = lat ? xi : hi; float* ro = lat ? xo : ho; const float* g = lat ? gx + (size_t)9216 * (u.pm >> 3) : gh;
        f32x4 gv[2][2];
#pragma unroll
        for (int bj = 0; bj < 2; ++bj)
#pragma unroll
            for (int n = 0; n < 2; ++n) gv[bj][n] = *(const f32x4*)(g + col0 + bj * HALF + n * 16) * scale;
#pragma unroll
        for (int ai = 0; ai < 2; ++ai)
#pragma unroll
            for (int m = 0; m < 4; ++m) { const size_t off = (size_t)(rowt + ai * HALF + m * 16) * 1024 + col0;
#pragma unroll
                for (int bj = 0; bj < 2; ++bj)
#pragma unroll
                    for (int n = 0; n < 2; ++n) { const f32x4 r = *(const f32x4*)(ri + off + bj * HALF + n * 16);
                        const f32x4 y = r * alpha + gv[bj][n] * acc[ai][bj][m][n]; if (!dry || y[0] == 123456.789f) *(f32x4*)(ro + off + bj * HALF + n * 16) = y; } }
    }
};

struct SplitOrder {
    int idx, K128;
    __device__ void init(int K, int c) { idx = c; K128 = K / 128; }
    __device__ bool next(int i, Unit& u) const {
        if (i != 0 || idx >= 128) return false;
        const int sp = idx & 3, base = K128 >> 2, rem = K128 & 3, len = base + (sp < rem ? 1 : 0), start = sp * base + (sp < rem ? sp : rem);
        u.pm = 64 + (idx >> 4); u.pn = (idx >> 2) & 3; u.kofs = start * 128; u.nt = len * 2; u.aux = sp; return true;
    }
    __device__ __forceinline__ void a_ready(const Unit&) const {}
    __device__ __forceinline__ void done(const Unit&) const {}
};
struct EpiPartial {
    static constexpr bool PERM = false, AFTER_DRAIN = false;
    float* PART;
    __device__ __forceinline__ void operator()(const f32x4 (&acc)[2][2][4][2], const Unit& u, int wr, int wc, int fr, int fq) const {
        const int rowt = (u.pm - 64) * BM + wr * 64 + fr, col0 = u.pn * BM + wc * 32 + 4 * fq;
        float* base = PART + (size_t)u.aux * 2048 * 1024;
#pragma unroll
        for (int ai = 0; ai < 2; ++ai)
#pragma unroll
            for (int m = 0; m < 4; ++m) { const size_t off = (size_t)(rowt + ai * HALF + m * 16) * 1024 + col0;
#pragma unroll
                for (int bj = 0; bj < 2; ++bj)
#pragma unroll
                    for (int n = 0; n < 2; ++n) *(f32x4*)(base + off + bj * HALF + n * 16) = acc[ai][bj][m][n]; }
    }
};

template <class Epi, class Sched, bool ALIGN_EPI = false, bool SP2 = false>
__device__ __forceinline__ void gemm_phase(PG8_LAS unsigned char* lds, const Gemm g, const Sched& S, const Epi& E) {
    const int tid = otid(), wid = __builtin_amdgcn_readfirstlane(tid >> 6), lane = tid & 63, wr = wid >> 2, wc = wid & 3, fr = lane & 15, fq = lane >> 4;
    const int K = g.K;
    unsigned voffA[2], voffB[2];
#pragma unroll
    for (int i = 0; i < 2; ++i) { int R, C; stage_rc(tid * 16 + i * 8192, R, C); const int Rb = Epi::PERM ? ((R & ~31) + perm32(R & 31)) : R;
        voffA[i] = (unsigned)(R * K + C) * 2u; voffB[i] = (unsigned)(Rb * K + C) * 2u; }
    const size_t kstep = (size_t)(BK * 2);
    const size_t hstep = (size_t)HALF * K * 2;
    const size_t tstep = 2 * hstep;
    const unsigned ldsw = (unsigned)wid * 1024u;
    const int aoff = lds_byte(wr * 64 + fr, fq * 8), boff = lds_byte(wc * 32 + fr, fq * 8);
#define PG8_SA(b, h) (((b) * 2 + (h)) * HTB)
#define PG8_SB(b, h) ((4 + (b) * 2 + (h)) * HTB)
#define PG8_STAGE(bufoff, gbase, voff) do { _Pragma("unroll") for (int _i = 0; _i < 2; ++_i) \
        __builtin_amdgcn_global_load_lds((const unsigned*)((const char*)(gbase) + (voff)[_i]), (PG8_LAS unsigned*)(lds + (bufoff) + ldsw + _i * 8192), 16, 0, 0); } while (0)
#define PG8_LDA(dst, b, h) do { _Pragma("unroll") for (int m = 0; m < 4; ++m) _Pragma("unroll") for (int k = 0; k < 2; ++k) dst[m][k] = *(const PG8_LAS bf16x8*)(lds + PG8_SA(b, h) + aoff + m * 2048 + k * 1024); } while (0)
#define PG8_LDB(dst, b, h) do { _Pragma("unroll") for (int n = 0; n < 2; ++n) _Pragma("unroll") for (int k = 0; k < 2; ++k) dst[n][k] = *(const PG8_LAS bf16x8*)(lds + PG8_SB(b, h) + boff + n * 2048 + k * 1024); } while (0)
#define PG8_MMA(ai, bj, At, Bt) do { __builtin_amdgcn_s_setprio(1); _Pragma("unroll") for (int m = 0; m < 4; ++m) _Pragma("unroll") for (int n = 0; n < 2; ++n) _Pragma("unroll") for (int k = 0; k < 2; ++k) \
        acc[ai][bj][m][n] = __builtin_amdgcn_mfma_f32_16x16x32_bf16(Bt[n][k], At[m][k], acc[ai][bj][m][n], 0, 0, 0); __builtin_amdgcn_s_setprio(0); } while (0)
#define PG8_WAIT_V(n) asm volatile("s_waitcnt vmcnt(" #n ")" ::: "memory")
#define PG8_WAIT_L(n) asm volatile("s_waitcnt lgkmcnt(" #n ")" ::: "memory")
#define PG8_BAR __builtin_amdgcn_s_barrier()
#define PG8_SCHED __builtin_amdgcn_sched_barrier(0)
    Unit cur, nxt; int ui = 0;
    if (!S.next(0, cur)) return;
    f32x4 acc[2][2][4][2];
#pragma unroll
    for (int a = 0; a < 2; ++a)
#pragma unroll
        for (int b = 0; b < 2; ++b)
#pragma unroll
            for (int m = 0; m < 4; ++m)
#pragma unroll
                for (int n = 0; n < 2; ++n) acc[a][b][m][n] = (f32x4){0.f, 0.f, 0.f, 0.f};
    bf16x8 At[4][2], B0[2][2], B1[2][2];
    const char* cA = (const char*)g.A + (size_t)cur.pm * tstep + (size_t)cur.kofs * 2; const char* cB = (const char*)g.Bt + (size_t)cur.pn * tstep + (size_t)cur.kofs * 2;
    S.a_ready(cur);
    if constexpr (SP2) {
        PG8_STAGE(PG8_SB(0, 0), cB, voffB); PG8_STAGE(PG8_SB(0, 1), cB + hstep, voffB); PG8_STAGE(PG8_SA(0, 0), cA, voffA); PG8_STAGE(PG8_SA(0, 1), cA + hstep, voffA);
        if (wr == 1) PG8_BAR;
        PG8_WAIT_V(2); PG8_BAR;
        PG8_STAGE(PG8_SB(1, 0), cB + kstep, voffB); PG8_STAGE(PG8_SA(1, 0), cA + kstep, voffA); PG8_STAGE(PG8_SB(1, 1), cB + hstep + kstep, voffB);
        PG8_WAIT_V(6); PG8_BAR;
    } else {
        PG8_STAGE(PG8_SB(0, 0), cB, voffB); PG8_STAGE(PG8_SA(0, 0), cA, voffA); PG8_STAGE(PG8_SB(0, 1), cB + hstep, voffB); PG8_STAGE(PG8_SA(0, 1), cA + hstep, voffA);
        if (wr == 1) PG8_BAR;
        PG8_WAIT_V(4); PG8_BAR;
        PG8_STAGE(PG8_SB(1, 0), cB + kstep, voffB); PG8_STAGE(PG8_SA(1, 0), cA + kstep, voffA); PG8_STAGE(PG8_SB(1, 1), cB + hstep + kstep, voffB);
        PG8_WAIT_V(6); PG8_BAR;
    }
    for (;;) {
        const bool has_next = S.next(ui + 1, nxt);
        const char* nA = has_next ? (const char*)g.A + (size_t)nxt.pm * tstep + (size_t)nxt.kofs * 2 : cA; const char* nB = has_next ? (const char*)g.Bt + (size_t)nxt.pn * tstep + (size_t)nxt.kofs * 2 : cB;
        const int nt = cur.nt;
        for (int t = 0; t < nt; t += 2) {
            const bool last = (t == nt - 2);
            const char* a1 = cA + (size_t)(t + 1) * kstep;
            const char* a2 = last ? nA : cA + (size_t)(t + 2) * kstep; const char* b2 = last ? nB : cB + (size_t)(t + 2) * kstep;
            const char* a3 = a2 + kstep; const char* b3 = b2 + kstep;
            if (last && has_next) S.a_ready(nxt);
            if constexpr (SP2) {
            PG8_LDB(B0, 0, 0); PG8_LDB(B1, 0, 1); PG8_SCHED; PG8_LDA(At, 0, 0); PG8_STAGE(PG8_SA(1, 1), a1 + hstep, voffA);
            PG8_WAIT_V(8); PG8_WAIT_L(0); PG8_BAR; PG8_MMA(0, 0, At, B0); PG8_MMA(0, 1, At, B1); PG8_BAR; PG8_SCHED;
            PG8_LDA(At, 0, 1); PG8_STAGE(PG8_SB(0, 0), b2, voffB); PG8_STAGE(PG8_SB(0, 1), b2 + hstep, voffB); PG8_STAGE(PG8_SA(0, 0), a2, voffA);
            PG8_WAIT_V(8); PG8_WAIT_L(0); PG8_BAR; PG8_MMA(1, 0, At, B0); PG8_MMA(1, 1, At, B1); PG8_BAR; PG8_SCHED;
            PG8_LDB(B0, 1, 0); PG8_LDB(B1, 1, 1); PG8_SCHED; PG8_LDA(At, 1, 0); PG8_STAGE(PG8_SA(0, 1), a2 + hstep, voffA);
            PG8_WAIT_V(8); PG8_WAIT_L(0); PG8_BAR; PG8_MMA(0, 0, At, B0); PG8_MMA(0, 1, At, B1); PG8_BAR; PG8_SCHED;
            PG8_LDA(At, 1, 1); PG8_STAGE(PG8_SB(1, 0), b3, voffB); PG8_STAGE(PG8_SB(1, 1), b3 + hstep, voffB); PG8_STAGE(PG8_SA(1, 0), a3, voffA);
            PG8_WAIT_V(8); PG8_WAIT_L(0); PG8_BAR; PG8_MMA(1, 0, At, B0); PG8_MMA(1, 1, At, B1); PG8_BAR; PG8_SCHED;
            } else {
            PG8_LDB(B0, 0, 0); PG8_SCHED; PG8_LDA(At, 0, 0); PG8_STAGE(PG8_SA(1, 1), a1 + hstep, voffA);
            PG8_WAIT_L(8); PG8_BAR; PG8_WAIT_L(0); PG8_MMA(0, 0, At, B0); PG8_BAR; PG8_SCHED;
            PG8_LDB(B1, 0, 1); PG8_STAGE(PG8_SB(0, 0), b2, voffB);
            PG8_BAR; PG8_WAIT_L(0); PG8_MMA(0, 1, At, B1); PG8_BAR;
            PG8_LDA(At, 0, 1); PG8_STAGE(PG8_SA(0, 0), a2, voffA);
            PG8_BAR; PG8_WAIT_L(0); PG8_MMA(1, 0, At, B0); PG8_BAR; PG8_SCHED;
            PG8_STAGE(PG8_SB(0, 1), b2 + hstep, voffB);
            PG8_WAIT_V(6); PG8_BAR; PG8_MMA(1, 1, At, B1); PG8_BAR;
            PG8_LDB(B0, 1, 0); PG8_SCHED; PG8_LDA(At, 1, 0); PG8_STAGE(PG8_SA(0, 1), a2 + hstep, voffA);
            PG8_WAIT_L(8); PG8_BAR; PG8_WAIT_L(0); PG8_MMA(0, 0, At, B0); PG8_BAR; PG8_SCHED;
            PG8_LDB(B1, 1, 1); PG8_STAGE(PG8_SB(1, 0), b3, voffB);
            PG8_BAR; PG8_WAIT_L(0); PG8_MMA(0, 1, At, B1); PG8_BAR;
            PG8_LDA(At, 1, 1); PG8_STAGE(PG8_SA(1, 0), a3, voffA);
            PG8_BAR; PG8_WAIT_L(0); PG8_MMA(1, 0, At, B0); PG8_BAR; PG8_SCHED;
            PG8_STAGE(PG8_SB(1, 1), b3 + hstep, voffB);
            PG8_WAIT_V(6); PG8_BAR; PG8_MMA(1, 1, At, B1); PG8_BAR;
            }
        }
        if constexpr (ALIGN_EPI) { if (wr == 0) PG8_BAR; }
        if constexpr (!Epi::AFTER_DRAIN) { E(acc, cur, wr, wc, fr, fq); S.done(cur); }
        if (!has_next) break;
#pragma unroll
        for (int a = 0; a < 2; ++a)
#pragma unroll
            for (int b = 0; b < 2; ++b)
#pragma unroll
                for (int m = 0; m < 4; ++m)
#pragma unroll
                    for (int n = 0; n < 2; ++n) acc[a][b][m][n] = (f32x4){0.f, 0.f, 0.f, 0.f};
        cur = nxt; cA = nA; cB = nB; ++ui;
        if constexpr (ALIGN_EPI) { if (wr == 1) PG8_BAR; }
    }
    PG8_WAIT_V(0);
    if constexpr (!ALIGN_EPI) { if (wr == 0) PG8_BAR; }
    PG8_BAR;
    if constexpr (Epi::AFTER_DRAIN) { E.fused(acc, cur, wr, wc, fr, fq, lds, wid, lane); S.done(cur); }
#undef PG8_SA
#undef PG8_SB
#undef PG8_STAGE
#undef PG8_LDA
#undef PG8_LDB
#undef PG8_MMA
#undef PG8_WAIT_V
#undef PG8_WAIT_L
#undef PG8_BAR
#undef PG8_SCHED
}
}
template <int NV>
DI void att_step(const float (&q)[64], const bf16_t* kp, const bf16_t* vp, float bias, float& mx, float& l, float (&o)[NV]) {
    float dot = 0.f;
#pragma unroll
    for (int c = 0; c < 8; ++c) { const u32x4 raw = *(const u32x4*)(kp + c * 8);
#pragma unroll
        for (int j = 0; j < 4; ++j) { dot += q[c * 8 + 2 * j] * __uint_as_float(raw[j] << 16); dot += q[c * 8 + 2 * j + 1] * __uint_as_float(raw[j] & 0xffff0000u); } }
    const float s = dot * 0.125f + bias;
    const float mn = fmaxf(mx, s), corr = expf(mx - mn), pr = expf(s - mn);
    mx = mn; l = l * corr + pr;
#pragma unroll
    for (int c = 0; c < NV / 8; ++c) { const u32x4 raw = *(const u32x4*)(vp + c * 8);
#pragma unroll
        for (int j = 0; j < 4; ++j) { o[c * 8 + 2 * j] = o[c * 8 + 2 * j] * corr + pr * __uint_as_float(raw[j] << 16); o[c * 8 + 2 * j + 1] = o[c * 8 + 2 * j + 1] * corr + pr * __uint_as_float(raw[j] & 0xffff0000u); } }
}
DI void load_q64(float (&q)[64], const bf16_t* qp) {
#pragma unroll
    for (int c = 0; c < 8; ++c) { const u32x4 raw = *(const u32x4*)(qp + c * 8);
#pragma unroll
        for (int j = 0; j < 4; ++j) { q[c * 8 + 2 * j] = __uint_as_float(raw[j] << 16); q[c * 8 + 2 * j + 1] = __uint_as_float(raw[j] & 0xffff0000u); } }
}
DI void phase_na_naive(const P& p) {
    const bf16_t* QKV = (const bf16_t*)(p.ws + WS_H); bf16_t* A = (bf16_t*)(p.ws + WS_A); const float* rpb = p.in[10];
    for (int idx = blockIdx.x * NTHR + otid(); idx < MT * 8; idx += gridDim.x * NTHR) {
        const int head = idx & 7, m = idx >> 3;
        float q[64], o[64]; float mx = -1e30f, l = 0.f;
        load_q64(q, QKV + (size_t)m * LD0 + C_NQ + head * 64);
#pragma unroll
        for (int d = 0; d < 64; ++d) o[d] = 0.f;
        int b;
        if (m < MX) {
            b = m >> 11; const int t = m & 2047, r = t >> 6, c = t & 63;
            const int rs = min(max(r - 4, 0), 24), cs = min(max(c - 8, 0), 48);
#pragma unroll 1
            for (int i = 0; i < 8; ++i)
#pragma unroll 1
                for (int w = 0; w < 16; ++w) { const int rr = rs + i, ww = cs + w; const size_t mk = (size_t)b * 2048 + rr * 64 + ww;
                    const float bias = rpb[(head * 15 + (rr - r + 7)) * 31 + (ww - c + 15)];
                    att_step<64>(q, QKV + mk * LD0 + C_NK + head * 64, QKV + mk * LD0 + C_NV + head * 64, bias, mx, l, o); }
        } else b = (m - MX) >> 8;
#pragma unroll 1
        for (int lk = 0; lk < 256; ++lk) { const size_t mk = (size_t)MX + b * 256 + lk;
            att_step<64>(q, QKV + mk * LD0 + C_NK + head * 64, QKV + mk * LD0 + C_NV + head * 64, 0.f, mx, l, o); }
        const float il = 1.f / l; bf16_t* op = A + (size_t)m * DM + head * 64;
#pragma unroll
        for (int d = 0; d < 64; d += 2) *(unsigned*)(op + d) = pk2(o[d] * il, o[d + 1] * il);
    }
}
DI void phase_gla_naive(const P& p, float* lds) {
    float* sq = lds; float* sk = lds + 4096; float* sa = lds + 8192; float* sv = lds + 12288;
    const bf16_t* QKV = (const bf16_t*)(p.ws + WS_H);
    const int tid = otid();
    for (int chain = blockIdx.x; chain < 64; chain += gridDim.x) {
        const int dir = chain & 1, h = (chain >> 1) & 3, b = chain >> 3;
        const float* wg = p.in[dir ? 13 : 11]; const float* bg = p.in[dir ? 14 : 12];
        bf16_t* O = (bf16_t*)(p.ws + (dir ? WS_OB : WS_OF));
        const int zoff = dir ? C_ZB : C_ZF;
        float S[64];
#pragma unroll
        for (int d = 0; d < 64; ++d) S[d] = 0.f;
        for (int seg = 0; seg < 2; ++seg) {
            const int base = seg == 0 ? MX + b * 256 : b * 2048, n = seg == 0 ? 256 : 2048;
            for (int c = 0; c < n / 64; ++c) {
                for (int idx = tid; idx < 4096; idx += NTHR) { const int i = idx >> 6, d = idx & 63, tp = c * 64 + i, t = dir ? n - 1 - tp : tp;
                    const bf16_t* rowp = QKV + (size_t)(base + t) * LD0;
                    sq[idx] = bf2f(rowp[C_GQ + h * 64 + d]) * 0.125f; sk[idx] = bf2f(rowp[C_GK + h * 64 + d]);
                    float z = bg[h * 64 + d];
#pragma unroll
                    for (int r = 0; r < 16; ++r) z += bf2f(rowp[zoff + r]) * wg[r * 256 + h * 64 + d];
                    const float ls = fminf(z, 0.f) - log1pf(expf(-fabsf(z)));
                    sa[idx] = expf(ls * (1.f / 16.f)); }
                for (int idx = tid; idx < 8192; idx += NTHR) { const int i = idx >> 7, e = idx & 127, tp = c * 64 + i, t = dir ? n - 1 - tp : tp;
                    sv[idx] = bf2f(QKV[(size_t)(base + t) * LD0 + C_GV + h * 128 + e]); }
                __syncthreads();
                if (tid < 128) {
                    const int e = tid;
#pragma unroll 1
                    for (int i = 0; i < 64; ++i) { const float ve = sv[i * 128 + e]; float o = 0.f;
#pragma unroll
                        for (int d = 0; d < 64; ++d) { float sd = sa[i * 64 + d] * S[d];
                            if (dir == 0) { sd += sk[i * 64 + d] * ve; o += sq[i * 64 + d] * sd; } else { o += sq[i * 64 + d] * sd; sd += sk[i * 64 + d] * ve; }
                            S[d] = sd; }
                        const int tp = c * 64 + i, t = dir ? n - 1 - tp : tp;
                        O[(size_t)(base + t) * 512 + h * 128 + e] = f2bf(o); }
                }
                __syncthreads();
            }
        }
    }
}
DI void phase_gla_finalize(const P& p) {
    const int tid = otid(), lane = tid & 63, w = tid >> 6;
    const int gw = blockIdx.x * 8 + w, NGW = gridDim.x * 8;
    const bf16_t* QKV = (const bf16_t*)(p.ws + WS_H); bf16_t* A = (bf16_t*)(p.ws + WS_A);
    const bf16_t* OF = (const bf16_t*)(p.ws + WS_OF); const bf16_t* OB = (const bf16_t*)(p.ws + WS_OB); const float* ng = p.in[15];
    for (int m = gw; m < MT; m += NGW) {
        const u32x4 rf = *(const u32x4*)(OF + (size_t)m * 512 + lane * 8), rb = *(const u32x4*)(OB + (size_t)m * 512 + lane * 8), rg = *(const u32x4*)(QKV + (size_t)m * LD0 + C_GR + lane * 8);
        float s[8], g[8]; float ss = 0.f;
#pragma unroll
        for (int j = 0; j < 4; ++j) { s[2 * j] = __uint_as_float(rf[j] << 16) + __uint_as_float(rb[j] << 16); s[2 * j + 1] = __uint_as_float(rf[j] & 0xffff0000u) + __uint_as_float(rb[j] & 0xffff0000u);
            g[2 * j] = __uint_as_float(rg[j] << 16); g[2 * j + 1] = __uint_as_float(rg[j] & 0xffff0000u); }
#pragma unroll
        for (int j = 0; j < 8; ++j) ss += s[j] * s[j];
        ss += __shfl_xor(ss, 1); ss += __shfl_xor(ss, 2); ss += __shfl_xor(ss, 4); ss += __shfl_xor(ss, 8);
        const float rms = 1.0f / sqrtf(ss * (1.f / 128.f) + LN_EPS);
        float o[8];
#pragma unroll
        for (int j = 0; j < 8; ++j) o[j] = s[j] * rms * ng[(lane & 15) * 8 + j] * silu_f(g[j]);
        u32x4 ov; ov.x = pk2(o[0], o[1]); ov.y = pk2(o[2], o[3]); ov.z = pk2(o[4], o[5]); ov.w = pk2(o[6], o[7]);
        *(u32x4*)(A + (size_t)m * DM + 512 + lane * 8) = ov;
    }
}
DI void phase_rope_naive(const P& p) {
    bf16_t* QKV = (bf16_t*)(p.ws + WS_H); const float* T = (const float*)(p.ws + WS_ROPE);
    for (size_t idx = (size_t)blockIdx.x * NTHR + otid(); idx < (size_t)MX * 1024; idx += (size_t)gridDim.x * NTHR) {
        const int m = (int)(idx >> 10), pi = (int)(idx & 1023), blk = pi >> 5, j = pi & 31, t = m & 2047;
        const int d0 = j < 16 ? j : 32 + (j - 16);
        const float c = T[(t * 32 + j) * 2], s = T[(t * 32 + j) * 2 + 1];
        bf16_t* u = QKV + (size_t)m * LD1 + blk * 64 + d0;
        const float u0 = bf2f(u[0]), u1 = bf2f(u[16]);
        u[0] = f2bf(u0 * c - u1 * s); u[16] = f2bf(u1 * c + u0 * s);
    }
}
DI void phase_diff_naive(const P& p) {
    const bf16_t* QKV = (const bf16_t*)(p.ws + WS_H); bf16_t* A = (bf16_t*)(p.ws + WS_A);
    float d1 = 0.f, d2 = 0.f;
    for (int i = 0; i < 64; ++i) { d1 += p.in[24][i] * p.in[25][i]; d2 += p.in[26][i] * p.in[27][i]; }
    const float lam = expf(d1) - expf(d2) + LAMBDA_INIT;
    const float* sg = p.in[28];
    for (int idx = blockIdx.x * NTHR + otid(); idx < MX * 32; idx += gridDim.x * NTHR) {
        const int quarter = idx & 3, head = (idx >> 2) & 7, m = idx >> 5, b = m >> 11;
        float res[32];
#pragma unroll 1
        for (int br = 0; br < 2; ++br) {
            float q[64], o[32]; float mx = -1e30f, l = 0.f;
            load_q64(q, QKV + (size_t)m * LD1 + head * 128 + br * 64);
#pragma unroll
            for (int e = 0; e < 32; ++e) o[e] = 0.f;
#pragma unroll 1
            for (int key = 0; key < 2304; ++key) { const size_t mk = key < 2048 ? (size_t)b * 2048 + key : (size_t)MX + b * 256 + (key - 2048);
                att_step<32>(q, QKV + mk * LD1 + 1024 + head * 128 + br * 64, QKV + mk * LD1 + 2048 + head * 128 + quarter * 32, 0.f, mx, l, o); }
            const float il = 1.f / l;
            if (br == 0) {
#pragma unroll
                for (int e = 0; e < 32; ++e) res[e] = o[e] * il;
            } else {
#pragma unroll
                for (int e = 0; e < 32; ++e) res[e] -= lam * o[e] * il;
            }
        }
        float ss = 0.f;
#pragma unroll
        for (int e = 0; e < 32; ++e) ss += res[e] * res[e];
        ss += __shfl_xor(ss, 1); ss += __shfl_xor(ss, 2);
        const float rms = 1.0f / sqrtf(ss * (1.f / 128.f) + LN_EPS);
        bf16_t* op = A + (size_t)m * DM + head * 128 + quarter * 32;
#pragma unroll
        for (int e = 0; e < 32; e += 2) *(unsigned*)(op + e) = pk2(res[e] * rms * sg[quarter * 32 + e] * (1.f - LAMBDA_INIT), res[e + 1] * rms * sg[quarter * 32 + e + 1] * (1.f - LAMBDA_INIT));
    }
}


namespace att {
#define ALDS __attribute__((address_space(3)))
typedef short bf16x8 __attribute__((ext_vector_type(8)));
typedef short s16x4 __attribute__((ext_vector_type(4)));
typedef float f32x16 __attribute__((ext_vector_type(16)));
typedef float f32x2_t __attribute__((ext_vector_type(2)));
typedef __bf16 bf16x2_t __attribute__((ext_vector_type(2)));
constexpr int KV_STAGE = 32768;
constexpr int OFF_BIAS = 65536;
constexpr int BIAS_STRIDE = 640;
constexpr int OFF_SG = 65536 + 8192;
constexpr float LOG2E = 1.4426950408889634f;
DI unsigned cvtpk(float lo, float hi) { f32x2_t v = {lo, hi}; bf16x2_t b = __builtin_convertvector(v, bf16x2_t); return __builtin_bit_cast(unsigned, b); }
DI unsigned fxor(unsigned row) { return ((row & 3u) << 2) | ((row >> 2) & 3u); }
DI unsigned off_b(unsigned row, unsigned ch) { return 256u * row + 16u * (ch ^ fxor(row)); }
DI s16x4 vtr(const ALDS unsigned char* p) { typedef short v4i16_t __attribute__((ext_vector_type(4))); return __builtin_bit_cast(s16x4, __builtin_amdgcn_ds_read_tr16_b64_v4i16((ALDS v4i16_t*)p)); }
DI float half_swap(float v) { return __shfl_xor(v, 32); }

template <class RowPtr>
DI void dma_image(ALDS unsigned char* img, int wid, int lane, const RowPtr& rowptr) {
#pragma unroll
    for (int i = 0; i < 2; ++i) { const int ci = 2 * wid + i; const unsigned row = 4u * ci + (lane >> 4), pos = lane & 15, ch = pos ^ fxor(row);
        const unsigned char* src = rowptr((int)row) + 16u * ch;
        __builtin_amdgcn_global_load_lds((const unsigned*)src, (ALDS unsigned*)(img + 1024 * ci), 16, 0, 0); }
}

struct WaveState { float m, l; };

template <int NC, class TFn>
DI void step(f32x16 (&OT)[NC], WaveState& st, const bf16x8 (&qf)[4], const ALDS unsigned char* Kimg, const ALDS unsigned char* Vimg, const unsigned (&kaddr)[4], const unsigned (&vaddr)[NC][2], float cscale, const TFn& tfn) {
    f32x16 S[2];
#pragma unroll
    for (int j = 0; j < 2; ++j) {
#pragma unroll
        for (int r = 0; r < 16; ++r) S[j][r] = 0.f;
#pragma unroll
        for (int d0 = 0; d0 < 4; ++d0) { const bf16x8 kf = *(const ALDS bf16x8*)(Kimg + kaddr[d0] + 8192 * j); S[j] = __builtin_amdgcn_mfma_f32_32x32x16_bf16(kf, qf[d0], S[j], 0, 0, 0); }
    }
    float mx = -1e30f;
#pragma unroll
    for (int j = 0; j < 2; ++j)
#pragma unroll
        for (int r = 0; r < 16; ++r) { S[j][r] = tfn(j, r, S[j][r] * cscale); mx = fmaxf(mx, S[j][r]); }
    mx = fmaxf(mx, half_swap(mx));
    const float mn = fmaxf(st.m, mx), alpha = __builtin_amdgcn_exp2f(st.m - mn);
    st.m = mn;
    float rs = 0.f;
#pragma unroll
    for (int j = 0; j < 2; ++j)
#pragma unroll
        for (int r = 0; r < 16; ++r) { S[j][r] = __builtin_amdgcn_exp2f(S[j][r] - mn); rs += S[j][r]; }
    st.l = st.l * alpha + rs;
    if (__any(alpha != 1.0f)) {
#pragma unroll
        for (int c = 0; c < NC; ++c)
#pragma unroll
            for (int r = 0; r < 16; ++r) OT[c][r] *= alpha;
    }
#pragma unroll
    for (int j = 0; j < 2; ++j)
#pragma unroll
        for (int ks = 0; ks < 2; ++ks) {
            u32x4 pw; pw.x = cvtpk(S[j][8 * ks], S[j][8 * ks + 1]); pw.y = cvtpk(S[j][8 * ks + 2], S[j][8 * ks + 3]); pw.z = cvtpk(S[j][8 * ks + 4], S[j][8 * ks + 5]); pw.w = cvtpk(S[j][8 * ks + 6], S[j][8 * ks + 7]);
            const bf16x8 pf = __builtin_bit_cast(bf16x8, pw);
#pragma unroll
            for (int c = 0; c < NC; ++c) { const s16x4 lo = vtr(Vimg + vaddr[c][0] + 8192 * j + 4096 * ks), hi = vtr(Vimg + vaddr[c][1] + 8192 * j + 4096 * ks);
                const bf16x8 vf = {lo[0], lo[1], lo[2], lo[3], hi[0], hi[1], hi[2], hi[3]};
                OT[c] = __builtin_amdgcn_mfma_f32_32x32x16_bf16(vf, pf, OT[c], 0, 0, 0); }
        }
}
DI void make_kaddr(unsigned (&kaddr)[4], int lane, int ks_base) {
    const unsigned i = lane & 31, h = lane >> 5, rowp = (i & ~12u) | ((i & 4u) << 1) | ((i & 8u) >> 1);
#pragma unroll
    for (int d0 = 0; d0 < 4; ++d0) kaddr[d0] = off_b(rowp, 2u * (ks_base + d0) + h);
}
template <int NC>
DI void make_vaddr(unsigned (&vaddr)[NC][2], int lane, int c_base) {
    const unsigned h = lane >> 5, blk = (lane >> 4) & 1, q = (lane & 15) >> 2, p = lane & 3;
#pragma unroll
    for (int c = 0; c < NC; ++c)
#pragma unroll
        for (int t = 0; t < 2; ++t) vaddr[c][t] = off_b(8u * h + 4u * t + q, 4u * (c_base + c) + 2u * blk + (p >> 1)) + 8u * (p & 1);
}
DI void load_q(bf16x8 (&qf)[4], const bf16_t* qrow, int lane) {
    const int h = lane >> 5;
#pragma unroll
    for (int d0 = 0; d0 < 4; ++d0) qf[d0] = *(const bf16x8*)(qrow + 16 * d0 + 8 * h);
}
#define ATT_WAIT_BAR() do { asm volatile("s_waitcnt vmcnt(0) lgkmcnt(0)" ::: "memory"); __builtin_amdgcn_s_barrier(); asm volatile("" ::: "memory"); } while (0)

DI void phase_diff(const P& p, unsigned char* lds_generic) {
    ALDS unsigned char* lds = (ALDS unsigned char*)lds_generic;
    const int tid = otid(), lane = tid & 63, wid = __builtin_amdgcn_readfirstlane(tid >> 6), g = wid >> 2, qb = wid & 3, h = lane >> 5;
    const bf16_t* QKV = (const bf16_t*)(p.ws + WS_H); bf16_t* A = (bf16_t*)(p.ws + WS_A);
    float d1 = 0.f, d2 = 0.f;
    for (int i = 0; i < 64; ++i) { d1 += p.in[24][i] * p.in[25][i]; d2 += p.in[26][i] * p.in[27][i]; }
    const float lam = expf(d1) - expf(d2) + LAMBDA_INIT;
    ALDS float* sgl = (ALDS float*)(lds + OFF_SG);
    if (tid < 128) sgl[tid] = p.in[28][tid] * (1.f - LAMBDA_INIT);
    unsigned kaddr[4], vaddr[4][2];
    make_kaddr(kaddr, lane, 4 * g); make_vaddr<4>(vaddr, lane, 0);
    const float cscale = 0.125f * LOG2E;
    for (int unit = blockIdx.x; unit < 1024; unit += gridDim.x) {
        const int b = unit >> 7, head = (unit >> 4) & 7, qblk = unit & 15;
        const int mq = b * 2048 + qblk * 128 + qb * 32 + (lane & 31);
        bf16x8 qf[4]; load_q(qf, QKV + (size_t)mq * LD1 + head * 128 + g * 64, lane);
        f32x16 OT[4];
#pragma unroll
        for (int c = 0; c < 4; ++c)
#pragma unroll
            for (int r = 0; r < 16; ++r) OT[c][r] = 0.f;
        WaveState st{-1e30f, 0.f};
        auto issue = [&](int s) {
            ALDS unsigned char* base = lds + (s & 1) * KV_STAGE;
            auto krow = [&](int row) { const int key = s * 64 + row; const size_t m = key < 2048 ? (size_t)b * 2048 + key : (size_t)MX + b * 256 + (key - 2048); return (const unsigned char*)(QKV + m * LD1 + 1024 + head * 128); };
            auto vrow = [&](int row) { const int key = s * 64 + row; const size_t m = key < 2048 ? (size_t)b * 2048 + key : (size_t)MX + b * 256 + (key - 2048); return (const unsigned char*)(QKV + m * LD1 + 2048 + head * 128); };
            dma_image(base, wid, lane, krow); dma_image(base + 16384, wid, lane, vrow);
        };
        issue(0);
#pragma unroll 1
        for (int s = 0; s < 36; ++s) {
            ATT_WAIT_BAR();
            if (s + 1 < 36) issue(s + 1);
            const ALDS unsigned char* base = lds + (s & 1) * KV_STAGE;
            step<4>(OT, st, qf, base, base + 16384, kaddr, vaddr, cscale, [](int, int, float v) { return v; });
        }
        const float inv = 1.0f / (st.l + half_swap(st.l));
        ATT_WAIT_BAR();
        ALDS float* exch = (ALDS float*)lds + qb * 4096;
        if (g == 1) {
#pragma unroll
            for (int c = 0; c < 4; ++c)
#pragma unroll
                for (int r = 0; r < 16; ++r) exch[(c * 16 + r) * 64 + lane] = OT[c][r] * inv;
        }
        ATT_WAIT_BAR();
        if (g == 0) {
            float ss = 0.f;
#pragma unroll
            for (int c = 0; c < 4; ++c)
#pragma unroll
                for (int r = 0; r < 16; ++r) { const float o = OT[c][r] * inv - lam * exch[(c * 16 + r) * 64 + lane]; OT[c][r] = o; ss += o * o; }
            ss += half_swap(ss);
            const float rms = 1.0f / sqrtf(ss * (1.f / 128.f) + LN_EPS);
            bf16_t* orow = A + (size_t)mq * DM + head * 128;
#pragma unroll
            for (int c = 0; c < 4; ++c)
#pragma unroll
                for (int r4 = 0; r4 < 4; ++r4) { const int e0 = 32 * c + 8 * r4 + 4 * h; const f32x4 sg = *(const ALDS f32x4*)(sgl + e0);
                    u32x2 w; w.x = cvtpk(OT[c][4 * r4] * rms * sg[0], OT[c][4 * r4 + 1] * rms * sg[1]); w.y = cvtpk(OT[c][4 * r4 + 2] * rms * sg[2], OT[c][4 * r4 + 3] * rms * sg[3]);
                    *(u32x2*)(orow + e0) = w; }
        }
        ATT_WAIT_BAR();
    }
}

DI void phase_na(const P& p, unsigned char* lds_generic) {
    ALDS unsigned char* lds = (ALDS unsigned char*)lds_generic;
    const int tid = otid(), lane = tid & 63, wid = __builtin_amdgcn_readfirstlane(tid >> 6), g = wid >> 2, qb = wid & 3, h = lane >> 5;
    const bf16_t* QKV = (const bf16_t*)(p.ws + WS_H); bf16_t* A = (bf16_t*)(p.ws + WS_A);
    ALDS float* biasl = (ALDS float*)(lds + OFF_BIAS);
    unsigned kaddr[4], vaddr[2][2];
    make_kaddr(kaddr, lane, 4 * g); make_vaddr<2>(vaddr, lane, 2 * g);
    const float cscale = 0.125f * LOG2E;
    int cur_hp = -1;
    for (int unit = blockIdx.x; unit < 576; unit += gridDim.x) {
        int b, hp, mq, r_q = 0, cq = 0, rs0 = 0, nloc = 0; bool lat = unit < 512;
        if (lat) { b = unit >> 6; hp = (unit >> 4) & 3; const int rp = unit & 15; r_q = 2 * rp + (qb >> 1); cq = 32 * (qb & 1) + (lane & 31);
            mq = b * 2048 + r_q * 64 + cq; rs0 = min(max(2 * rp - 4, 0), 24); const int rs1 = min(max(2 * rp + 1 - 4, 0), 24); nloc = rs1 + 8 - rs0; }
        else { const int u = unit - 512; b = u >> 3; hp = (u >> 1) & 3; mq = MX + b * 256 + (u & 1) * 128 + qb * 32 + (lane & 31); }
        const int head = 2 * hp + g;
        if (hp != cur_hp) {
            ATT_WAIT_BAR();
            for (int i = tid; i < 2 * BIAS_STRIDE; i += NTHR) { const int hh = i / BIAS_STRIDE, k = i % BIAS_STRIDE - 64; biasl[i] = (k >= 0 && k < 465) ? p.in[10][(2 * hp + hh) * 465 + k] * LOG2E : 0.f; }
            cur_hp = hp;
        }
        bf16x8 qf[4]; load_q(qf, QKV + (size_t)mq * LD0 + C_NQ + head * 64, lane);
        f32x16 OT[2];
#pragma unroll
        for (int c = 0; c < 2; ++c)
#pragma unroll
            for (int r = 0; r < 16; ++r) OT[c][r] = 0.f;
        WaveState st{-1e30f, 0.f};
        const int nsteps = nloc + 4;
        auto issue = [&](int s) {
            ALDS unsigned char* base = lds + (s & 1) * KV_STAGE;
            const size_t m0 = s < nloc ? (size_t)b * 2048 + (rs0 + s) * 64 : (size_t)MX + b * 256 + (s - nloc) * 64;
            auto krow = [&](int row) { return (const unsigned char*)(QKV + (m0 + row) * LD0 + C_NK + hp * 128); };
            auto vrow = [&](int row) { return (const unsigned char*)(QKV + (m0 + row) * LD0 + C_NV + hp * 128); };
            dma_image(base, wid, lane, krow); dma_image(base + 16384, wid, lane, vrow);
        };
        issue(0);
        const int rsq = min(max(r_q - 4, 0), 24), cs = min(max(cq - 8, 0), 48);
#pragma unroll 1
        for (int s = 0; s < nsteps; ++s) {
            ATT_WAIT_BAR();
            if (s + 1 < nsteps) issue(s + 1);
            const ALDS unsigned char* base = lds + (s & 1) * KV_STAGE;
            if (s < nloc) {
                const int rr = rs0 + s;
                if (rr >= rsq && rr < rsq + 8) {
                    const ALDS float* bl = biasl + g * BIAS_STRIDE + 64 + (rr - r_q + 7) * 31 + 15 - cq + 8 * h;
                    step<2>(OT, st, qf, base, base + 16384, kaddr, vaddr, cscale, [&](int j, int r, float v) {
                        const int w = 32 * j + 16 * (r >> 3) + 8 * h + (r & 7);
                        const float bv = bl[32 * j + 16 * (r >> 3) + (r & 7)];
                        return ((unsigned)(w - cs) < 16u) ? v + bv : -1e30f; });
                }
            } else step<2>(OT, st, qf, base, base + 16384, kaddr, vaddr, cscale, [](int, int, float v) { return v; });
        }
        const float inv = 1.0f / (st.l + half_swap(st.l));
        bf16_t* orow = A + (size_t)mq * DM + head * 64;
#pragma unroll
        for (int c = 0; c < 2; ++c)
#pragma unroll
            for (int r4 = 0; r4 < 4; ++r4) { const int e0 = 32 * c + 8 * r4 + 4 * h;
                u32x2 w; w.x = cvtpk(OT[c][4 * r4] * inv, OT[c][4 * r4 + 1] * inv); w.y = cvtpk(OT[c][4 * r4 + 2] * inv, OT[c][4 * r4 + 3] * inv);
                *(u32x2*)(orow + e0) = w; }
        ATT_WAIT_BAR();
    }
    ATT_WAIT_BAR();
}
#undef ALDS
}


namespace gla {
#define ALDS __attribute__((address_space(3)))
using att::bf16x8; using att::s16x4; using att::f32x16; using att::off_b; using att::fxor; using att::vtr; using att::cvtpk; using att::half_swap;
constexpr size_t WS_U = WS_OF;
constexpr size_t WS_GD = 283 * MiB;
DI int chain_id(int b, int h, int dir) { return (b * 4 + h) * 2 + dir; }
DI float logsig16(float z) { return (fminf(z, 0.f) - log1pf(expf(-fabsf(z)))) * (1.f / 16.f); }

DI void gates(const P& p, const bf16_t* QKV, size_t m0, int hh, int d, int seg, ALDS float* tot, float (&Bf)[8], float (&Bb)[8], float& totf, float& totb) {
    float wf[16], wb[16];
#pragma unroll
    for (int r = 0; r < 16; ++r) { wf[r] = p.in[11][r * 256 + hh * 64 + d]; wb[r] = p.in[13][r * 256 + hh * 64 + d]; }
    const float bf = p.in[12][hh * 64 + d], bb = p.in[14][hh * 64 + d];
    float lf[8], lb[8];
#pragma unroll
    for (int k = 0; k < 8; ++k) {
        const u32x4* zr = (const u32x4*)(QKV + (m0 + 8 * seg + k) * LD0 + C_ZF);
        float zf = bf, zb = bb;
#pragma unroll
        for (int c4 = 0; c4 < 2; ++c4) { const u32x4 a = zr[c4], b2 = zr[2 + c4];
#pragma unroll
            for (int j = 0; j < 4; ++j) { zf += __uint_as_float(a[j] << 16) * wf[c4 * 8 + 2 * j] + __uint_as_float(a[j] & 0xffff0000u) * wf[c4 * 8 + 2 * j + 1];
                zb += __uint_as_float(b2[j] << 16) * wb[c4 * 8 + 2 * j] + __uint_as_float(b2[j] & 0xffff0000u) * wb[c4 * 8 + 2 * j + 1]; } }
        lf[k] = logsig16(zf); lb[k] = logsig16(zb);
    }
    Bf[0] = lf[0];
#pragma unroll
    for (int k = 1; k < 8; ++k) Bf[k] = Bf[k - 1] + lf[k];
    Bb[7] = lb[7];
#pragma unroll
    for (int k = 6; k >= 0; --k) Bb[k] = Bb[k + 1] + lb[k];
    tot[seg * 64 + d] = Bf[7]; tot[(8 + seg) * 64 + d] = Bb[0];
    asm volatile("s_waitcnt lgkmcnt(0)" ::: "memory"); __builtin_amdgcn_s_barrier(); asm volatile("" ::: "memory");
    float offf = 0.f, offb = 0.f; totf = 0.f; totb = 0.f;
#pragma unroll
    for (int s2 = 0; s2 < 8; ++s2) { const float tf = tot[s2 * 64 + d], tb = tot[(8 + s2) * 64 + d]; totf += tf; totb += tb; if (s2 < seg) offf += tf; if (s2 > seg) offb += tb; }
#pragma unroll
    for (int k = 0; k < 8; ++k) { Bf[k] += offf; Bb[k] += offb; }
}
DI void token_chunk(int tc, int b, size_t& m0, int& cf, int& cb) {
    if (tc < 4) { m0 = (size_t)MX + b * 256 + tc * 64; cf = tc; cb = 3 - tc; } else { m0 = (size_t)b * 2048 + (tc - 4) * 64; cf = tc; cb = 39 - tc; }
}
DI void img_store(ALDS unsigned char* img, int row, int col, float v) { *(ALDS bf16_t*)(img + off_b(row, col >> 3) + 2 * (col & 7)) = f2bf(v); }
template <int NCC>
DI void make_tr(unsigned (&a)[NCC][2], int lane, int c_base) { att::make_vaddr<NCC>(a, lane, c_base); }
DI bf16x8 tr_frag(const ALDS unsigned char* img, const unsigned (&a)[2], int ks) { const s16x4 lo = vtr(img + a[0] + 4096 * ks), hi = vtr(img + a[1] + 4096 * ks); return (bf16x8){lo[0], lo[1], lo[2], lo[3], hi[0], hi[1], hi[2], hi[3]}; }

DI void phase_g1(const P& p, unsigned char* lds_generic) {
    ALDS unsigned char* lds = (ALDS unsigned char*)lds_generic;
    ALDS unsigned char* Vimg = lds; ALDS unsigned char* KDimg = lds + 16384; ALDS float* tot = (ALDS float*)(lds + 32768);
    const int tid = otid(), lane = tid & 63, wid = __builtin_amdgcn_readfirstlane(tid >> 6), d = lane, seg = wid, h = lane >> 5;
    const bf16_t* QKV = (const bf16_t*)(p.ws + WS_H); bf16_t* U = (bf16_t*)(p.ws + WS_U); float* GD = (float*)(p.ws + WS_GD);
    const int db = wid & 1, eb = wid >> 1;
    unsigned akd[2][2], av[1][2];
    for (int unit = blockIdx.x; unit < 1152; unit += gridDim.x) {
        const int tc = unit % 36, bh = unit / 36, b = bh >> 2, hh = bh & 3;
        size_t m0; int cf, cb; token_chunk(tc, b, m0, cf, cb);
        att::dma_image(Vimg, wid, lane, [&](int row) { return (const unsigned char*)(QKV + (m0 + row) * LD0 + C_GV + hh * 128); });
        float Bf[8], Bb[8], totf, totb;
        gates(p, QKV, m0, hh, d, seg, tot, Bf, Bb, totf, totb);
#pragma unroll
        for (int k = 0; k < 8; ++k) { const int i = 8 * seg + k; const float kv = bf2f(QKV[(m0 + i) * LD0 + C_GK + hh * 64 + d]);
            img_store(KDimg, i, d, kv * expf(totf - Bf[k])); img_store(KDimg, i, 64 + d, kv * expf(totb - Bb[k])); }
        if (seg == 0) GD[(size_t)(chain_id(b, hh, 0) * 36 + cf) * 64 + d] = expf(totf);
        if (seg == 1) GD[(size_t)(chain_id(b, hh, 1) * 36 + cb) * 64 + d] = expf(totb);
        ATT_WAIT_BAR();
        make_tr<2>(akd, lane, db); make_tr<1>(av, lane, eb);
        unsigned akb[1][2]; make_tr<1>(akb, lane, 2 + db);
        f32x16 accf, accb;
#pragma unroll
        for (int r = 0; r < 16; ++r) { accf[r] = 0.f; accb[r] = 0.f; }
#pragma unroll
        for (int ks = 0; ks < 4; ++ks) { const bf16x8 vf = tr_frag(Vimg, av[0], ks);
            accf = __builtin_amdgcn_mfma_f32_32x32x16_bf16(tr_frag(KDimg, akd[0], ks), vf, accf, 0, 0, 0);
            accb = __builtin_amdgcn_mfma_f32_32x32x16_bf16(tr_frag(KDimg, akb[0], ks), vf, accb, 0, 0, 0); }
        bf16_t* Uf = U + ((size_t)(chain_id(b, hh, 0) * 36 + cf) * 64) * 128; bf16_t* Ub = U + ((size_t)(chain_id(b, hh, 1) * 36 + cb) * 64) * 128;
#pragma unroll
        for (int r = 0; r < 16; ++r) { const int dd = 32 * db + 8 * (r >> 2) + 4 * h + (r & 3), e = 32 * eb + (lane & 31);
            Uf[dd * 128 + e] = f2bf(accf[r]); Ub[dd * 128 + e] = f2bf(accb[r]); }
        ATT_WAIT_BAR();
    }
}
DI void phase_g2(const P& p, int dry) {
    bf16_t* U = (bf16_t*)(p.ws + WS_U); const float* GD = (const float*)(p.ws + WS_GD);
    for (int item = blockIdx.x * NTHR + otid(); item < 65536; item += gridDim.x * NTHR) {
        const int chain = item >> 10, rem = item & 1023, d = rem >> 4, e8 = (rem & 15) * 8;
        float st[8];
#pragma unroll
        for (int j = 0; j < 8; ++j) st[j] = 0.f;
#pragma unroll 4
        for (int c = 0; c < 36; ++c) {
            u32x4* ptr = (u32x4*)(U + ((size_t)(chain * 36 + c) * 64 + d) * 128 + e8); const u32x4 raw = *ptr; const float dec = GD[(size_t)(chain * 36 + c) * 64 + d];
            u32x4 o; o.x = pk2(st[0], st[1]); o.y = pk2(st[2], st[3]); o.z = pk2(st[4], st[5]); o.w = pk2(st[6], st[7]); if (!dry || st[0] == 123456.789f) *ptr = o;
#pragma unroll
            for (int j = 0; j < 4; ++j) { st[2 * j] = dec * st[2 * j] + __uint_as_float(raw[j] << 16); st[2 * j + 1] = dec * st[2 * j + 1] + __uint_as_float(raw[j] & 0xffff0000u); }
        }
    }
}
DI void phase_g3(const P& p, unsigned char* lds_generic) {
    ALDS unsigned char* lds = (ALDS unsigned char*)lds_generic;
    ALDS unsigned char* Vimg = lds; ALDS unsigned char* Simg = lds + 16384  ; ALDS unsigned char* QKimg = lds + 49152  ;
    ALDS float* tot = (ALDS float*)(lds + 81920); ALDS float* ssb = (ALDS float*)(lds + 86016);
    const int tid = otid(), lane = tid & 63, wid = __builtin_amdgcn_readfirstlane(tid >> 6), d = lane, seg = wid, h = lane >> 5;
    const bf16_t* QKV = (const bf16_t*)(p.ws + WS_H); const bf16_t* U = (const bf16_t*)(p.ws + WS_U); bf16_t* A = (bf16_t*)(p.ws + WS_A);
    const int eb = wid & 3, tb = wid >> 2;
    unsigned kaddr[4], qaddr[4], atr[1][2];
    att::make_kaddr(kaddr, lane, 4);
#pragma unroll
    for (int d0 = 0; d0 < 4; ++d0) qaddr[d0] = off_b(lane & 31, 2 * d0 + h);
    make_tr<1>(atr, lane, eb);
    for (int unit = blockIdx.x; unit < 1152; unit += gridDim.x) {
        const int tc = unit % 36, bh = unit / 36, b = bh >> 2, hh = bh & 3;
        size_t m0; int cf, cb; token_chunk(tc, b, m0, cf, cb);
        att::dma_image(Vimg, wid, lane, [&](int row) { return (const unsigned char*)(QKV + (m0 + row) * LD0 + C_GV + hh * 128); });
        att::dma_image(Simg, wid, lane, [&](int row) { return (const unsigned char*)(U + ((size_t)(chain_id(b, hh, 0) * 36 + cf) * 64 + row) * 128); });
        att::dma_image(Simg + 16384, wid, lane, [&](int row) { return (const unsigned char*)(U + ((size_t)(chain_id(b, hh, 1) * 36 + cb) * 64 + row) * 128); });
        float Bf[8], Bb[8], totf, totb;
        gates(p, QKV, m0, hh, d, seg, tot, Bf, Bb, totf, totb);
#pragma unroll
        for (int k = 0; k < 8; ++k) { const int i = 8 * seg + k; const float qv = bf2f(QKV[(m0 + i) * LD0 + C_GQ + hh * 64 + d]) * 0.125f, kv = bf2f(QKV[(m0 + i) * LD0 + C_GK + hh * 64 + d]);
            img_store(QKimg, i, d, qv * expf(Bf[k])); img_store(QKimg, i, 64 + d, kv * expf(-Bf[k]));
            img_store(QKimg + 16384, i, d, qv * expf(Bb[k])); img_store(QKimg + 16384, i, 64 + d, kv * expf(-Bb[k])); }
        ATT_WAIT_BAR();
        f32x16 acc;
#pragma unroll
        for (int r = 0; r < 16; ++r) acc[r] = 0.f;
        const int tq = 32 * tb + (lane & 31);
#pragma unroll
        for (int dir = 0; dir < 2; ++dir) {
            const ALDS unsigned char* QK = QKimg + 16384 * dir; const ALDS unsigned char* SI = Simg + 16384 * dir;
            bf16x8 qf[4];
#pragma unroll
            for (int d0 = 0; d0 < 4; ++d0) qf[d0] = *(const ALDS bf16x8*)(QK + qaddr[d0] + 8192 * tb);
#pragma unroll
            for (int sb = 0; sb < 2; ++sb) {
                if ((dir == 0 && sb > tb) || (dir == 1 && sb < tb)) continue;
                f32x16 S;
#pragma unroll
                for (int r = 0; r < 16; ++r) S[r] = 0.f;
#pragma unroll
                for (int d0 = 0; d0 < 4; ++d0) { const bf16x8 kf = *(const ALDS bf16x8*)(QK + kaddr[d0] + 8192 * sb); S = __builtin_amdgcn_mfma_f32_32x32x16_bf16(kf, qf[d0], S, 0, 0, 0); }
#pragma unroll
                for (int r = 0; r < 16; ++r) { const int sk = 32 * sb + 16 * (r >> 3) + 8 * h + (r & 7); const bool keep = dir == 0 ? (sk <= tq) : (sk > tq); S[r] = keep ? S[r] : 0.f; }
#pragma unroll
                for (int ks2 = 0; ks2 < 2; ++ks2) {
                    u32x4 pw; pw.x = cvtpk(S[8 * ks2], S[8 * ks2 + 1]); pw.y = cvtpk(S[8 * ks2 + 2], S[8 * ks2 + 3]); pw.z = cvtpk(S[8 * ks2 + 4], S[8 * ks2 + 5]); pw.w = cvtpk(S[8 * ks2 + 6], S[8 * ks2 + 7]);
                    acc = __builtin_amdgcn_mfma_f32_32x32x16_bf16(tr_frag(Vimg, atr[0], 2 * sb + ks2), __builtin_bit_cast(bf16x8, pw), acc, 0, 0, 0); }
            }
#pragma unroll
            for (int ks = 0; ks < 4; ++ks) acc = __builtin_amdgcn_mfma_f32_32x32x16_bf16(tr_frag(SI, atr[0], ks), qf[ks], acc, 0, 0, 0);
        }
        float ss = 0.f;
#pragma unroll
        for (int r = 0; r < 16; ++r) ss += acc[r] * acc[r];
        ss += half_swap(ss);
        if (h == 0) ssb[eb * 64 + tq] = ss;
        ATT_WAIT_BAR();
        const float tots = ssb[tq] + ssb[64 + tq] + ssb[128 + tq] + ssb[192 + tq];
        const float rms = 1.0f / sqrtf(tots * (1.f / 128.f) + LN_EPS);
        const size_t m = m0 + tq;
#pragma unroll
        for (int r4 = 0; r4 < 4; ++r4) { const int e0 = 32 * eb + 8 * r4 + 4 * h;
            const f32x4 ng = *(const f32x4*)(p.in[15] + e0); const u32x2 gr = *(const u32x2*)(QKV + m * LD0 + C_GR + hh * 128 + e0);
            const float g0 = __uint_as_float(gr.x << 16), g1 = __uint_as_float(gr.x & 0xffff0000u), g2 = __uint_as_float(gr.y << 16), g3 = __uint_as_float(gr.y & 0xffff0000u);
            u32x2 w; w.x = cvtpk(acc[4 * r4] * rms * ng[0] * silu_f(g0), acc[4 * r4 + 1] * rms * ng[1] * silu_f(g1)); w.y = cvtpk(acc[4 * r4 + 2] * rms * ng[2] * silu_f(g2), acc[4 * r4 + 3] * rms * ng[3] * silu_f(g3));
            *(u32x2*)(A + m * DM + 512 + hh * 128 + e0) = w; }
        ATT_WAIT_BAR();
    }
}
#undef ALDS
}


#define LAS __attribute__((address_space(3)))
#define XB_TMO      128
#define XB_XCNT(j)  (256  + 64 * (j))
#define XB_XSUB(j)  (1280 + 64 * (j))
#define XB_XGEN(j)  (2304 + 64 * (j))
#define XB_TOP      3328
#define XB_TOPGEN   3392
#define XCD_BAR_WORDS 3456
#define XB_SPIN_CAP (1u << 18)

__device__ __forceinline__ unsigned xb_ld(unsigned* p)              { return __hip_atomic_load(p, __ATOMIC_RELAXED, __HIP_MEMORY_SCOPE_AGENT); }
__device__ __forceinline__ unsigned xb_add(unsigned* p, unsigned v) { return __hip_atomic_fetch_add(p, v, __ATOMIC_RELAXED, __HIP_MEMORY_SCOPE_AGENT); }
__device__ __forceinline__ unsigned xb_xcc_id() { return (unsigned)__builtin_amdgcn_s_getreg((3 << 11) | 20) & 0xFu; }
#define XB_SPIN(cond, bar) do { unsigned _sp = 0; while (cond) { __builtin_amdgcn_s_sleep(1); \
    if ((++_sp & 255u) == 0u) { if (xb_ld(&(bar)[XB_TMO])) break; if (_sp > XB_SPIN_CAP) { atomicAdd(&(bar)[XB_TMO], 1u); break; } } } } while (0)

struct XcdBarrier {
    unsigned* bar; unsigned x;
    volatile LAS unsigned* st;
};

__device__ __forceinline__ XcdBarrier xcd_barrier_post(unsigned* bar, volatile LAS unsigned* st) {
    XcdBarrier b; b.bar = bar; b.x = xb_xcc_id(); b.st = st;
    if (threadIdx.x == 0) (void)xb_add(&bar[XB_XCNT(b.x)], 1u);
    return b;
}
__device__ __forceinline__ void xcd_barrier_complete(unsigned* bar, unsigned x, unsigned& nloc, unsigned& nx) {
    const unsigned G = gridDim.x * gridDim.y * gridDim.z;
    unsigned sum, cnt, mine, sp = 0u;
    for (;;) {
        sum = 0u; cnt = 0u; mine = 0u;
#pragma unroll
        for (unsigned j = 0; j < 16; ++j) { const unsigned c = xb_ld(&bar[XB_XCNT(j)]); sum += c; cnt += (c > 0u) ? 1u : 0u; mine = (j == x) ? c : mine; }
        if (sum == G) break;
        __builtin_amdgcn_s_sleep(1);
        if ((++sp & 255u) == 0u) { if (xb_ld(&bar[XB_TMO])) break; if (sp > XB_SPIN_CAP) { atomicAdd(&bar[XB_TMO], 1u); break; } }
    }
    nloc = mine > 0u ? mine : 1u; nx = cnt > 0u ? cnt : 1u;
}

__device__ __forceinline__ void xcd_barrier(const XcdBarrier& b) {
    asm volatile("s_waitcnt vmcnt(0)" ::: "memory");
    __syncthreads();
    if (threadIdx.x == 0) {
        unsigned* bar = b.bar;
        __builtin_amdgcn_s_waitcnt(0);
        unsigned nloc = b.st[0], nx = b.st[1];
        if (nloc == 0u) { xcd_barrier_complete(bar, b.x, nloc, nx); b.st[0] = nloc; b.st[1] = nx; }
        const unsigned old = xb_add(&bar[XB_XSUB(b.x)], 1u);
        const unsigned gen = old / nloc;
        if (old + 1u == (gen + 1u) * nloc) {
            __builtin_amdgcn_fence(__ATOMIC_RELEASE, "agent");
            asm volatile("s_waitcnt vmcnt(0)" ::: "memory");
            const unsigned og = xb_add(&bar[XB_TOP], 1u);
            const unsigned tg = og / nx;
            if (og + 1u == (tg + 1u) * nx) xb_add(&bar[XB_TOPGEN], 1u);
            else XB_SPIN(xb_ld(&bar[XB_TOPGEN]) == tg, bar);
            __builtin_amdgcn_fence(__ATOMIC_ACQUIRE, "agent");
            xb_add(&bar[XB_XGEN(b.x)], 1u);
            asm volatile("s_waitcnt vmcnt(0)" ::: "memory");
        } else {
            XB_SPIN(xb_ld(&bar[XB_XGEN(b.x)]) == gen, bar);
            __builtin_amdgcn_fence(__ATOMIC_ACQUIRE, "agent");
            asm volatile("s_waitcnt vmcnt(0)" ::: "memory");
        }
    }
    __syncthreads();
}

__global__ void __launch_bounds__(NTHR) mk_fwd(P p) {
    extern __shared__ __attribute__((aligned(16))) unsigned char lds_raw[];
    float* lds = (float*)lds_raw;
    cg::grid_group grid = cg::this_grid();
    volatile LAS unsigned* bst = (volatile LAS unsigned*)((LAS unsigned char*)lds_raw + 139264);
    if (threadIdx.x < 4) bst[threadIdx.x] = 0u;
    __syncthreads();
    const XcdBarrier xbar = xcd_barrier_post((unsigned*)(p.ws + WS_CTL), bst);
    int ph = 0;
#define RUN(...) do { if (ph >= p.ph_lo && ph < p.ph_hi) { __VA_ARGS__; if (ph + 1 < p.ph_hi) { for (int rs_ = 0; rs_ < REP_SYNC; ++rs_) { if (ph == 0) grid.sync(); else xcd_barrier(xbar); } } } ++ph; } while (0)
#define REPEAT(n, ...) do { for (int rp_ = 0; rp_ < (n); ++rp_) { __VA_ARGS__; } } while (0)
    bf16_t* A = (bf16_t*)(p.ws + WS_A); bf16_t* H = (bf16_t*)(p.ws + WS_H);

    RUN(REPEAT(REP_PRO, phase_adaln(p, lds); phase_rope_table(p); phase_convert(p, lds); __syncthreads()));
    RUN(REPEAT(REP_ROW, phase_rowpass(p, false, 0, false, true, 0, 0, 1, MT)));
    __attribute__((address_space(3))) unsigned char* glds = (__attribute__((address_space(3))) unsigned char*)lds_raw;
    float* XH = (float*)(p.ws + WS_XH); const float* ROPE = (const float*)(p.ws + WS_ROPE);
    const int G = (int)gridDim.x, cid = (int)blockIdx.x;
#define GEMM_SWIGLU(Aop, Wt, Mrows) do { pg8::Gemm g{Aop, Wt, Mrows, 2 * DFF, DM}; pg8::StaticOrder S; S.init(Mrows, 2 * DFF, G, cid, DM); pg8::EpiSwigluF E{H, DFF}; \
        pg8::gemm_phase<pg8::EpiSwigluF, pg8::StaticOrder, true, true>(glds, g, S, E); } while (0)
#define GEMM_STORE(Aop, Wt, Mrows, N, ropet) do { pg8::Gemm g{Aop, Wt, Mrows, N, DM}; pg8::StaticOrder S; S.init(Mrows, N, G, cid, DM); pg8::EpiStoreF E{H, N, ROPE, ropet, MX}; \
        pg8::gemm_phase<pg8::EpiStoreF, pg8::StaticOrder, true, true>(glds, g, S, E); } while (0)
#define GEMM_RESID(Aop, Wt, Mrows, K, xi, hi, chunk, sc) do { pg8::Gemm g{Aop, Wt, Mrows, DM, K}; pg8::StaticOrder S; S.init(Mrows, DM, G, cid, K); \
        for (int rr_ = REP_RES - 1; rr_ >= 0; --rr_) { pg8::EpiResidF E{xi, hi, p.out, XH, mod_ptr(p, l, 0, chunk), mod_ptr(p, l, 8, chunk), sc, ALPHA, rr_}; \
        pg8::gemm_phase<pg8::EpiResidF, pg8::StaticOrder, true, true>(glds, g, S, E); } } while (0)
#define GEMM_HPART(Aop, Wt, K) do { pg8::Gemm g{Aop, Wt, MT, DM, K}; pg8::SplitOrder S; S.init(K, cid); pg8::EpiPartial E{(float*)(p.ws + WS_OF)}; \
        pg8::gemm_phase<pg8::EpiPartial, pg8::SplitOrder, true, true>(glds, g, S, E); } while (0)
#pragma unroll 1
    for (int l = 0; l < 2; ++l) {
        RUN(REPEAT(REP_SWI, GEMM_SWIGLU(A, wt_ptr(p, l, WT_F1I), MT)));
        RUN({ GEMM_RESID(H, wt_ptr(p, l, WT_F1O), MX, DFF, (l == 0 ? p.in[0] : (const float*)p.out), (const float*)XH, 2, 0.5f); GEMM_HPART(H, wt_ptr(p, l, WT_F1O), DFF); });
        RUN(REPEAT(REP_ROW, phase_rowpass(p, true, 1, true, true, l, 3, 4, MT, 2, 0.5f, l, l == 0)));
        if (l == 0) {
            RUN(REPEAT(REP_STORE, GEMM_STORE(A, wt_ptr(p, l, WT_MI), MT, LD0, 0)));
            RUN({ REPEAT(REP_G1, gla::phase_g1(p, lds_raw)); REPEAT(REP_NA, att::phase_na(p, lds_raw)); });
            RUN({ for (int rr_ = REP_G2 - 1; rr_ >= 0; --rr_) gla::phase_g2(p, rr_); });
            RUN(REPEAT(REP_G3, gla::phase_g3(p, lds_raw)));
        } else {
            RUN(REPEAT(REP_STORE, GEMM_STORE(A, wt_ptr(p, l, WT_MI), MT, LD1, 8)));
            RUN(REPEAT(REP_DIFF, att::phase_diff(p, lds_raw)));
        }
        const int Mrows = l == 0 ? MT : MX;
        RUN({ GEMM_RESID(A, wt_ptr(p, l, WT_MO), MX, DM, (const float*)p.out, (const float*)XH, 5, 1.0f); if (l == 0) GEMM_HPART(A, wt_ptr(p, l, WT_MO), DM); });
        RUN(REPEAT(REP_ROW, phase_rowpass(p, true, 1, true, true, l, 6, 7, Mrows, l == 0 ? 5 : -1, 1.0f, l, false)));
        RUN(REPEAT(REP_SWI, GEMM_SWIGLU(A, wt_ptr(p, l, WT_F2I), Mrows)));
        RUN({ GEMM_RESID(H, wt_ptr(p, l, WT_F2O), MX, DFF, (const float*)p.out, (const float*)XH, 8, 0.5f); if (l == 0) GEMM_HPART(H, wt_ptr(p, l, WT_F2O), DFF); });
        RUN(REPEAT(REP_ROW, phase_rowpass(p, true, 1, true, l == 0, 1, 0, 1, Mrows, l == 0 ? 8 : -1, 0.5f, l, false)));
    }
#undef RUN
}

extern "C" void kernel_launch(void* const* d_in, const int* in_sizes, int n_in, void* d_out, int out_size, void* d_ws, size_t ws_size, hipStream_t stream) {
    static int grid = 0;
    if (grid == 0) {
        if (n_in != 31 || out_size != MX * DM || ws_size < WS_END) { fprintf(stderr, "kernel_launch: unexpected shapes (n_in %d out %d ws %zu)\n", n_in, out_size, ws_size); grid = -1; return; }
        int dev = 0, cus = 0, per_cu = 0;
        hipGetDevice(&dev); hipDeviceGetAttribute(&cus, hipDeviceAttributeMultiprocessorCount, dev);
        hipFuncSetAttribute((const void*)mk_fwd, hipFuncAttributeMaxDynamicSharedMemorySize, LDS_BYTES);
        hipOccupancyMaxActiveBlocksPerMultiprocessor(&per_cu, (const void*)mk_fwd, NTHR, LDS_BYTES);
        if (per_cu < 1) { fprintf(stderr, "kernel_launch: occupancy query says %d blocks per CU\n", per_cu); grid = -1; return; }
        grid = cus;
    }
    if (grid < 0) return;
    if (hipMemsetAsync((char*)d_ws + WS_CTL, 0, CTL_BYTES, stream) != hipSuccess) { fprintf(stderr, "memset failed\n"); return; }
    P p{};
    for (int i = 0; i < 31; ++i) p.in[i] = (const float*)d_in[i];
    p.out = (float*)d_out; p.ws = (unsigned char*)d_ws; p.ph_lo = 0; p.ph_hi = 1000;
    void* args[] = {&p};
    hipError_t e = hipLaunchCooperativeKernel((const void*)mk_fwd, dim3(grid), dim3(NTHR), args, LDS_BYTES, stream);
    if (e != hipSuccess) fprintf(stderr, "cooperative launch failed: %s (grid %d)\n", hipGetErrorString(e), grid);
}
```
